# Optimizing an MI355X kernel written in HIP

```python
import math
import jax, jax.numpy as jnp
from jax import lax
import numpy as np

D_MODEL = 2048
BATCH = 4
SEQ = 2048
DEPTH = 1
DEC_BATCH = 128
DEC_SEQ = 4
PAST_LEN = 16384
PAGE_SIZE = 128

D_RNN = D_MODEL // 2
RNN_BLOCKS = 16
RNN_BW = D_RNN // RNN_BLOCKS
CONV_W = 4
LRU_C = 8.0
D_GMLP = D_MODEL // 2
CHUNK = 128
GMLP_GROUPS = 8
GMLP_GW = D_GMLP // GMLP_GROUPS
D_FF = 5632
ALPHA = (2.0 * DEPTH) ** 0.25
BETA = (8.0 * DEPTH) ** -0.25
LN_EPS = 1e-5
N_MOD = 9
IN_COLS = 2 * D_RNN + 2 * D_GMLP + 2 * D_MODEL

kernel_name = "hybrid_rglru_chunkgmlp_macaron_decode_step"


def layer_norm(x, g, b):
    xf = x.astype(jnp.float32)
    mu = jnp.mean(xf, axis=-1, keepdims=True)
    var = jnp.mean(jnp.square(xf - mu), axis=-1, keepdims=True)
    y = (xf - mu) * lax.rsqrt(var + LN_EPS)
    return (y * g.astype(jnp.float32) + b.astype(jnp.float32)).astype(x.dtype)


def swiglu(u, w_gu, w_down):
    gv = u @ w_gu
    g, v = jnp.split(gv, 2, axis=-1)
    return (jax.nn.silu(g) * v) @ w_down


def causal_conv(xpad, w, b):
    T = xpad.shape[1] - CONV_W + 1
    out = b
    for k in range(CONV_W):
        out = out + xpad[:, k:k + T] * w[k]
    return out


def rg_lru(x, h0, wa, ba, wx, bx, lam, reset_first):
    B, T, _ = x.shape
    f32 = jnp.float32
    xf = x.astype(f32)
    xb = xf.reshape(B, T, RNN_BLOCKS, RNN_BW)
    r = jax.nn.sigmoid(jnp.einsum('btnd,nde->btne', xb, wa.astype(f32)).reshape(B, T, D_RNN) + ba.astype(f32))
    i = jax.nn.sigmoid(jnp.einsum('btnd,nde->btne', xb, wx.astype(f32)).reshape(B, T, D_RNN) + bx.astype(f32))
    log_a = -LRU_C * r * jax.nn.softplus(-lam.astype(f32))
    a = jnp.exp(log_a)
    mult = jnp.sqrt(-jnp.expm1(2.0 * log_a))
    if reset_first:
        mult = jnp.where((jnp.arange(T) == 0)[None, :, None], 1.0, mult)
    bt = mult * i * xf

    def step(h, ab):
        a_t, b_t = ab
        h = a_t * h + b_t
        return h, h

    hT, ys = lax.scan(step, h0.astype(f32), (jnp.swapaxes(a, 0, 1), jnp.swapaxes(bt, 0, 1)))
    return jnp.swapaxes(ys, 0, 1), hT


def chunk_spatial_mix(v, w_s, b_s):
    B, T, _ = v.shape
    n = min(T, CHUNK)
    mask = jnp.tril(jnp.ones((n, n), dtype=bool))
    w = jnp.where(mask[None], w_s[:, :n, :n], 0.0)
    vb = v.reshape(B, T // n, n, GMLP_GROUPS, GMLP_GW)
    s = jnp.einsum('gts,bcsgd->bctgd', w, vb) + jnp.transpose(b_s[:, :n])[None, None, :, :, None]
    return s.reshape(B, T, D_GMLP)


def token_mixing(u, conv_buf, h0, reset_first, p):
    proj = u @ p['w_in']
    o1 = D_RNN
    o2 = o1 + D_RNN
    o3 = o2 + D_GMLP
    o4 = o3 + D_GMLP
    o5 = o4 + D_MODEL
    xr, gr, gu, gv, ga, gb = (proj[..., :o1], proj[..., o1:o2], proj[..., o2:o3],
                              proj[..., o3:o4], proj[..., o4:o5], proj[..., o5:])
    xpad = jnp.concatenate([conv_buf.astype(xr.dtype), xr], axis=1)
    new_buf = xpad[:, -(CONV_W - 1):]
    xc = causal_conv(xpad, p['conv_w'], p['conv_b'])
    y_lru, hT = rg_lru(xc, h0, p['lru_wa'], p['lru_ba'], p['lru_wx'], p['lru_bx'], p['lru_lambda'], reset_first)
    y_a = (y_lru.astype(u.dtype) * jax.nn.gelu(gr)) @ p['w_pa']
    vn = layer_norm(gv, p['gmlp_ln_g'], p['gmlp_ln_b'])
    s = chunk_spatial_mix(vn, p['gmlp_ws'], p['gmlp_bs'])
    y_b = (gu * s) @ p['w_pb']
    m = jax.nn.sigmoid(ga) * y_a + jax.nn.sigmoid(gb) * y_b
    return m @ p['w_out'], new_buf, hT.astype(u.dtype), vn


def decoder_layer(x, c, conv_buf, h0, reset_first, p):
    mod = jax.nn.silu(c) @ p['w_ada'] + p['b_ada']
    mod = mod.reshape(c.shape[0], 1, N_MOD, D_MODEL)
    sh1, sc1, g1, sh2, sc2, g2, sh3, sc3, g3 = [mod[:, :, k] for k in range(N_MOD)]
    ln_g, ln_b = p['ln_g'], p['ln_b']
    u = x * (1.0 + sc1) + sh1
    x = layer_norm(ALPHA * x + 0.5 * g1 * swiglu(u, p['ffn1_w_gu'], p['ffn1_w_down']), ln_g[0], ln_b[0])
    u = x * (1.0 + sc2) + sh2
    mix, new_buf, hT, vn = token_mixing(u, conv_buf, h0, reset_first, p)
    x = layer_norm(ALPHA * x + g2 * mix, ln_g[1], ln_b[1])
    u = x * (1.0 + sc3) + sh3
    x = layer_norm(ALPHA * x + 0.5 * g3 * swiglu(u, p['ffn2_w_gu'], p['ffn2_w_down']), ln_g[2], ln_b[2])
    return x, new_buf, hT, vn


def setup_inputs(seed: int = 0) -> dict:
    key = jax.random.key(seed)
    ks = jax.random.split(key, 32)
    f32 = jnp.float32
    L = DEPTH

    def nrm(k, shape, scale):
        return jax.random.normal(k, shape, f32) * scale

    a8 = jax.random.uniform(ks[20], (L, D_RNN), f32, 0.9, 0.999)
    a = a8 ** (1.0 / LRU_C)
    lam = jnp.log(a) - jnp.log1p(-a)
    return {
        'x_prompt': nrm(ks[0], (BATCH, SEQ, D_MODEL), 1.0),
        'x_sample': nrm(ks[1], (DEC_BATCH, DEC_SEQ, D_MODEL), 1.0),
        'state_conv': nrm(ks[2], (L, DEC_BATCH, CONV_W - 1, D_RNN), 1.0),
        'state_h': nrm(ks[3], (L, DEC_BATCH, D_RNN), 0.5),
        'c_prompt': nrm(ks[4], (BATCH, D_MODEL), 1.0),
        'c_sample': nrm(ks[5], (DEC_BATCH, D_MODEL), 1.0),
        'w_ada': nrm(ks[6], (L, D_MODEL, N_MOD * D_MODEL), 0.5 * D_MODEL ** -0.5),
        'b_ada': nrm(ks[7], (L, N_MOD * D_MODEL), 0.02),
        'ffn1_w_gu': nrm(ks[8], (L, D_MODEL, 2 * D_FF), D_MODEL ** -0.5),
        'ffn1_w_down': nrm(ks[9], (L, D_FF, D_MODEL), BETA * D_FF ** -0.5),
        'ffn2_w_gu': nrm(ks[10], (L, D_MODEL, 2 * D_FF), D_MODEL ** -0.5),
        'ffn2_w_down': nrm(ks[11], (L, D_FF, D_MODEL), BETA * D_FF ** -0.5),
        'w_in': nrm(ks[12], (L, D_MODEL, IN_COLS), D_MODEL ** -0.5),
        'conv_w': nrm(ks[13], (L, CONV_W, D_RNN), CONV_W ** -0.5),
        'conv_b': nrm(ks[14], (L, D_RNN), 0.02),
        'lru_wa': nrm(ks[15], (L, RNN_BLOCKS, RNN_BW, RNN_BW), RNN_BW ** -0.5),
        'lru_ba': nrm(ks[16], (L, D_RNN), 0.02),
        'lru_wx': nrm(ks[17], (L, RNN_BLOCKS, RNN_BW, RNN_BW), RNN_BW ** -0.5),
        'lru_bx': nrm(ks[18], (L, D_RNN), 0.02),
        'lru_lambda': lam,
        'gmlp_ln_g': 1.0 + nrm(ks[21], (L, D_GMLP), 0.02),
        'gmlp_ln_b': nrm(ks[22], (L, D_GMLP), 0.02),
        'gmlp_ws': nrm(ks[23], (L, GMLP_GROUPS, CHUNK, CHUNK), CHUNK ** -0.5),
        'gmlp_bs': 1.0 + nrm(ks[24], (L, GMLP_GROUPS, CHUNK), 0.1),
        'w_pa': nrm(ks[25], (L, D_RNN, D_MODEL), D_RNN ** -0.5),
        'w_pb': nrm(ks[26], (L, D_GMLP, D_MODEL), D_GMLP ** -0.5),
        'w_out': nrm(ks[27], (L, D_MODEL, D_MODEL), BETA * D_MODEL ** -0.5),
        'ln_g': 1.0 + nrm(ks[28], (L, 3, D_MODEL), 0.02),
        'ln_b': nrm(ks[29], (L, 3, D_MODEL), 0.02),
    }


def reference(x_prompt, x_sample, state_conv, state_h, c_prompt, c_sample,
              w_ada, b_ada, ffn1_w_gu, ffn1_w_down, ffn2_w_gu, ffn2_w_down,
              w_in, conv_w, conv_b, lru_wa, lru_ba, lru_wx, lru_bx, lru_lambda,
              gmlp_ln_g, gmlp_ln_b, gmlp_ws, gmlp_bs, w_pa, w_pb, w_out, ln_g, ln_b):
    yp, ys = x_prompt, x_sample
    bp = x_prompt.shape[0]
    conv_p, h_p, conv_s, h_s, v_s = [], [], [], [], []
    for l in range(DEPTH):
        p = {
            'w_ada': w_ada[l], 'b_ada': b_ada[l],
            'ffn1_w_gu': ffn1_w_gu[l], 'ffn1_w_down': ffn1_w_down[l],
            'ffn2_w_gu': ffn2_w_gu[l], 'ffn2_w_down': ffn2_w_down[l],
            'w_in': w_in[l], 'conv_w': conv_w[l], 'conv_b': conv_b[l],
            'lru_wa': lru_wa[l], 'lru_ba': lru_ba[l], 'lru_wx': lru_wx[l], 'lru_bx': lru_bx[l],
            'lru_lambda': lru_lambda[l],
            'gmlp_ln_g': gmlp_ln_g[l], 'gmlp_ln_b': gmlp_ln_b[l],
            'gmlp_ws': gmlp_ws[l], 'gmlp_bs': gmlp_bs[l],
            'w_pa': w_pa[l], 'w_pb': w_pb[l], 'w_out': w_out[l],
            'ln_g': ln_g[l], 'ln_b': ln_b[l],
        }
        zero_buf = jnp.zeros((bp, CONV_W - 1, D_RNN), x_prompt.dtype)
        zero_h = jnp.zeros((bp, D_RNN), jnp.float32)
        yp, cbp, hbp, _ = decoder_layer(yp, c_prompt, zero_buf, zero_h, True, p)
        ys, cbs, hbs, vns = decoder_layer(ys, c_sample, state_conv[l], state_h[l], False, p)
        conv_p.append(cbp)
        h_p.append(hbp)
        conv_s.append(cbs)
        h_s.append(hbs)
        v_s.append(vns)
    return (yp, ys, jnp.stack(conv_p), jnp.stack(h_p), jnp.stack(conv_s), jnp.stack(h_s), jnp.stack(v_s))
```

```cpp
#include <hip/hip_runtime.h>
#include <hip/hip_cooperative_groups.h>
#include <cstdio>
#include <cstdint>
namespace cg = cooperative_groups;

#ifndef ONE_LAUNCH
#define ONE_LAUNCH 1
#endif

#define LAS __attribute__((address_space(3)))
typedef unsigned short bf16_t;
typedef short bf16x8 __attribute__((ext_vector_type(8)));
typedef float f32x4 __attribute__((ext_vector_type(4)));
typedef float f32x2 __attribute__((ext_vector_type(2)));
typedef unsigned u32x4 __attribute__((ext_vector_type(4)));
typedef unsigned u32x2 __attribute__((ext_vector_type(2)));

constexpr int DM = 2048, NP = 8192, NS = 512, MR = NP + NS, DFF = 5632, DR = 1024, INC = 8192, NMOD = 9 * DM;
constexpr int SEQ = 2048, NSEG = 32, SEGL = 64;
constexpr float ALPHA = 1.189207115002721f;
constexpr float LN_EPS = 1e-5f;
constexpr int NWAVES = 8;

constexpr size_t MiB = 1u << 20;
constexpr size_t OFF_W1GU = 1 * MiB, OFF_W1D = 45 * MiB, OFF_W2GU = 67 * MiB, OFF_W2D = 111 * MiB, OFF_WIN = 133 * MiB, OFF_WPAB = 165 * MiB, OFF_WOUT = 173 * MiB;
constexpr size_t OFF_SC = 182 * MiB, OFF_MOD = 183 * MiB, OFF_U = 201 * MiB, OFF_YAB = 235 * MiB, OFF_X = 269 * MiB, OFF_HP = 337 * MiB, OFF_WADA = 473 * MiB;
constexpr size_t OFF_HL = OFF_WADA, OFF_PP = OFF_WADA + 32 * MiB, OFF_SEG = OFF_WADA + 64 * MiB, WS_END = 545 * MiB;

constexpr size_t O_Y = 0, O_CP = 17825792, O_HP = 17838080, O_CS = 17842176, O_HS = 18235392, O_VS = 18366464;

constexpr int LDS_BYTES = 131072 + 1024;

__device__ __forceinline__ unsigned f2bf(float f) { unsigned u = __builtin_bit_cast(unsigned, f); return (u + 0x7fffu + ((u >> 16) & 1u)) >> 16; }
__device__ __forceinline__ unsigned pk2(float lo, float hi) { return f2bf(lo) | (f2bf(hi) << 16); }
__device__ __forceinline__ float bflo(unsigned w) { return __builtin_bit_cast(float, w << 16); }
__device__ __forceinline__ float bfhi(unsigned w) { return __builtin_bit_cast(float, w & 0xffff0000u); }
__device__ __forceinline__ float bf2f(bf16_t b) { return __builtin_bit_cast(float, ((unsigned)b) << 16); }
__device__ __forceinline__ float wave_sum(float v) {
#pragma unroll
    for (int o = 1; o < 64; o <<= 1) v += __shfl_xor(v, o);
    return v;
}
__device__ __forceinline__ float sigmoid_fast(float x) { return __builtin_amdgcn_rcpf(1.0f + __expf(-x)); }
__device__ __forceinline__ float gelu_tanh(float x) { const float z = 0.7978845608028654f * (x + 0.044715f * x * x * x); return x * sigmoid_fast(2.0f * z); }
__device__ __forceinline__ int modrow(int r) { return r < NP ? (r >> 11) : 4 + ((r - NP) >> 2); }
#define LDS_WAIT() asm volatile("s_waitcnt lgkmcnt(0)" ::: "memory")

namespace pg8 {
constexpr int BM = 256, BK = 64, HALF = 128, HTB = HALF * BK * 2, STAGE_BYTES = 8 * HTB, NXCD = 8, WGM = 8;
__host__ __device__ __forceinline__ int lds_byte(int r, int c) { const int st = (r >> 4) * 2 + (c >> 5), rr = r & 15, cc = c & 31, ob = rr * 64 + cc * 2; return st * 1024 + (ob ^ (((ob >> 9) & 1) << 5)); }
__host__ __device__ __forceinline__ void stage_rc(int b, int& R, int& C) { const int st = b / 1024, sb = b % 1024, swz = sb ^ (((sb >> 9) & 1) << 5); R = (st >> 1) * 16 + swz / 64; C = (st & 1) * 32 + (swz % 64) / 2; }
__host__ __device__ __forceinline__ int perm32(int rho) { const int n = rho >> 4, i = rho & 15; return 8 * (i >> 2) + 4 * n + (i & 3); }

struct Unit { int pm, pn; };
struct Gemm { const bf16_t* A; const bf16_t* Bt; int M, N, K, lda, ldb; };

struct StaticOrder {
    int nM, nN, nwg, G, c;
    __host__ __device__ void init(int M, int N, int G_, int c_) { nM = M / BM; nN = N / BM; nwg = nM * nN; G = G_; c = c_; }
    __host__ __device__ bool next(int i, Unit& u) const {
        const long L = (long)i * G + c; if (L >= nwg) return false;
        int wgid = (int)L; { const int q = nwg / NXCD, r = nwg % NXCD, xcd = wgid % NXCD, off = wgid / NXCD; wgid = (xcd < r ? xcd * (q + 1) : r * (q + 1) + (xcd - r) * q) + off; }
        const int nig = WGM * nN, gid = wgid / nig, fm = gid * WGM, gsz = (nM - fm) < WGM ? (nM - fm) : WGM;
        u.pm = fm + ((wgid % nig) % gsz); u.pn = (wgid % nig) / gsz; return true;
    }
};

__device__ __forceinline__ unsigned cvt_pk_bf16(float lo, float hi) { unsigned r; asm volatile("v_cvt_pk_bf16_f32 %0, %1, %2" : "=v"(r) : "v"(lo), "v"(hi)); return r; }

struct EpiF32 {
    static constexpr bool PERM = false, HAS_MID = false;
    float* C; int ldc; const float* bias;
    __device__ __forceinline__ void mid(f32x4 (&acc)[2][2][4][2], const Unit& u, int wr, int wc, int fr, int fq) const {}
    __device__ __forceinline__ void operator()(const f32x4 (&acc)[2][2][4][2], const Unit& u, int wr, int wc, int fr, int fq) const {
        const int row0 = u.pm * BM + wr * 64 + fr, col0 = u.pn * BM + wc * 32 + 4 * fq;
        f32x4 bv[2][2];
#pragma unroll
        for (int bj = 0; bj < 2; ++bj)
#pragma unroll
            for (int n = 0; n < 2; ++n) bv[bj][n] = *(const f32x4*)(bias + col0 + bj * HALF + n * 16);
#pragma unroll
        for (int ai = 0; ai < 2; ++ai)
#pragma unroll
            for (int m = 0; m < 4; ++m) { float* rowp = C + (size_t)(row0 + ai * HALF + m * 16) * ldc + col0;
#pragma unroll
                for (int bj = 0; bj < 2; ++bj)
#pragma unroll
                    for (int n = 0; n < 2; ++n) *(f32x4*)(rowp + bj * HALF + n * 16) = acc[ai][bj][m][n] + bv[bj][n]; }
    }
};
struct EpiBf16 {
    static constexpr bool PERM = true, HAS_MID = false;
    bf16_t* O; int ldc;
    __device__ __forceinline__ void mid(f32x4 (&acc)[2][2][4][2], const Unit& u, int wr, int wc, int fr, int fq) const {}
    __device__ __forceinline__ void operator()(const f32x4 (&acc)[2][2][4][2], const Unit& u, int wr, int wc, int fr, int fq) const {
        const int row0 = u.pm * BM + wr * 64 + fr, col0 = u.pn * BM + wc * 32 + 8 * fq;
#pragma unroll
        for (int ai = 0; ai < 2; ++ai)
#pragma unroll
            for (int m = 0; m < 4; ++m) { bf16_t* rowp = O + (size_t)(row0 + ai * HALF + m * 16) * ldc + col0;
#pragma unroll
                for (int bj = 0; bj < 2; ++bj) { const f32x4 v0 = acc[ai][bj][m][0], v1 = acc[ai][bj][m][1];
                    u32x4 w; w.x = cvt_pk_bf16(v0[0], v0[1]); w.y = cvt_pk_bf16(v0[2], v0[3]); w.z = cvt_pk_bf16(v1[0], v1[1]); w.w = cvt_pk_bf16(v1[2], v1[3]);
                    *(u32x4*)(rowp + bj * HALF) = w; } }
    }
};
struct EpiSwiglu {
    static constexpr bool PERM = true, HAS_MID = false;
    bf16_t* H;
    __device__ __forceinline__ void mid(f32x4 (&acc)[2][2][4][2], const Unit& u, int wr, int wc, int fr, int fq) const {}
    __device__ __forceinline__ void operator()(const f32x4 (&acc)[2][2][4][2], const Unit& u, int wr, int wc, int fr, int fq) const {
        const int row0 = u.pm * BM + wr * 64 + fr, col0 = u.pn * HALF + wc * 32 + 8 * fq;
#pragma unroll
        for (int ai = 0; ai < 2; ++ai)
#pragma unroll
            for (int m = 0; m < 4; ++m) { bf16_t* rowp = H + (size_t)(row0 + ai * HALF + m * 16) * DFF + col0;
                float o[8];
#pragma unroll
                for (int n = 0; n < 2; ++n)
#pragma unroll
                    for (int j = 0; j < 4; ++j) { const float g = acc[ai][0][m][n][j], v = acc[ai][1][m][n][j]; o[n * 4 + j] = g * sigmoid_fast(g) * v; }
                u32x4 w; w.x = cvt_pk_bf16(o[0], o[1]); w.y = cvt_pk_bf16(o[2], o[3]); w.z = cvt_pk_bf16(o[4], o[5]); w.w = cvt_pk_bf16(o[6], o[7]);
                *(u32x4*)rowp = w; }
    }
};
struct EpiResid {
    static constexpr bool PERM = false, HAS_MID = false;
    const float* xp; const float* xs; float* X; const float* MOD; int gk; float coef;
    __device__ __forceinline__ void mid(f32x4 (&acc)[2][2][4][2], const Unit& u, int wr, int wc, int fr, int fq) const {}
    __device__ __forceinline__ void operator()(const f32x4 (&acc)[2][2][4][2], const Unit& u, int wr, int wc, int fr, int fq) const {
        const int row0 = u.pm * BM + wr * 64 + fr, col0 = u.pn * BM + wc * 32 + 4 * fq;
        const bool samp = u.pm >= NP / BM;
        f32x4 gv[2][2];
        if (!samp) { const float* md = MOD + (size_t)(u.pm >> 3) * NMOD + gk * DM + col0;
#pragma unroll
            for (int bj = 0; bj < 2; ++bj)
#pragma unroll
                for (int n = 0; n < 2; ++n) gv[bj][n] = *(const f32x4*)(md + bj * HALF + n * 16) * coef; }
#pragma unroll
        for (int ai = 0; ai < 2; ++ai)
#pragma unroll
            for (int m = 0; m < 4; ++m) { const int row = row0 + ai * HALF + m * 16;
                const float* xrow = (samp ? xs + (size_t)(row - NP) * DM : xp + (size_t)row * DM) + col0;
                if (samp) { const float* md = MOD + (size_t)(4 + ((row - NP) >> 2)) * NMOD + gk * DM + col0;
#pragma unroll
                    for (int bj = 0; bj < 2; ++bj)
#pragma unroll
                        for (int n = 0; n < 2; ++n) gv[bj][n] = *(const f32x4*)(md + bj * HALF + n * 16) * coef; }
                float* orow = X + (size_t)row * DM + col0;
#pragma unroll
                for (int bj = 0; bj < 2; ++bj)
#pragma unroll
                    for (int n = 0; n < 2; ++n) { const f32x4 xv = *(const f32x4*)(xrow + bj * HALF + n * 16); *(f32x4*)(orow + bj * HALF + n * 16) = xv * ALPHA + gv[bj][n] * acc[ai][bj][m][n]; }
                asm volatile("" ::: "memory"); }
    }
};
struct EpiMerge {
    static constexpr bool PERM = true, HAS_MID = true;
    const bf16_t* PROJ; bf16_t* O;
    __device__ __forceinline__ void mid(f32x4 (&acc)[2][2][4][2], const Unit& u, int wr, int wc, int fr, int fq) const {
        unsigned off = (unsigned)((u.pm * BM + wr * 64 + fr) * INC + u.pn * BM + wc * 32 + 8 * fq) * 2u;
        asm volatile("" : "+v"(off));
        const char* base = (const char*)PROJ;
#pragma unroll
        for (int ai = 0; ai < 2; ++ai) {
#pragma unroll
            for (int m = 0; m < 4; ++m) { const unsigned ro = off + (unsigned)((ai * HALF + m * 16) * INC * 2);
#pragma unroll
                for (int bj = 0; bj < 2; ++bj) { const u32x4 a = *(const u32x4*)(base + ro + (4096 + bj * HALF) * 2), b = *(const u32x4*)(base + ro + (6144 + bj * HALF) * 2);
#pragma unroll
                    for (int q = 0; q < 4; ++q) { const float a0 = fminf(fmaxf(bflo(a[q]), -30.f), 30.f), a1 = fminf(fmaxf(bfhi(a[q]), -30.f), 30.f), b0 = fminf(fmaxf(bflo(b[q]), -30.f), 30.f), b1 = fminf(fmaxf(bfhi(b[q]), -30.f), 30.f);
                        const float r0 = (1.0f + __expf(-b0)) * __builtin_amdgcn_rcpf(1.0f + __expf(-a0)), r1 = (1.0f + __expf(-b1)) * __builtin_amdgcn_rcpf(1.0f + __expf(-a1));
                        acc[ai][bj][m][q >> 1][(q & 1) * 2] *= r0; acc[ai][bj][m][q >> 1][(q & 1) * 2 + 1] *= r1; } } }
            asm volatile("" ::: "memory"); }
    }
    __device__ __forceinline__ void operator()(const f32x4 (&acc)[2][2][4][2], const Unit& u, int wr, int wc, int fr, int fq) const {
        const int row0 = u.pm * BM + wr * 64 + fr, col0 = u.pn * BM + wc * 32 + 8 * fq;
#pragma unroll
        for (int ai = 0; ai < 2; ++ai)
#pragma unroll
            for (int m = 0; m < 4; ++m) { const size_t row = (size_t)(row0 + ai * HALF + m * 16); const bf16_t* pr = PROJ + row * INC + 6144 + col0; bf16_t* orow = O + row * DM + col0;
#pragma unroll
                for (int bj = 0; bj < 2; ++bj) { const u32x4 b = *(const u32x4*)(pr + bj * HALF); u32x4 w;
#pragma unroll
                    for (int q = 0; q < 4; ++q) { const float b0 = fminf(fmaxf(bflo(b[q]), -30.f), 30.f), b1 = fminf(fmaxf(bfhi(b[q]), -30.f), 30.f);
                        w[q] = cvt_pk_bf16(acc[ai][bj][m][q >> 1][(q & 1) * 2] * sigmoid_fast(b0), acc[ai][bj][m][q >> 1][(q & 1) * 2 + 1] * sigmoid_fast(b1)); }
                    *(u32x4*)(orow + bj * HALF) = w; }
                asm volatile("" ::: "memory"); }
    }
};

template <class Epi, class Sched>
__device__ __forceinline__ void gemm_phase(LAS unsigned char* lds, const Gemm g, const Sched& S, const Epi& E) {
    int tid_ = threadIdx.x; asm volatile("" : "+v"(tid_));
    const int tid = tid_, wid = __builtin_amdgcn_readfirstlane(tid >> 6), lane = tid & 63, wr = wid >> 2, wc = wid & 3, fr = lane & 15, fq = lane >> 4;
    const int nt = g.K / BK, tmid = nt / 2;
    unsigned voffA[2], voffB[2];
#pragma unroll
    for (int i = 0; i < 2; ++i) { int R, C; stage_rc(tid * 16 + i * 8192, R, C); const int Rb = Epi::PERM ? ((R & ~31) + perm32(R & 31)) : R;
        voffA[i] = (unsigned)(R * g.lda + C) * 2u; voffB[i] = (unsigned)(Rb * g.ldb + C) * 2u; }
    const size_t kstep = (size_t)(BK * 2);
    const size_t hA = (size_t)HALF * g.lda * 2, hB = (size_t)HALF * g.ldb * 2, tA = 2 * hA, tB = 2 * hB;
    const unsigned ldsw = (unsigned)wid * 1024u;
    const int aoff = lds_byte(wr * 64 + fr, fq * 8), boff = lds_byte(wc * 32 + fr, fq * 8);
#define PG8_SA(b, h) (((b) * 2 + (h)) * HTB)
#define PG8_SB(b, h) ((4 + (b) * 2 + (h)) * HTB)
#define PG8_STAGE(bufoff, gbase, voff) do { _Pragma("unroll") for (int _i = 0; _i < 2; ++_i) \
        __builtin_amdgcn_global_load_lds((const unsigned*)((const char*)(gbase) + (voff)[_i]), (LAS unsigned*)(lds + (bufoff) + ldsw + _i * 8192), 16, 0, 0); } while (0)
#define PG8_LDA(dst, b, h) do { _Pragma("unroll") for (int m = 0; m < 4; ++m) _Pragma("unroll") for (int k = 0; k < 2; ++k) dst[m][k] = *(const LAS bf16x8*)(lds + PG8_SA(b, h) + aoff + m * 2048 + k * 1024); } while (0)
#define PG8_LDB(dst, b, h) do { _Pragma("unroll") for (int n = 0; n < 2; ++n) _Pragma("unroll") for (int k = 0; k < 2; ++k) dst[n][k] = *(const LAS bf16x8*)(lds + PG8_SB(b, h) + boff + n * 2048 + k * 1024); } while (0)
#define PG8_MMA(ai, bj, At, Bt) do { __builtin_amdgcn_s_setprio(1); _Pragma("unroll") for (int m = 0; m < 4; ++m) _Pragma("unroll") for (int n = 0; n < 2; ++n) _Pragma("unroll") for (int k = 0; k < 2; ++k) \
        acc[ai][bj][m][n] = __builtin_amdgcn_mfma_f32_16x16x32_bf16(Bt[n][k], At[m][k], acc[ai][bj][m][n], 0, 0, 0); __builtin_amdgcn_s_setprio(0); } while (0)
#define PG8_WAIT_V(n) asm volatile("s_waitcnt vmcnt(" #n ")" ::: "memory")
#define PG8_WAIT_L(n) asm volatile("s_waitcnt lgkmcnt(" #n ")" ::: "memory")
#define PG8_BAR __builtin_amdgcn_s_barrier()
#define PG8_SCHED __builtin_amdgcn_sched_barrier(0)
    Unit cur, nxt; int ui = 0;
    if (!S.next(0, cur)) return;
    f32x4 acc[2][2][4][2];
#pragma unroll
    for (int a = 0; a < 2; ++a)
#pragma unroll
        for (int b = 0; b < 2; ++b)
#pragma unroll
            for (int m = 0; m < 4; ++m)
#pragma unroll
                for (int n = 0; n < 2; ++n) acc[a][b][m][n] = (f32x4){0.f, 0.f, 0.f, 0.f};
    bf16x8 At[4][2], B0[2][2], B1[2][2];
    const char* cA = (const char*)g.A + (size_t)cur.pm * tA; const char* cB = (const char*)g.Bt + (size_t)cur.pn * tB;
    PG8_STAGE(PG8_SB(0, 0), cB, voffB); PG8_STAGE(PG8_SB(0, 1), cB + hB, voffB); PG8_STAGE(PG8_SA(0, 0), cA, voffA); PG8_STAGE(PG8_SA(0, 1), cA + hA, voffA);
    if (wr == 1) PG8_BAR;
    PG8_WAIT_V(2); PG8_BAR;
    PG8_STAGE(PG8_SB(1, 0), cB + kstep, voffB); PG8_STAGE(PG8_SA(1, 0), cA + kstep, voffA); PG8_STAGE(PG8_SB(1, 1), cB + hB + kstep, voffB);
    PG8_WAIT_V(6); PG8_BAR;
    for (;;) {
        const bool has_next = S.next(ui + 1, nxt);
        const char* nA = has_next ? (const char*)g.A + (size_t)nxt.pm * tA : cA; const char* nB = has_next ? (const char*)g.Bt + (size_t)nxt.pn * tB : cB;
        for (int t = 0; t < nt; t += 2) {
            const bool last = (t == nt - 2);
            const char* a1 = cA + (size_t)(t + 1) * kstep;
            const char* a2 = last ? nA : cA + (size_t)(t + 2) * kstep; const char* b2 = last ? nB : cB + (size_t)(t + 2) * kstep;
            const char* a3 = a2 + kstep; const char* b3 = b2 + kstep;
            if constexpr (Epi::HAS_MID) { if (t == tmid) E.mid(acc, cur, wr, wc, fr, fq); }
            PG8_LDB(B0, 0, 0); PG8_LDB(B1, 0, 1); PG8_SCHED; PG8_LDA(At, 0, 0); PG8_STAGE(PG8_SA(1, 1), a1 + hA, voffA);
            PG8_WAIT_V(8); PG8_WAIT_L(0); PG8_BAR; PG8_MMA(0, 0, At, B0); PG8_MMA(0, 1, At, B1); PG8_BAR; PG8_SCHED;
            PG8_LDA(At, 0, 1); PG8_STAGE(PG8_SB(0, 0), b2, voffB); PG8_STAGE(PG8_SB(0, 1), b2 + hB, voffB); PG8_STAGE(PG8_SA(0, 0), a2, voffA);
            PG8_WAIT_V(8); PG8_WAIT_L(0); PG8_BAR; PG8_MMA(1, 0, At, B0); PG8_MMA(1, 1, At, B1); PG8_BAR; PG8_SCHED;
            PG8_LDB(B0, 1, 0); PG8_LDB(B1, 1, 1); PG8_SCHED; PG8_LDA(At, 1, 0); PG8_STAGE(PG8_SA(0, 1), a2 + hA, voffA);
            PG8_WAIT_V(8); PG8_WAIT_L(0); PG8_BAR; PG8_MMA(0, 0, At, B0); PG8_MMA(0, 1, At, B1); PG8_BAR; PG8_SCHED;
            PG8_LDA(At, 1, 1); PG8_STAGE(PG8_SB(1, 0), b3, voffB); PG8_STAGE(PG8_SB(1, 1), b3 + hB, voffB); PG8_STAGE(PG8_SA(1, 0), a3, voffA);
            PG8_WAIT_V(8); PG8_WAIT_L(0); PG8_BAR; PG8_MMA(1, 0, At, B0); PG8_MMA(1, 1, At, B1); PG8_BAR; PG8_SCHED;
        }
        if (wr == 0) PG8_BAR;
        E(acc, cur, wr, wc, fr, fq);
        if (!has_next) break;
#pragma unroll
        for (int a = 0; a < 2; ++a)
#pragma unroll
            for (int b = 0; b < 2; ++b)
#pragma unroll
                for (int m = 0; m < 4; ++m)
#pragma unroll
                    for (int n = 0; n < 2; ++n) acc[a][b][m][n] = (f32x4){0.f, 0.f, 0.f, 0.f};
        cur = nxt; cA = nA; cB = nB; ++ui;
        if (wr == 1) PG8_BAR;
    }
    PG8_WAIT_V(0);
    PG8_BAR;
#undef PG8_SA
#undef PG8_SB
#undef PG8_STAGE
#undef PG8_LDA
#undef PG8_LDB
#undef PG8_MMA
#undef PG8_WAIT_V
#undef PG8_WAIT_L
#undef PG8_BAR
#undef PG8_SCHED
}
}

struct Args { const float* in[29]; float* out; unsigned char* ws; int ph_lo, ph_hi; };
enum { I_XP = 0, I_XS, I_SCONV, I_SH, I_CP, I_CS, I_WADA, I_BADA, I_F1GU, I_F1D, I_F2GU, I_F2D, I_WIN, I_CONVW, I_CONVB, I_LWA, I_LBA, I_LWX, I_LBX, I_LAM, I_GLNG, I_GLNB, I_GWS, I_GBS, I_WPA, I_WPB, I_WOUT, I_LNG, I_LNB };
constexpr int NPHASE = 15;

__device__ __forceinline__ void transpose_item(const float* W, int N, bf16_t* WT, int ldd, int koff, int mode, LAS float* scr, int item, int lane) {
    const int nblk = N / 32, kb = item / nblk, nb = item % nblk, k0 = 64 * kb, n0 = 32 * nb;
#pragma unroll 8
    for (int i = 0; i < 32; ++i) { const int kk = 2 * i + (lane >> 5); scr[kk * 33 + (lane & 31)] = W[(size_t)(k0 + kk) * N + n0 + (lane & 31)]; }
    LDS_WAIT(); asm volatile("" ::: "memory");
    int d0 = n0;
    if (mode == 1) { const int half = n0 >= DFF ? 1 : 0, jj = n0 - half * DFF; d0 = 256 * (jj >> 7) + 128 * half + (jj & 127); }
    const int c = lane & 7;
#pragma unroll
    for (int j = 0; j < 4; ++j) { const int n = (lane >> 3) + 8 * j; const LAS float* s = scr + (8 * c) * 33 + n;
        u32x4 o; o.x = pk2(s[0 * 33], s[1 * 33]); o.y = pk2(s[2 * 33], s[3 * 33]); o.z = pk2(s[4 * 33], s[5 * 33]); o.w = pk2(s[6 * 33], s[7 * 33]);
        *(u32x4*)(WT + (size_t)(d0 + n) * ldd + koff + k0 + 8 * c) = o; }
    LDS_WAIT(); asm volatile("" ::: "memory");
}

template <int KIND> __device__ __forceinline__ void phase_body(const Args& args, const int ph, LAS unsigned char* lds) {

    int tid_ = threadIdx.x; asm volatile("" : "+v"(tid_));
    const int tid = tid_, lane = tid & 63, wave = __builtin_amdgcn_readfirstlane(tid >> 6);
    int bx_ = blockIdx.x; asm volatile("" : "+s"(bx_));
    const int G = gridDim.x, bx = bx_;
    const int gw = bx * NWAVES + wave, NGW = G * NWAVES;
    unsigned char* ws = args.ws; asm volatile("" : "+s"(ws));
    bf16_t* W1GU = (bf16_t*)(ws + OFF_W1GU); bf16_t* W1D = (bf16_t*)(ws + OFF_W1D); bf16_t* W2GU = (bf16_t*)(ws + OFF_W2GU); bf16_t* W2D = (bf16_t*)(ws + OFF_W2D);
    bf16_t* WIN = (bf16_t*)(ws + OFF_WIN); bf16_t* WPAB = (bf16_t*)(ws + OFF_WPAB); bf16_t* WOUT = (bf16_t*)(ws + OFF_WOUT); bf16_t* WADA = (bf16_t*)(ws + OFF_WADA);
    bf16_t* SC = (bf16_t*)(ws + OFF_SC); float* MOD = (float*)(ws + OFF_MOD); bf16_t* U = (bf16_t*)(ws + OFF_U); bf16_t* YAB = (bf16_t*)(ws + OFF_YAB);
    float* X = (float*)(ws + OFF_X); bf16_t* HP = (bf16_t*)(ws + OFF_HP); float* HL = (float*)(ws + OFF_HL); float* PP = (float*)(ws + OFF_PP);
    float* SEGA = (float*)(ws + OFF_SEG); float* SEGH = SEGA + 4 * NSEG * DR;
    float* out = args.out;

        if constexpr (KIND == 0) {
            LAS float* scr = (LAS float*)(lds + wave * 16384);
            constexpr int I_ADA = 32 * (NMOD / 32), I_GU = 32 * (2 * DFF / 32), I_D = (DFF / 64) * (DM / 32), I_IN = 32 * (INC / 32), I_PA = (DR / 64) * (DM / 32), I_OUT = 32 * (DM / 32);
            constexpr int NIT = I_ADA + 2 * I_GU + 2 * I_D + I_IN + 2 * I_PA + I_OUT;
            for (int it = gw; it < NIT; it += NGW) {
                int r = it;
                if (r < I_ADA) { transpose_item(args.in[I_WADA], NMOD, WADA, DM, 0, 0, scr, r, lane); continue; } r -= I_ADA;
                if (r < I_GU) { transpose_item(args.in[I_F1GU], 2 * DFF, W1GU, DM, 0, 1, scr, r, lane); continue; } r -= I_GU;
                if (r < I_D) { transpose_item(args.in[I_F1D], DM, W1D, DFF, 0, 0, scr, r, lane); continue; } r -= I_D;
                if (r < I_IN) { transpose_item(args.in[I_WIN], INC, WIN, DM, 0, 0, scr, r, lane); continue; } r -= I_IN;
                if (r < I_PA) { transpose_item(args.in[I_WPA], DM, WPAB, DM, 0, 0, scr, r, lane); continue; } r -= I_PA;
                if (r < I_PA) { transpose_item(args.in[I_WPB], DM, WPAB, DM, DR, 0, scr, r, lane); continue; } r -= I_PA;
                if (r < I_OUT) { transpose_item(args.in[I_WOUT], DM, WOUT, DM, 0, 0, scr, r, lane); continue; } r -= I_OUT;
                if (r < I_GU) { transpose_item(args.in[I_F2GU], 2 * DFF, W2GU, DM, 0, 1, scr, r, lane); continue; } r -= I_GU;
                transpose_item(args.in[I_F2D], DM, W2D, DFF, 0, 0, scr, r, lane);
            }
            for (int i = bx * 512 + tid; i < 256 * DM / 2; i += G * 512) { const int row = i / (DM / 2), c2 = (i % (DM / 2)) * 2;
                float v0 = 0.f, v1 = 0.f;
                if (row < 132) { const float* cp = row < 4 ? args.in[I_CP] + (size_t)row * DM : args.in[I_CS] + (size_t)(row - 4) * DM; const float a = cp[c2], b = cp[c2 + 1]; v0 = a / (1.0f + expf(-a)); v1 = b / (1.0f + expf(-b)); }
                ((unsigned*)SC)[i] = pk2(v0, v1); }
        }
        if constexpr (KIND == 1) {
            pg8::Gemm g{SC, WADA, 256, NMOD, DM, DM, DM}; pg8::StaticOrder S; S.init(256, NMOD, G, bx);
            pg8::EpiF32 E{MOD, NMOD, args.in[I_BADA]};
            pg8::gemm_phase<pg8::EpiF32, pg8::StaticOrder>(lds, g, S, E);
        }
        if constexpr (KIND == 2) {
            for (int r = gw; r < MR; r += NGW) {
                const float* xr = r < NP ? args.in[I_XP] + (size_t)r * DM : args.in[I_XS] + (size_t)(r - NP) * DM;
                const float* md = MOD + (size_t)modrow(r) * NMOD;
#pragma unroll
                for (int j = 0; j < 8; ++j) { const int c = lane * 4 + 256 * j; const f32x4 x = *(const f32x4*)(xr + c), sh = *(const f32x4*)(md + c), sc = *(const f32x4*)(md + DM + c);
                    const f32x4 u = x * (1.0f + sc) + sh; u32x2 w; w.x = pk2(u[0], u[1]); w.y = pk2(u[2], u[3]); *(u32x2*)(U + (size_t)r * DM + c) = w; }
            }
        }
        if constexpr (KIND == 3) {
            pg8::Gemm g{U, ph == 3 ? W1GU : W2GU, MR, 2 * DFF, DM, DM, DM}; pg8::StaticOrder S; S.init(MR, 2 * DFF, G, bx);
            pg8::EpiSwiglu E{HP};
            pg8::gemm_phase<pg8::EpiSwiglu, pg8::StaticOrder>(lds, g, S, E);
        }
        if constexpr (KIND == 4) {
            pg8::Gemm g{ph == 10 ? U : HP, ph == 4 ? W1D : (ph == 10 ? WOUT : W2D), MR, DM, ph == 10 ? DM : DFF, ph == 10 ? DM : DFF, ph == 10 ? DM : DFF};
            pg8::StaticOrder S; S.init(MR, DM, G, bx);
            pg8::EpiResid E{ph == 4 ? args.in[I_XP] : X, ph == 4 ? args.in[I_XS] : X + (size_t)NP * DM, X, MOD, ph == 4 ? 2 : (ph == 10 ? 5 : 8), ph == 10 ? 1.0f : 0.5f};
            pg8::gemm_phase<pg8::EpiResid, pg8::StaticOrder>(lds, g, S, E);
        }
        if constexpr (KIND == 5) {
            const int li = ph == 5 ? 0 : (ph == 11 ? 1 : 2);
            const float* lg = args.in[I_LNG] + li * DM; const float* lb = args.in[I_LNB] + li * DM;
            float* dst = ph == 14 ? out + O_Y : X;
            for (int r = gw; r < MR; r += NGW) {
                const float* xr = X + (size_t)r * DM; f32x4 v[8]; float s = 0.f;
#pragma unroll
                for (int j = 0; j < 8; ++j) { v[j] = *(const f32x4*)(xr + lane * 4 + 256 * j); s += (v[j][0] + v[j][1]) + (v[j][2] + v[j][3]); }
                const float mean = wave_sum(s) * (1.0f / DM); float q = 0.f;
#pragma unroll
                for (int j = 0; j < 8; ++j) { v[j] = v[j] - mean; q += (v[j][0] * v[j][0] + v[j][1] * v[j][1]) + (v[j][2] * v[j][2] + v[j][3] * v[j][3]); }
                const float rstd = 1.0f / sqrtf(wave_sum(q) * (1.0f / DM) + LN_EPS);
                const float* md = MOD + (size_t)modrow(r) * NMOD + (3 * (li + 1)) * DM;
#pragma unroll
                for (int j = 0; j < 8; ++j) { const int c = lane * 4 + 256 * j; const f32x4 y = v[j] * rstd * *(const f32x4*)(lg + c) + *(const f32x4*)(lb + c);
                    *(f32x4*)(dst + (size_t)r * DM + c) = y;
                    if (ph != 14) { const f32x4 sh = *(const f32x4*)(md + c), sc = *(const f32x4*)(md + DM + c); const f32x4 u = y * (1.0f + sc) + sh; u32x2 w; w.x = pk2(u[0], u[1]); w.y = pk2(u[2], u[3]); *(u32x2*)(U + (size_t)r * DM + c) = w; } }
            }
        }
        if constexpr (KIND == 6) {
            pg8::Gemm g{U, WIN, MR, INC, DM, DM, DM}; pg8::StaticOrder S; S.init(MR, INC, G, bx);
            pg8::EpiBf16 E{HP, INC};
            pg8::gemm_phase<pg8::EpiBf16, pg8::StaticOrder>(lds, g, S, E);
        }
        if constexpr (KIND == 7) {
            const bf16_t* PROJ = HP;
            {
                LAS float* xs = (LAS float*)lds;
                LAS float* xc = (LAS float*)(lds + 28672);
                LAS float* SA = (LAS float*)(lds + 45056);
                LAS float* SH = (LAS float*)(lds + 47104);
                const float* cw = args.in[I_CONVW]; const float* cb = args.in[I_CONVB];
                for (int it = bx; it < 2048 + 128; it += G) {
                    const bool samp = it >= 2048;
                    const int n = it & 15, e = lane, ch = n * 64 + e;
                    int b = 0, seg = 0, row0 = 0, b0 = 0;
                    if (!samp) { b = it >> 9; seg = (it >> 4) & 31; row0 = b * SEQ + seg * SEGL; } else { b0 = ((it - 2048) >> 4) * 16; row0 = NP + b0 * 4; }
                    __syncthreads();
                    if (!samp) {
                        for (int i = tid; i < 67 * 64; i += 512) { const int j = i >> 6, c = i & 63; float v = 0.f; if (seg > 0 || j >= 3) v = bf2f(PROJ[(size_t)(row0 + j - 3) * INC + n * 64 + c]); xs[i] = v; }
                    } else {
                        for (int i = tid; i < 112 * 64; i += 512) { const int rr = i >> 6, c = i & 63, bb = rr / 7, j = rr - bb * 7; float v;
                            if (j < 3) v = args.in[I_SCONV][((size_t)(b0 + bb) * 3 + j) * DR + n * 64 + c]; else v = bf2f(PROJ[(size_t)(NP + (b0 + bb) * 4 + (j - 3)) * INC + n * 64 + c]);
                            xs[i] = v; }
                    }
                    __syncthreads();
                    {
                        const float w0 = cw[0 * DR + ch], w1 = cw[1 * DR + ch], w2 = cw[2 * DR + ch], w3 = cw[3 * DR + ch], bb_ = cb[ch];
#pragma unroll
                        for (int i = 0; i < 8; ++i) { const int tt = wave + 8 * i; const int base = samp ? ((tt >> 2) * 7 + (tt & 3)) : tt;
                            xc[tt * 64 + e] = bb_ + w0 * xs[(base + 0) * 64 + e] + w1 * xs[(base + 1) * 64 + e] + w2 * xs[(base + 2) * 64 + e] + w3 * xs[(base + 3) * 64 + e]; }
                    }
                    __syncthreads();
                    float ar[8], br[8];
                    {
                        float accr[8], acci[8];
#pragma unroll
                        for (int k = 0; k < 8; ++k) { accr[k] = 0.f; acci[k] = 0.f; }
                        const float* wa = args.in[I_LWA] + (size_t)n * 4096 + e; const float* wx = args.in[I_LWX] + (size_t)n * 4096 + e;
#pragma unroll 2
                        for (int d4 = 0; d4 < 16; ++d4) {
                            float wav[4], wxv[4];
#pragma unroll
                            for (int q = 0; q < 4; ++q) { wav[q] = wa[(d4 * 4 + q) * 64]; wxv[q] = wx[(d4 * 4 + q) * 64]; }
#pragma unroll
                            for (int k = 0; k < 8; ++k) { const f32x4 xv = *(const LAS f32x4*)(xc + (wave * 8 + k) * 64 + d4 * 4);
#pragma unroll
                                for (int q = 0; q < 4; ++q) { accr[k] += xv[q] * wav[q]; acci[k] += xv[q] * wxv[q]; } }
                        }
                        const float ba = args.in[I_LBA][ch], bxx = args.in[I_LBX][ch], lam = args.in[I_LAM][ch];
                        const float sp = log1pf(expf(-lam));
#pragma unroll
                        for (int k = 0; k < 8; ++k) { const int tt = wave * 8 + k;
                            const float r = 1.0f / (1.0f + expf(-(accr[k] + ba))), ig = 1.0f / (1.0f + expf(-(acci[k] + bxx)));
                            const float la = -8.0f * r * sp; const float a = expf(la); float mult = sqrtf(-expm1f(2.0f * la));
                            if (!samp && seg == 0 && tt == 0) mult = 1.0f;
                            ar[k] = a; br[k] = mult * ig * xc[tt * 64 + e]; }
                    }
                    if (!samp) {
                        float h = 0.f, P = 1.f; float hl[8], pp[8];
#pragma unroll
                        for (int k = 0; k < 8; ++k) { h = ar[k] * h + br[k]; P *= ar[k]; hl[k] = h; pp[k] = P; }
                        SA[wave * 64 + e] = P; SH[wave * 64 + e] = h;
                        __syncthreads();
                        float Hin = 0.f, Ain = 1.f;
                        for (int q = 0; q < wave; ++q) { const float a_ = SA[q * 64 + e]; Hin = a_ * Hin + SH[q * 64 + e]; Ain *= a_; }
#pragma unroll
                        for (int k = 0; k < 8; ++k) { hl[k] += pp[k] * Hin; pp[k] *= Ain; const size_t o = (size_t)(row0 + wave * 8 + k) * DR + ch; HL[o] = hl[k]; PP[o] = pp[k]; }
                        if (wave == 7) { SEGA[(size_t)(b * NSEG + seg) * DR + ch] = pp[7]; SEGH[(size_t)(b * NSEG + seg) * DR + ch] = hl[7]; }
                        if (seg == NSEG - 1 && wave < 3) out[O_CP + ((size_t)b * 3 + wave) * DR + ch] = xs[(64 + wave) * 64 + e];
                    } else {
#pragma unroll
                        for (int bq = 0; bq < 2; ++bq) { const int bb = wave * 2 + bq, bg = b0 + bb; float h = args.in[I_SH][(size_t)bg * DR + ch];
#pragma unroll
                            for (int t = 0; t < 4; ++t) { const int k = bq * 4 + t; h = ar[k] * h + br[k]; const size_t row = (size_t)NP + bg * 4 + t;
                                const float gr = bf2f(PROJ[row * INC + DR + ch]); YAB[row * DM + ch] = (bf16_t)f2bf(h * gelu_tanh(gr)); }
                            out[O_HS + (size_t)bg * DR + ch] = h;
#pragma unroll
                            for (int j = 0; j < 3; ++j) out[O_CS + ((size_t)bg * 3 + j) * DR + ch] = xs[(bb * 7 + 4 + j) * 64 + e]; }
                    }
                }
            }
            __syncthreads();
            {
                LAS float* vn = (LAS float*)lds;
                LAS float* wt = (LAS float*)(lds + 65536);
                LAS float* st = (LAS float*)(lds + 131072);
                const float* lg = args.in[I_GLNG]; const float* lb = args.in[I_GLNB];
                for (int it = bx; it < 512; it += G) {
                    const int g = it & 7, c = (it >> 3) & 15, b = it >> 7, row0 = b * SEQ + c * 128;
                    __syncthreads();
                    for (int k = 0; k < 16; ++k) { const int tt = wave * 16 + k; const bf16_t* gvp = PROJ + (size_t)(row0 + tt) * INC + 3072;
                        const u32x4 p0 = *(const u32x4*)(gvp + lane * 8), p1 = *(const u32x4*)(gvp + 512 + lane * 8); float xv[16];
#pragma unroll
                        for (int q = 0; q < 4; ++q) { xv[2 * q] = bflo(p0[q]); xv[2 * q + 1] = bfhi(p0[q]); xv[8 + 2 * q] = bflo(p1[q]); xv[8 + 2 * q + 1] = bfhi(p1[q]); }
                        float s = 0.f;
#pragma unroll
                        for (int q = 0; q < 16; ++q) s += xv[q];
                        const float mean = wave_sum(s) * (1.0f / DR); float qq = 0.f;
#pragma unroll
                        for (int q = 0; q < 16; ++q) { const float d = xv[q] - mean; qq += d * d; }
                        const float rstd = 1.0f / sqrtf(wave_sum(qq) * (1.0f / DR) + LN_EPS);
                        if (lane == 0) { st[tt * 2] = mean; st[tt * 2 + 1] = rstd; } }
                    for (int i = tid; i < 128 * 128; i += 512) { const int t = i >> 7, s = i & 127; wt[i] = s <= t ? args.in[I_GWS][(size_t)g * 16384 + i] : 0.f; }
                    __syncthreads();
                    { const int d = tid & 127, chn = g * 128 + d; const float gg = lg[chn], bbv = lb[chn];
                        for (int i = 0; i < 32; ++i) { const int s = (tid >> 7) + 4 * i; const float x = bf2f(PROJ[(size_t)(row0 + s) * INC + 3072 + chn]); vn[s * 128 + d] = (x - st[s * 2]) * st[s * 2 + 1] * gg + bbv; } }
                    __syncthreads();
                    { const int d = tid & 127, tq = tid >> 7, chn = g * 128 + d;
                        for (int i = 0; i < 32; ++i) { const int t = tq + 4 * i; float acc = args.in[I_GBS][g * 128 + t];
                            const int s4n = (t >> 2) + 1;
                            for (int s4 = 0; s4 < s4n; ++s4) { const f32x4 w = *(const LAS f32x4*)(wt + t * 128 + s4 * 4);
                                acc += w[0] * vn[(s4 * 4 + 0) * 128 + d] + w[1] * vn[(s4 * 4 + 1) * 128 + d] + w[2] * vn[(s4 * 4 + 2) * 128 + d] + w[3] * vn[(s4 * 4 + 3) * 128 + d]; }
                            const size_t row = (size_t)(row0 + t); const float gu = bf2f(PROJ[row * INC + 2048 + chn]);
                            YAB[row * DM + DR + chn] = (bf16_t)f2bf(gu * acc); } }
                }
            }
            for (int bg = gw; bg < 128; bg += NGW) {
                float vnv[4][16];
#pragma unroll
                for (int t = 0; t < 4; ++t) { const bf16_t* gvp = PROJ + (size_t)(NP + bg * 4 + t) * INC + 3072;
                    const u32x4 p0 = *(const u32x4*)(gvp + lane * 8), p1 = *(const u32x4*)(gvp + 512 + lane * 8);
#pragma unroll
                    for (int q = 0; q < 4; ++q) { vnv[t][2 * q] = bflo(p0[q]); vnv[t][2 * q + 1] = bfhi(p0[q]); vnv[t][8 + 2 * q] = bflo(p1[q]); vnv[t][8 + 2 * q + 1] = bfhi(p1[q]); }
                    float s = 0.f;
#pragma unroll
                    for (int q = 0; q < 16; ++q) s += vnv[t][q];
                    const float mean = wave_sum(s) * (1.0f / DR); float qq = 0.f;
#pragma unroll
                    for (int q = 0; q < 16; ++q) { const float d = vnv[t][q] - mean; qq += d * d; }
                    const float rstd = 1.0f / sqrtf(wave_sum(qq) * (1.0f / DR) + LN_EPS);
#pragma unroll
                    for (int q = 0; q < 16; ++q) { const int chn = (q >> 3) * 512 + lane * 8 + (q & 7); vnv[t][q] = (vnv[t][q] - mean) * rstd * args.in[I_GLNG][chn] + args.in[I_GLNB][chn]; }
                    float* vo = out + O_VS + (size_t)(bg * 4 + t) * DR;
#pragma unroll
                    for (int j = 0; j < 2; ++j) { *(f32x4*)(vo + j * 512 + lane * 8) = (f32x4){vnv[t][j * 8 + 0], vnv[t][j * 8 + 1], vnv[t][j * 8 + 2], vnv[t][j * 8 + 3]};
                        *(f32x4*)(vo + j * 512 + lane * 8 + 4) = (f32x4){vnv[t][j * 8 + 4], vnv[t][j * 8 + 5], vnv[t][j * 8 + 6], vnv[t][j * 8 + 7]}; }
                }
#pragma unroll
                for (int j = 0; j < 2; ++j) { const int g = (lane >> 4) + 4 * j; const float* wg = args.in[I_GWS] + (size_t)g * 16384; const float* bsg = args.in[I_GBS] + g * 128;
#pragma unroll
                    for (int t = 0; t < 4; ++t) { const size_t row = (size_t)NP + bg * 4 + t; const u32x4 gu = *(const u32x4*)(PROJ + row * INC + 2048 + j * 512 + lane * 8); float o[8];
#pragma unroll
                        for (int q = 0; q < 8; ++q) { float acc = bsg[t];
#pragma unroll
                            for (int s = 0; s < 4; ++s) if (s <= t) acc += wg[t * 128 + s] * vnv[s][j * 8 + q];
                            const float guv = (q & 1) ? bfhi(gu[q >> 1]) : bflo(gu[q >> 1]); o[q] = guv * acc; }
                        u32x4 w; w.x = pk2(o[0], o[1]); w.y = pk2(o[2], o[3]); w.z = pk2(o[4], o[5]); w.w = pk2(o[6], o[7]);
                        *(u32x4*)(YAB + row * DM + DR + j * 512 + lane * 8) = w; } }
            }
        }
        if constexpr (KIND == 8) {
            const bf16_t* PROJ = HP;
            for (int it = bx; it < 256; it += G) {
                const int half = it & 1, seg = (it >> 1) & 31, b = it >> 6, ch = tid * 2;
                f32x2 h = (f32x2){0.f, 0.f};
                for (int s = 0; s < seg; ++s) { const f32x2 a = *(const f32x2*)(SEGA + (size_t)(b * NSEG + s) * DR + ch), hh = *(const f32x2*)(SEGH + (size_t)(b * NSEG + s) * DR + ch); h = a * h + hh; }
#pragma unroll 4
                for (int k = 0; k < 32; ++k) { const int tt = half * 32 + k; const size_t row = (size_t)b * SEQ + seg * SEGL + tt;
                    const f32x2 hl = *(const f32x2*)(HL + row * DR + ch), pp = *(const f32x2*)(PP + row * DR + ch); const f32x2 y = hl + pp * h;
                    const unsigned gr = *(const unsigned*)(PROJ + row * INC + DR + ch);
                    *(unsigned*)(YAB + row * DM + ch) = pk2(y[0] * gelu_tanh(bflo(gr)), y[1] * gelu_tanh(bfhi(gr)));
                    if (seg == NSEG - 1 && tt == SEGL - 1) *(f32x2*)(out + O_HP + (size_t)b * DR + ch) = y; }
            }
        }
        if constexpr (KIND == 9) {
            pg8::Gemm g{YAB, WPAB, MR, DM, DM, DM, DM}; pg8::StaticOrder S; S.init(MR, DM, G, bx);
            pg8::EpiMerge E{HP, U};
            pg8::gemm_phase<pg8::EpiMerge, pg8::StaticOrder>(lds, g, S, E);
        }
}

__global__ void __launch_bounds__(NWAVES * 64, 2) fwd(Args args) {
    extern __shared__ __attribute__((aligned(16))) unsigned char lds_raw[];
    LAS unsigned char* lds = (LAS unsigned char*)lds_raw;
    cg::grid_group grid = cg::this_grid();
    for (int ph = args.ph_lo; ph < args.ph_hi; ++ph) {
        switch (ph) {
        case 0: phase_body<0>(args, ph, lds); break;
        case 1: phase_body<1>(args, ph, lds); break;
        case 2: phase_body<2>(args, ph, lds); break;
        case 3: case 12: phase_body<3>(args, ph, lds); break;
        case 4: case 10: case 13: phase_body<4>(args, ph, lds); break;
        case 5: case 11: case 14: phase_body<5>(args, ph, lds); break;
        case 6: phase_body<6>(args, ph, lds); break;
        case 7: phase_body<7>(args, ph, lds); break;
        case 8: phase_body<8>(args, ph, lds); break;
        case 9: phase_body<9>(args, ph, lds); break;
        default: break;
        }
        if (ph + 1 < args.ph_hi) grid.sync();
    }
}


#ifdef DIAG_KINDS
template <int KIND> __global__ void __launch_bounds__(NWAVES * 64, 2) diag(Args args) {
    extern __shared__ __attribute__((aligned(16))) unsigned char lds_raw[];
    phase_body<KIND>(args, args.ph_lo, (LAS unsigned char*)lds_raw);
}
template __global__ void diag<0>(Args); template __global__ void diag<1>(Args); template __global__ void diag<2>(Args); template __global__ void diag<3>(Args); template __global__ void diag<4>(Args);
template __global__ void diag<5>(Args); template __global__ void diag<6>(Args); template __global__ void diag<7>(Args); template __global__ void diag<8>(Args); template __global__ void diag<9>(Args);
#endif
extern "C" void kernel_launch(void* const* d_in, const int* in_sizes, int n_in, void* d_out, int out_size, void* d_ws, size_t ws_size, hipStream_t stream) {
    static int grid = 0;
    if (grid == 0) {
        if (n_in != 29 || ws_size < WS_END) { fprintf(stderr, "kernel_launch: need 29 inputs and %zu bytes of ws; got %d, %zu\n", (size_t)WS_END, n_in, ws_size); grid = -1; return; }
        int dev = 0, cus = 0, per_cu = 0;
        hipGetDevice(&dev); hipDeviceGetAttribute(&cus, hipDeviceAttributeMultiprocessorCount, dev);
        if (hipFuncSetAttribute((const void*)fwd, hipFuncAttributeMaxDynamicSharedMemorySize, LDS_BYTES) != hipSuccess) { fprintf(stderr, "kernel_launch: hipFuncSetAttribute failed\n"); grid = -1; return; }
        if (hipOccupancyMaxActiveBlocksPerMultiprocessor(&per_cu, (const void*)fwd, NWAVES * 64, LDS_BYTES) != hipSuccess || per_cu < 1) { fprintf(stderr, "kernel_launch: occupancy query says %d\n", per_cu); per_cu = 1; }
        (void)hipGetLastError();
        grid = cus;
    }
    if (grid < 0) return;
    Args a{};
    for (int i = 0; i < 29; ++i) a.in[i] = (const float*)d_in[i];
    a.out = (float*)d_out; a.ws = (unsigned char*)d_ws;
#if ONE_LAUNCH
    a.ph_lo = 0; a.ph_hi = NPHASE;
    { void* kargs[] = {&a}; hipError_t e = hipLaunchCooperativeKernel((const void*)fwd, dim3(grid), dim3(NWAVES * 64), kargs, LDS_BYTES, stream);
      if (e != hipSuccess) fprintf(stderr, "cooperative launch failed: %s (grid %d)\n", hipGetErrorString(e), grid); }
#else
    for (int ph = 0; ph < NPHASE; ++ph) { a.ph_lo = ph; a.ph_hi = ph + 1; void* kargs[] = {&a};
        hipError_t e = hipLaunchCooperativeKernel((const void*)fwd, dim3(grid), dim3(NWAVES * 64), kargs, LDS_BYTES, stream);
        if (e != hipSuccess) { fprintf(stderr, "cooperative launch %d failed: %s (grid %d)\n", ph, hipGetErrorString(e), grid); break; } }
#endif
}
```

```cpp
#include <hip/hip_runtime.h>
#include <hip/hip_cooperative_groups.h>
#include <cstdio>
#include <cstdint>
namespace cg = cooperative_groups;

#define REPEAT_PH -1
#ifndef ONE_LAUNCH
#define ONE_LAUNCH 1
#endif

#define LAS __attribute__((address_space(3)))
typedef unsigned short bf16_t;
typedef short bf16x8 __attribute__((ext_vector_type(8)));
typedef float f32x4 __attribute__((ext_vector_type(4)));
typedef float f32x2 __attribute__((ext_vector_type(2)));
typedef unsigned u32x4 __attribute__((ext_vector_type(4)));
typedef unsigned u32x2 __attribute__((ext_vector_type(2)));

constexpr int DM = 2048, NP = 8192, NS = 512, MR = NP + NS, DFF = 5632, DR = 1024, INC = 8192, NMOD = 9 * DM;
constexpr int SEQ = 2048, NSEG = 32, SEGL = 64;
constexpr float ALPHA = 1.189207115002721f;
constexpr float LN_EPS = 1e-5f;
constexpr int NWAVES = 8;

constexpr size_t MiB = 1u << 20;
constexpr size_t OFF_W1GU = 1 * MiB, OFF_W1D = 45 * MiB, OFF_W2GU = 67 * MiB, OFF_W2D = 111 * MiB, OFF_WIN = 133 * MiB, OFF_WPAB = 165 * MiB, OFF_WOUT = 173 * MiB;
constexpr size_t OFF_SC = 182 * MiB, OFF_MOD = 183 * MiB, OFF_U = 201 * MiB, OFF_YAB = 235 * MiB, OFF_X = 269 * MiB, OFF_HP = 337 * MiB, OFF_WADA = 473 * MiB;
constexpr size_t OFF_HL = OFF_WADA, OFF_PP = OFF_WADA + 32 * MiB, OFF_SEG = OFF_WADA + 64 * MiB, WS_END = 545 * MiB;

constexpr size_t O_Y = 0, O_CP = 17825792, O_HP = 17838080, O_CS = 17842176, O_HS = 18235392, O_VS = 18366464;

constexpr int LDS_BYTES = 131072 + 1024;

__device__ __forceinline__ unsigned f2bf(float f) { unsigned u = __builtin_bit_cast(unsigned, f); return (u + 0x7fffu + ((u >> 16) & 1u)) >> 16; }
__device__ __forceinline__ unsigned pk2(float lo, float hi) { return f2bf(lo) | (f2bf(hi) << 16); }
__device__ __forceinline__ float bflo(unsigned w) { return __builtin_bit_cast(float, w << 16); }
__device__ __forceinline__ float bfhi(unsigned w) { return __builtin_bit_cast(float, w & 0xffff0000u); }
__device__ __forceinline__ float bf2f(bf16_t b) { return __builtin_bit_cast(float, ((unsigned)b) << 16); }
__device__ __forceinline__ float wave_sum(float v) {
#pragma unroll
    for (int o = 1; o < 64; o <<= 1) v += __shfl_xor(v, o);
    return v;
}
__device__ __forceinline__ float sigmoid_fast(float x) { return __builtin_amdgcn_rcpf(1.0f + __expf(-x)); }
__device__ __forceinline__ float gelu_tanh(float x) { const float z = 0.7978845608028654f * (x + 0.044715f * x * x * x); return x * sigmoid_fast(2.0f * z); }
__device__ __forceinline__ int modrow(int r) { return r < NP ? (r >> 11) : 4 + ((r - NP) >> 2); }
#define LDS_WAIT() asm volatile("s_waitcnt lgkmcnt(0)" ::: "memory")

namespace pg8 {
constexpr int BM = 256, BK = 64, HALF = 128, HTB = HALF * BK * 2, STAGE_BYTES = 8 * HTB, NXCD = 8, WGM = 8;
__host__ __device__ __forceinline__ int lds_byte(int r, int c) { const int st = (r >> 4) * 2 + (c >> 5), rr = r & 15, cc = c & 31, ob = rr * 64 + cc * 2; return st * 1024 + (ob ^ (((ob >> 9) & 1) << 5)); }
__host__ __device__ __forceinline__ void stage_rc(int b, int& R, int& C) { const int st = b / 1024, sb = b % 1024, swz = sb ^ (((sb >> 9) & 1) << 5); R = (st >> 1) * 16 + swz / 64; C = (st & 1) * 32 + (swz % 64) / 2; }
__host__ __device__ __forceinline__ int perm32(int rho) { const int n = rho >> 4, i = rho & 15; return 8 * (i >> 2) + 4 * n + (i & 3); }

struct Unit { const char* a; const char* b; int nt, pm, pn, ks; };
struct Gemm { int lda, ldb; };

struct TileSched {
    const char* A; const char* Bt; size_t tA, tB;
    int nM, nN, nt, nwg, G, c, s_pm0, s_nM, s_splits, s_nt;
    __device__ void init(const bf16_t* A_, const bf16_t* Bt_, int lda, int ldb, int M, int N, int K, int G_, int c_) {
        A = (const char*)A_; Bt = (const char*)Bt_; tA = (size_t)BM * lda * 2; tB = (size_t)BM * ldb * 2; nM = M / BM; nN = N / BM; nt = K / BK; nwg = nM * nN; G = G_; c = c_; s_pm0 = 0; s_nM = 0; s_splits = 0; s_nt = 0; }
    __device__ bool next(int i, Unit& u) const {
        long L = (long)i * G + c;
        if (L < nwg) {
            int wgid = (int)L; { const int q = nwg / NXCD, r = nwg % NXCD, xcd = wgid % NXCD, off = wgid / NXCD; wgid = (xcd < r ? xcd * (q + 1) : r * (q + 1) + (xcd - r) * q) + off; }
            const int nig = WGM * nN, gid = wgid / nig, fm = gid * WGM, gsz = (nM - fm) < WGM ? (nM - fm) : WGM;
            u.pm = fm + ((wgid % nig) % gsz); u.pn = (wgid % nig) / gsz; u.nt = nt; u.ks = -1;
            u.a = A + (size_t)u.pm * tA; u.b = Bt + (size_t)u.pn * tB; return true; }
        L -= nwg; const int per = s_nM * nN;
        if (L >= (long)per * s_splits) return false;
        const int ks = (int)L / per, rem = (int)L % per;
        u.pm = s_pm0 + rem % s_nM; u.pn = rem / s_nM; u.nt = s_nt; u.ks = ks;
        u.a = A + (size_t)u.pm * tA + (size_t)ks * s_nt * (BK * 2); u.b = Bt + (size_t)u.pn * tB + (size_t)ks * s_nt * (BK * 2); return true;
    }
};

__device__ __forceinline__ unsigned cvt_pk_bf16(float lo, float hi) { unsigned r; asm volatile("v_cvt_pk_bf16_f32 %0, %1, %2" : "=v"(r) : "v"(lo), "v"(hi)); return r; }

struct EpiF32 {
    static constexpr bool PERM = false, HAS_MID = false;
    float* C; int ldc; const float* bias;
    __device__ __forceinline__ void mid(f32x4 (&acc)[2][2][4][2], const Unit& u, int wr, int wc, int fr, int fq) const {}
    __device__ __forceinline__ void operator()(const f32x4 (&acc)[2][2][4][2], const Unit& u, int wr, int wc, int fr, int fq) const {
        const int row0 = u.pm * BM + wr * 64 + fr, col0 = u.pn * BM + wc * 32 + 4 * fq;
        f32x4 bv[2][2];
#pragma unroll
        for (int bj = 0; bj < 2; ++bj)
#pragma unroll
            for (int n = 0; n < 2; ++n) bv[bj][n] = *(const f32x4*)(bias + col0 + bj * HALF + n * 16);
#pragma unroll
        for (int ai = 0; ai < 2; ++ai)
#pragma unroll
            for (int m = 0; m < 4; ++m) { float* rowp = C + (size_t)(row0 + ai * HALF + m * 16) * ldc + col0;
#pragma unroll
                for (int bj = 0; bj < 2; ++bj)
#pragma unroll
                    for (int n = 0; n < 2; ++n) *(f32x4*)(rowp + bj * HALF + n * 16) = acc[ai][bj][m][n] + bv[bj][n]; }
    }
};
struct EpiBf16 {
    static constexpr bool PERM = true, HAS_MID = false;
    bf16_t* O; int ldc;
    __device__ __forceinline__ void mid(f32x4 (&acc)[2][2][4][2], const Unit& u, int wr, int wc, int fr, int fq) const {}
    __device__ __forceinline__ void operator()(const f32x4 (&acc)[2][2][4][2], const Unit& u, int wr, int wc, int fr, int fq) const {
        const int row0 = u.pm * BM + wr * 64 + fr, col0 = u.pn * BM + wc * 32 + 8 * fq;
#pragma unroll
        for (int ai = 0; ai < 2; ++ai)
#pragma unroll
            for (int m = 0; m < 4; ++m) { bf16_t* rowp = O + (size_t)(row0 + ai * HALF + m * 16) * ldc + col0;
#pragma unroll
                for (int bj = 0; bj < 2; ++bj) { const f32x4 v0 = acc[ai][bj][m][0], v1 = acc[ai][bj][m][1];
                    u32x4 w; w.x = cvt_pk_bf16(v0[0], v0[1]); w.y = cvt_pk_bf16(v0[2], v0[3]); w.z = cvt_pk_bf16(v1[0], v1[1]); w.w = cvt_pk_bf16(v1[2], v1[3]);
                    *(u32x4*)(rowp + bj * HALF) = w; } }
    }
};
struct EpiSwiglu {
    static constexpr bool PERM = true, HAS_MID = false;
    bf16_t* H;
    __device__ __forceinline__ void mid(f32x4 (&acc)[2][2][4][2], const Unit& u, int wr, int wc, int fr, int fq) const {}
    __device__ __forceinline__ void operator()(const f32x4 (&acc)[2][2][4][2], const Unit& u, int wr, int wc, int fr, int fq) const {
        const int row0 = u.pm * BM + wr * 64 + fr, col0 = u.pn * HALF + wc * 32 + 8 * fq;
#pragma unroll
        for (int ai = 0; ai < 2; ++ai)
#pragma unroll
            for (int m = 0; m < 4; ++m) { bf16_t* rowp = H + (size_t)(row0 + ai * HALF + m * 16) * DFF + col0;
                float o[8];
#pragma unroll
                for (int n = 0; n < 2; ++n)
#pragma unroll
                    for (int j = 0; j < 4; ++j) { const float g = acc[ai][0][m][n][j], v = acc[ai][1][m][n][j]; o[n * 4 + j] = g * sigmoid_fast(g) * v; }
                u32x4 w; w.x = cvt_pk_bf16(o[0], o[1]); w.y = cvt_pk_bf16(o[2], o[3]); w.z = cvt_pk_bf16(o[4], o[5]); w.w = cvt_pk_bf16(o[6], o[7]);
                *(u32x4*)rowp = w; }
    }
};
struct EpiResid {
    static constexpr bool PERM = false, HAS_MID = false;
    const float* xp; const float* xs; float* X; const float* MOD; int gk; float coef; float* PART;
    __device__ __forceinline__ void mid(f32x4 (&acc)[2][2][4][2], const Unit& u, int wr, int wc, int fr, int fq) const {}
    __device__ __forceinline__ void operator()(const f32x4 (&acc)[2][2][4][2], const Unit& u, int wr, int wc, int fr, int fq) const {
        const int row0 = u.pm * BM + wr * 64 + fr, col0 = u.pn * BM + wc * 32 + 4 * fq;
        if (u.ks >= 0) {
#pragma unroll
            for (int ai = 0; ai < 2; ++ai)
#pragma unroll
                for (int m = 0; m < 4; ++m) { float* orow = PART + ((size_t)u.ks * NS + (row0 + ai * HALF + m * 16 - NP)) * DM + col0;
#pragma unroll
                    for (int bj = 0; bj < 2; ++bj)
#pragma unroll
                        for (int n = 0; n < 2; ++n) *(f32x4*)(orow + bj * HALF + n * 16) = acc[ai][bj][m][n]; }
            return; }
        const bool samp = u.pm >= NP / BM;
        f32x4 gv[2][2];
        if (!samp) { const float* md = MOD + (size_t)(u.pm >> 3) * NMOD + gk * DM + col0;
#pragma unroll
            for (int bj = 0; bj < 2; ++bj)
#pragma unroll
                for (int n = 0; n < 2; ++n) gv[bj][n] = *(const f32x4*)(md + bj * HALF + n * 16) * coef; }
#pragma unroll
        for (int ai = 0; ai < 2; ++ai)
#pragma unroll
            for (int m = 0; m < 4; ++m) { const int row = row0 + ai * HALF + m * 16;
                const float* xrow = (samp ? xs + (size_t)(row - NP) * DM : xp + (size_t)row * DM) + col0;
                if (samp) { const float* md = MOD + (size_t)(4 + ((row - NP) >> 2)) * NMOD + gk * DM + col0;
#pragma unroll
                    for (int bj = 0; bj < 2; ++bj)
#pragma unroll
                        for (int n = 0; n < 2; ++n) gv[bj][n] = *(const f32x4*)(md + bj * HALF + n * 16) * coef; }
                float* orow = X + (size_t)row * DM + col0;
#pragma unroll
                for (int bj = 0; bj < 2; ++bj)
#pragma unroll
                    for (int n = 0; n < 2; ++n) { const f32x4 xv = *(const f32x4*)(xrow + bj * HALF + n * 16); *(f32x4*)(orow + bj * HALF + n * 16) = xv * ALPHA + gv[bj][n] * acc[ai][bj][m][n]; }
                asm volatile("" ::: "memory"); }
    }
};
struct EpiMerge {
    static constexpr bool PERM = true, HAS_MID = true;
    const bf16_t* PROJ; bf16_t* O;
    __device__ __forceinline__ void mid(f32x4 (&acc)[2][2][4][2], const Unit& u, int wr, int wc, int fr, int fq) const {
        unsigned off = (unsigned)((u.pm * BM + wr * 64 + fr) * INC + u.pn * BM + wc * 32 + 8 * fq) * 2u;
        asm volatile("" : "+v"(off));
        const char* base = (const char*)PROJ;
#pragma unroll
        for (int ai = 0; ai < 2; ++ai) {
#pragma unroll
            for (int m = 0; m < 4; ++m) { const unsigned ro = off + (unsigned)((ai * HALF + m * 16) * INC * 2);
#pragma unroll
                for (int bj = 0; bj < 2; ++bj) { const u32x4 a = *(const u32x4*)(base + ro + (4096 + bj * HALF) * 2), b = *(const u32x4*)(base + ro + (6144 + bj * HALF) * 2);
#pragma unroll
                    for (int q = 0; q < 4; ++q) { const float a0 = fminf(fmaxf(bflo(a[q]), -30.f), 30.f), a1 = fminf(fmaxf(bfhi(a[q]), -30.f), 30.f), b0 = fminf(fmaxf(bflo(b[q]), -30.f), 30.f), b1 = fminf(fmaxf(bfhi(b[q]), -30.f), 30.f);
                        const float r0 = (1.0f + __expf(-b0)) * __builtin_amdgcn_rcpf(1.0f + __expf(-a0)), r1 = (1.0f + __expf(-b1)) * __builtin_amdgcn_rcpf(1.0f + __expf(-a1));
                        acc[ai][bj][m][q >> 1][(q & 1) * 2] *= r0; acc[ai][bj][m][q >> 1][(q & 1) * 2 + 1] *= r1; } } }
            asm volatile("" ::: "memory"); }
    }
    __device__ __forceinline__ void operator()(const f32x4 (&acc)[2][2][4][2], const Unit& u, int wr, int wc, int fr, int fq) const {
        const int row0 = u.pm * BM + wr * 64 + fr, col0 = u.pn * BM + wc * 32 + 8 * fq;
#pragma unroll
        for (int ai = 0; ai < 2; ++ai)
#pragma unroll
            for (int m = 0; m < 4; ++m) { const size_t row = (size_t)(row0 + ai * HALF + m * 16); const bf16_t* pr = PROJ + row * INC + 6144 + col0; bf16_t* orow = O + row * DM + col0;
#pragma unroll
                for (int bj = 0; bj < 2; ++bj) { const u32x4 b = *(const u32x4*)(pr + bj * HALF); u32x4 w;
#pragma unroll
                    for (int q = 0; q < 4; ++q) { const float b0 = fminf(fmaxf(bflo(b[q]), -30.f), 30.f), b1 = fminf(fmaxf(bfhi(b[q]), -30.f), 30.f);
                        w[q] = cvt_pk_bf16(acc[ai][bj][m][q >> 1][(q & 1) * 2] * sigmoid_fast(b0), acc[ai][bj][m][q >> 1][(q & 1) * 2 + 1] * sigmoid_fast(b1)); }
                    *(u32x4*)(orow + bj * HALF) = w; }
                asm volatile("" ::: "memory"); }
    }
};

template <class Epi, class Sched>
__device__ __forceinline__ void gemm_phase(LAS unsigned char* lds, const Gemm g, const Sched& S, const Epi& E) {
    int tid_ = threadIdx.x; asm volatile("" : "+v"(tid_));
    const int tid = tid_, wid = __builtin_amdgcn_readfirstlane(tid >> 6), lane = tid & 63, wr = wid >> 2, wc = wid & 3, fr = lane & 15, fq = lane >> 4;
    unsigned voffA[2], voffB[2];
#pragma unroll
    for (int i = 0; i < 2; ++i) { int R, C; stage_rc(tid * 16 + i * 8192, R, C); const int Rb = Epi::PERM ? ((R & ~31) + perm32(R & 31)) : R;
        voffA[i] = (unsigned)(R * g.lda + C) * 2u; voffB[i] = (unsigned)(Rb * g.ldb + C) * 2u; }
    const size_t kstep = (size_t)(BK * 2);
    const size_t hA = (size_t)HALF * g.lda * 2, hB = (size_t)HALF * g.ldb * 2;
    const unsigned ldsw = (unsigned)wid * 1024u;
    const int aoff = lds_byte(wr * 64 + fr, fq * 8), boff = lds_byte(wc * 32 + fr, fq * 8);
#define PG8_SA(b, h) (((b) * 2 + (h)) * HTB)
#define PG8_SB(b, h) ((4 + (b) * 2 + (h)) * HTB)
#define PG8_STAGE(bufoff, gbase, voff) do { _Pragma("unroll") for (int _i = 0; _i < 2; ++_i) \
        __builtin_amdgcn_global_load_lds((const unsigned*)((const char*)(gbase) + (voff)[_i]), (LAS unsigned*)(lds + (bufoff) + ldsw + _i * 8192), 16, 0, 0); } while (0)
#define PG8_LDA(dst, b, h) do { _Pragma("unroll") for (int m = 0; m < 4; ++m) _Pragma("unroll") for (int k = 0; k < 2; ++k) dst[m][k] = *(const LAS bf16x8*)(lds + PG8_SA(b, h) + aoff + m * 2048 + k * 1024); } while (0)
#define PG8_LDB(dst, b, h) do { _Pragma("unroll") for (int n = 0; n < 2; ++n) _Pragma("unroll") for (int k = 0; k < 2; ++k) dst[n][k] = *(const LAS bf16x8*)(lds + PG8_SB(b, h) + boff + n * 2048 + k * 1024); } while (0)
#define PG8_MMA(ai, bj, At, Bt) do { __builtin_amdgcn_s_setprio(1); _Pragma("unroll") for (int m = 0; m < 4; ++m) _Pragma("unroll") for (int n = 0; n < 2; ++n) _Pragma("unroll") for (int k = 0; k < 2; ++k) \
        acc[ai][bj][m][n] = __builtin_amdgcn_mfma_f32_16x16x32_bf16(Bt[n][k], At[m][k], acc[ai][bj][m][n], 0, 0, 0); __builtin_amdgcn_s_setprio(0); } while (0)
#define PG8_WAIT_V(n) asm volatile("s_waitcnt vmcnt(" #n ")" ::: "memory")
#define PG8_WAIT_L(n) asm volatile("s_waitcnt lgkmcnt(" #n ")" ::: "memory")
#define PG8_BAR __builtin_amdgcn_s_barrier()
#define PG8_SCHED __builtin_amdgcn_sched_barrier(0)
    Unit cur, nxt; int ui = 0;
    if (!S.next(0, cur)) return;
    f32x4 acc[2][2][4][2];
#pragma unroll
    for (int a = 0; a < 2; ++a)
#pragma unroll
        for (int b = 0; b < 2; ++b)
#pragma unroll
            for (int m = 0; m < 4; ++m)
#pragma unroll
                for (int n = 0; n < 2; ++n) acc[a][b][m][n] = (f32x4){0.f, 0.f, 0.f, 0.f};
    bf16x8 At[4][2], B0[2][2], B1[2][2];
    const char* cA = cur.a; const char* cB = cur.b;
    PG8_STAGE(PG8_SB(0, 0), cB, voffB); PG8_STAGE(PG8_SB(0, 1), cB + hB, voffB); PG8_STAGE(PG8_SA(0, 0), cA, voffA); PG8_STAGE(PG8_SA(0, 1), cA + hA, voffA);
    if (wr == 1) PG8_BAR;
    PG8_WAIT_V(2); PG8_BAR;
    PG8_STAGE(PG8_SB(1, 0), cB + kstep, voffB); PG8_STAGE(PG8_SA(1, 0), cA + kstep, voffA); PG8_STAGE(PG8_SB(1, 1), cB + hB + kstep, voffB);
    PG8_WAIT_V(6); PG8_BAR;
    for (;;) {
        const bool has_next = S.next(ui + 1, nxt);
        const char* nA = has_next ? nxt.a : cA; const char* nB = has_next ? nxt.b : cB;
        const int nt = cur.nt, tmid = nt >> 1;
        for (int t = 0; t < nt; t += 2) {
            const bool last = (t == nt - 2);
            const char* a1 = cA + (size_t)(t + 1) * kstep;
            const char* a2 = last ? nA : cA + (size_t)(t + 2) * kstep; const char* b2 = last ? nB : cB + (size_t)(t + 2) * kstep;
            const char* a3 = a2 + kstep; const char* b3 = b2 + kstep;
            if constexpr (Epi::HAS_MID) { if (t == tmid) E.mid(acc, cur, wr, wc, fr, fq); }
            PG8_LDB(B0, 0, 0); PG8_LDB(B1, 0, 1); PG8_SCHED; PG8_LDA(At, 0, 0); PG8_STAGE(PG8_SA(1, 1), a1 + hA, voffA);
            PG8_WAIT_V(8); PG8_WAIT_L(0); PG8_BAR; PG8_MMA(0, 0, At, B0); PG8_MMA(0, 1, At, B1); PG8_BAR; PG8_SCHED;
            PG8_LDA(At, 0, 1); PG8_STAGE(PG8_SB(0, 0), b2, voffB); PG8_STAGE(PG8_SB(0, 1), b2 + hB, voffB); PG8_STAGE(PG8_SA(0, 0), a2, voffA);
            PG8_WAIT_V(8); PG8_WAIT_L(0); PG8_BAR; PG8_MMA(1, 0, At, B0); PG8_MMA(1, 1, At, B1); PG8_BAR; PG8_SCHED;
            PG8_LDB(B0, 1, 0); PG8_LDB(B1, 1, 1); PG8_SCHED; PG8_LDA(At, 1, 0); PG8_STAGE(PG8_SA(0, 1), a2 + hA, voffA);
            PG8_WAIT_V(8); PG8_WAIT_L(0); PG8_BAR; PG8_MMA(0, 0, At, B0); PG8_MMA(0, 1, At, B1); PG8_BAR; PG8_SCHED;
            PG8_LDA(At, 1, 1); PG8_STAGE(PG8_SB(1, 0), b3, voffB); PG8_STAGE(PG8_SB(1, 1), b3 + hB, voffB); PG8_STAGE(PG8_SA(1, 0), a3, voffA);
            PG8_WAIT_V(8); PG8_WAIT_L(0); PG8_BAR; PG8_MMA(1, 0, At, B0); PG8_MMA(1, 1, At, B1); PG8_BAR; PG8_SCHED;
        }
        if (wr == 0) PG8_BAR;
        E(acc, cur, wr, wc, fr, fq);
        if (!has_next) break;
#pragma unroll
        for (int a = 0; a < 2; ++a)
#pragma unroll
            for (int b = 0; b < 2; ++b)
#pragma unroll
                for (int m = 0; m < 4; ++m)
#pragma unroll
                    for (int n = 0; n < 2; ++n) acc[a][b][m][n] = (f32x4){0.f, 0.f, 0.f, 0.f};
        cur = nxt; cA = nA; cB = nB; ++ui;
        if (wr == 1) PG8_BAR;
    }
    PG8_WAIT_V(0);
    PG8_BAR;
#undef PG8_SA
#undef PG8_SB
#undef PG8_STAGE
#undef PG8_LDA
#undef PG8_LDB
#undef PG8_MMA
#undef PG8_WAIT_V
#undef PG8_WAIT_L
#undef PG8_BAR
#undef PG8_SCHED
}
}

struct Args { const float* in[29]; float* out; unsigned char* ws; int ph_lo, ph_hi; };
enum { I_XP = 0, I_XS, I_SCONV, I_SH, I_CP, I_CS, I_WADA, I_BADA, I_F1GU, I_F1D, I_F2GU, I_F2D, I_WIN, I_CONVW, I_CONVB, I_LWA, I_LBA, I_LWX, I_LBX, I_LAM, I_GLNG, I_GLNB, I_GWS, I_GBS, I_WPA, I_WPB, I_WOUT, I_LNG, I_LNB };
constexpr int NPHASE = 15;

__device__ __forceinline__ void transpose_item(const float* W, int N, bf16_t* WT, int ldd, int koff, int mode, LAS float* scr, int item, int lane) {
    const int nblk = N / 32, kb = item / nblk, nb = item % nblk, k0 = 64 * kb, n0 = 32 * nb;
#pragma unroll 8
    for (int i = 0; i < 32; ++i) { const int kk = 2 * i + (lane >> 5); scr[kk * 33 + (lane & 31)] = W[(size_t)(k0 + kk) * N + n0 + (lane & 31)]; }
    LDS_WAIT(); asm volatile("" ::: "memory");
    int d0 = n0;
    if (mode == 1) { const int half = n0 >= DFF ? 1 : 0, jj = n0 - half * DFF; d0 = 256 * (jj >> 7) + 128 * half + (jj & 127); }
    const int c = lane & 7;
#pragma unroll
    for (int j = 0; j < 4; ++j) { const int n = (lane >> 3) + 8 * j; const LAS float* s = scr + (8 * c) * 33 + n;
        u32x4 o; o.x = pk2(s[0 * 33], s[1 * 33]); o.y = pk2(s[2 * 33], s[3 * 33]); o.z = pk2(s[4 * 33], s[5 * 33]); o.w = pk2(s[6 * 33], s[7 * 33]);
        *(u32x4*)(WT + (size_t)(d0 + n) * ldd + koff + k0 + 8 * c) = o; }
    LDS_WAIT(); asm volatile("" ::: "memory");
}

template <int KIND> __device__ __forceinline__ void phase_body(const Args& args, const int ph, LAS unsigned char* lds) {

    int tid_ = threadIdx.x; asm volatile("" : "+v"(tid_));
    const int tid = tid_, lane = tid & 63, wave = __builtin_amdgcn_readfirstlane(tid >> 6);
    int bx_ = blockIdx.x; asm volatile("" : "+s"(bx_));
    const int G = gridDim.x, bx = bx_;
    const int gw = bx * NWAVES + wave, NGW = G * NWAVES;
    unsigned char* ws = args.ws; asm volatile("" : "+s"(ws));
    bf16_t* W1GU = (bf16_t*)(ws + OFF_W1GU); bf16_t* W1D = (bf16_t*)(ws + OFF_W1D); bf16_t* W2GU = (bf16_t*)(ws + OFF_W2GU); bf16_t* W2D = (bf16_t*)(ws + OFF_W2D);
    bf16_t* WIN = (bf16_t*)(ws + OFF_WIN); bf16_t* WPAB = (bf16_t*)(ws + OFF_WPAB); bf16_t* WOUT = (bf16_t*)(ws + OFF_WOUT); bf16_t* WADA = (bf16_t*)(ws + OFF_WADA);
    bf16_t* SC = (bf16_t*)(ws + OFF_SC); float* MOD = (float*)(ws + OFF_MOD); bf16_t* U = (bf16_t*)(ws + OFF_U); bf16_t* YAB = (bf16_t*)(ws + OFF_YAB);
    float* X = (float*)(ws + OFF_X); bf16_t* HP = (bf16_t*)(ws + OFF_HP); float* HL = (float*)(ws + OFF_HL); float* PP = (float*)(ws + OFF_PP);
    float* SEGA = (float*)(ws + OFF_SEG); float* SEGH = SEGA + 4 * NSEG * DR;
    float* out = args.out;

        if constexpr (KIND == 0) {
            LAS float* scr = (LAS float*)(lds + wave * 16384);
            constexpr int I_ADA = 32 * (NMOD / 32), I_GU = 32 * (2 * DFF / 32), I_D = (DFF / 64) * (DM / 32), I_IN = 32 * (INC / 32), I_PA = (DR / 64) * (DM / 32), I_OUT = 32 * (DM / 32);
            constexpr int NIT = I_ADA + 2 * I_GU + 2 * I_D + I_IN + 2 * I_PA + I_OUT;
            for (int it = gw; it < NIT; it += NGW) {
                int r = it;
                if (r < I_ADA) { transpose_item(args.in[I_WADA], NMOD, WADA, DM, 0, 0, scr, r, lane); continue; } r -= I_ADA;
                if (r < I_GU) { transpose_item(args.in[I_F1GU], 2 * DFF, W1GU, DM, 0, 1, scr, r, lane); continue; } r -= I_GU;
                if (r < I_D) { transpose_item(args.in[I_F1D], DM, W1D, DFF, 0, 0, scr, r, lane); continue; } r -= I_D;
                if (r < I_IN) { transpose_item(args.in[I_WIN], INC, WIN, DM, 0, 0, scr, r, lane); continue; } r -= I_IN;
                if (r < I_PA) { transpose_item(args.in[I_WPA], DM, WPAB, DM, 0, 0, scr, r, lane); continue; } r -= I_PA;
                if (r < I_PA) { transpose_item(args.in[I_WPB], DM, WPAB, DM, DR, 0, scr, r, lane); continue; } r -= I_PA;
                if (r < I_OUT) { transpose_item(args.in[I_WOUT], DM, WOUT, DM, 0, 0, scr, r, lane); continue; } r -= I_OUT;
                if (r < I_GU) { transpose_item(args.in[I_F2GU], 2 * DFF, W2GU, DM, 0, 1, scr, r, lane); continue; } r -= I_GU;
                transpose_item(args.in[I_F2D], DM, W2D, DFF, 0, 0, scr, r, lane);
            }
            for (int i = bx * 512 + tid; i < 256 * DM / 2; i += G * 512) { const int row = i / (DM / 2), c2 = (i % (DM / 2)) * 2;
                float v0 = 0.f, v1 = 0.f;
                if (row < 132) { const float* cp = row < 4 ? args.in[I_CP] + (size_t)row * DM : args.in[I_CS] + (size_t)(row - 4) * DM; const float a = cp[c2], b = cp[c2 + 1]; v0 = a / (1.0f + expf(-a)); v1 = b / (1.0f + expf(-b)); }
                ((unsigned*)SC)[i] = pk2(v0, v1); }
        }
        if constexpr (KIND == 1) {
            pg8::Gemm g{DM, DM}; pg8::TileSched S; S.init(SC, WADA, DM, DM, 256, NMOD, DM, G, bx);
            pg8::EpiF32 E{MOD, NMOD, args.in[I_BADA]};
            pg8::gemm_phase<pg8::EpiF32, pg8::TileSched>(lds, g, S, E);
        }
        if constexpr (KIND == 2) {
            for (int r = gw; r < MR; r += NGW) {
                const float* xr = r < NP ? args.in[I_XP] + (size_t)r * DM : args.in[I_XS] + (size_t)(r - NP) * DM;
                const float* md = MOD + (size_t)modrow(r) * NMOD;
#pragma unroll
                for (int j = 0; j < 8; ++j) { const int c = lane * 4 + 256 * j; const f32x4 x = *(const f32x4*)(xr + c), sh = *(const f32x4*)(md + c), sc = *(const f32x4*)(md + DM + c);
                    const f32x4 u = x * (1.0f + sc) + sh; u32x2 w; w.x = pk2(u[0], u[1]); w.y = pk2(u[2], u[3]); *(u32x2*)(U + (size_t)r * DM + c) = w; }
            }
        }
        if constexpr (KIND == 3) {
            pg8::Gemm g{DM, DM}; pg8::TileSched S; S.init(U, ph == 3 ? W1GU : W2GU, DM, DM, MR, 2 * DFF, DM, G, bx);
            pg8::EpiSwiglu E{HP};
            pg8::gemm_phase<pg8::EpiSwiglu, pg8::TileSched>(lds, g, S, E);
        }
        if constexpr (KIND == 4) {
            const int Kd = ph == 10 ? DM : DFF;
            pg8::Gemm g{Kd, Kd}; pg8::TileSched S; S.init(ph == 10 ? U : HP, ph == 4 ? W1D : (ph == 10 ? WOUT : W2D), Kd, Kd, NP, DM, Kd, G, bx);
            S.s_pm0 = NP / 256; S.s_nM = NS / 256; S.s_splits = ph == 10 ? 8 : 11; S.s_nt = ph == 10 ? 4 : 8;
            pg8::EpiResid E{ph == 4 ? args.in[I_XP] : X, ph == 4 ? args.in[I_XS] : X + (size_t)NP * DM, X, MOD, ph == 4 ? 2 : (ph == 10 ? 5 : 8), ph == 10 ? 1.0f : 0.5f, (float*)(ws + OFF_WADA)};
            pg8::gemm_phase<pg8::EpiResid, pg8::TileSched>(lds, g, S, E);
        }
        if constexpr (KIND == 5) {
            const int li = ph == 5 ? 0 : (ph == 11 ? 1 : 2);
            const float* lg = args.in[I_LNG] + li * DM; const float* lb = args.in[I_LNB] + li * DM;
            float* dst = ph == 14 ? out + O_Y : X;
            for (int r = gw; r < MR; r += NGW) {
                const float* xr = X + (size_t)r * DM; f32x4 v[8]; float s = 0.f;
                if (r < NP) {
#pragma unroll
                    for (int j = 0; j < 8; ++j) v[j] = *(const f32x4*)(xr + lane * 4 + 256 * j);
                } else {
                    const float* xsrc = li == 0 ? args.in[I_XS] + (size_t)(r - NP) * DM : xr;
                    const float* gt = MOD + (size_t)modrow(r) * NMOD + (3 * li + 2) * DM; const float coef = li == 1 ? 1.0f : 0.5f; const int nsl = li == 1 ? 8 : 11;
                    const float* pt = (const float*)(ws + OFF_WADA) + (size_t)(r - NP) * DM;
#pragma unroll
                    for (int j = 0; j < 8; ++j) { const int c = lane * 4 + 256 * j; f32x4 a = *(const f32x4*)(pt + c);
                        for (int k = 1; k < nsl; ++k) a += *(const f32x4*)(pt + (size_t)k * NS * DM + c);
                        v[j] = *(const f32x4*)(xsrc + c) * ALPHA + *(const f32x4*)(gt + c) * coef * a; }
                }
#pragma unroll
                for (int j = 0; j < 8; ++j) s += (v[j][0] + v[j][1]) + (v[j][2] + v[j][3]);
                const float mean = wave_sum(s) * (1.0f / DM); float q = 0.f;
#pragma unroll
                for (int j = 0; j < 8; ++j) { v[j] = v[j] - mean; q += (v[j][0] * v[j][0] + v[j][1] * v[j][1]) + (v[j][2] * v[j][2] + v[j][3] * v[j][3]); }
                const float rstd = 1.0f / sqrtf(wave_sum(q) * (1.0f / DM) + LN_EPS);
                const float* md = MOD + (size_t)modrow(r) * NMOD + (3 * (li + 1)) * DM;
#pragma unroll
                for (int j = 0; j < 8; ++j) { const int c = lane * 4 + 256 * j; const f32x4 y = v[j] * rstd * *(const f32x4*)(lg + c) + *(const f32x4*)(lb + c);
                    *(f32x4*)(dst + (size_t)r * DM + c) = y;
                    if (ph != 14) { const f32x4 sh = *(const f32x4*)(md + c), sc = *(const f32x4*)(md + DM + c); const f32x4 u = y * (1.0f + sc) + sh; u32x2 w; w.x = pk2(u[0], u[1]); w.y = pk2(u[2], u[3]); *(u32x2*)(U + (size_t)r * DM + c) = w; } }
            }
        }
        if constexpr (KIND == 6) {
            pg8::Gemm g{DM, DM}; pg8::TileSched S; S.init(U, WIN, DM, DM, MR, INC, DM, G, bx);
            pg8::EpiBf16 E{HP, INC};
            pg8::gemm_phase<pg8::EpiBf16, pg8::TileSched>(lds, g, S, E);
        }
        if constexpr (KIND == 7) {
            const bf16_t* PROJ = HP;
            {
                LAS float* xs = (LAS float*)lds;
                LAS float* xc = (LAS float*)(lds + 28672);
                LAS float* SA = (LAS float*)(lds + 45056);
                LAS float* SH = (LAS float*)(lds + 47104);
                const float* cw = args.in[I_CONVW]; const float* cb = args.in[I_CONVB];
                for (int it = bx; it < 2048 + 128; it += G) {
                    const bool samp = it >= 2048;
                    const int n = it & 15, e = lane, ch = n * 64 + e;
                    int b = 0, seg = 0, row0 = 0, b0 = 0;
                    if (!samp) { b = it >> 9; seg = (it >> 4) & 31; row0 = b * SEQ + seg * SEGL; } else { b0 = ((it - 2048) >> 4) * 16; row0 = NP + b0 * 4; }
                    __syncthreads();
                    if (!samp) {
                        for (int i = tid; i < 67 * 64; i += 512) { const int j = i >> 6, c = i & 63; float v = 0.f; if (seg > 0 || j >= 3) v = bf2f(PROJ[(size_t)(row0 + j - 3) * INC + n * 64 + c]); xs[i] = v; }
                    } else {
                        for (int i = tid; i < 112 * 64; i += 512) { const int rr = i >> 6, c = i & 63, bb = rr / 7, j = rr - bb * 7; float v;
                            if (j < 3) v = args.in[I_SCONV][((size_t)(b0 + bb) * 3 + j) * DR + n * 64 + c]; else v = bf2f(PROJ[(size_t)(NP + (b0 + bb) * 4 + (j - 3)) * INC + n * 64 + c]);
                            xs[i] = v; }
                    }
                    __syncthreads();
                    {
                        const float w0 = cw[0 * DR + ch], w1 = cw[1 * DR + ch], w2 = cw[2 * DR + ch], w3 = cw[3 * DR + ch], bb_ = cb[ch];
#pragma unroll
                        for (int i = 0; i < 8; ++i) { const int tt = wave + 8 * i; const int base = samp ? ((tt >> 2) * 7 + (tt & 3)) : tt;
                            xc[tt * 64 + e] = bb_ + w0 * xs[(base + 0) * 64 + e] + w1 * xs[(base + 1) * 64 + e] + w2 * xs[(base + 2) * 64 + e] + w3 * xs[(base + 3) * 64 + e]; }
                    }
                    __syncthreads();
                    float ar[8], br[8];
                    {
                        float accr[8], acci[8];
#pragma unroll
                        for (int k = 0; k < 8; ++k) { accr[k] = 0.f; acci[k] = 0.f; }
                        const float* wa = args.in[I_LWA] + (size_t)n * 4096 + e; const float* wx = args.in[I_LWX] + (size_t)n * 4096 + e;
#pragma unroll 2
                        for (int d4 = 0; d4 < 16; ++d4) {
                            float wav[4], wxv[4];
#pragma unroll
                            for (int q = 0; q < 4; ++q) { wav[q] = wa[(d4 * 4 + q) * 64]; wxv[q] = wx[(d4 * 4 + q) * 64]; }
#pragma unroll
                            for (int k = 0; k < 8; ++k) { const f32x4 xv = *(const LAS f32x4*)(xc + (wave * 8 + k) * 64 + d4 * 4);
#pragma unroll
                                for (int q = 0; q < 4; ++q) { accr[k] += xv[q] * wav[q]; acci[k] += xv[q] * wxv[q]; } }
                        }
                        const float ba = args.in[I_LBA][ch], bxx = args.in[I_LBX][ch], lam = args.in[I_LAM][ch];
                        const float sp = log1pf(expf(-lam));
#pragma unroll
                        for (int k = 0; k < 8; ++k) { const int tt = wave * 8 + k;
                            const float r = 1.0f / (1.0f + expf(-(accr[k] + ba))), ig = 1.0f / (1.0f + expf(-(acci[k] + bxx)));
                            const float la = -8.0f * r * sp; const float a = expf(la); float mult = sqrtf(-expm1f(2.0f * la));
                            if (!samp && seg == 0 && tt == 0) mult = 1.0f;
                            ar[k] = a; br[k] = mult * ig * xc[tt * 64 + e]; }
                    }
                    if (!samp) {
                        float h = 0.f, P = 1.f; float hl[8], pp[8];
#pragma unroll
                        for (int k = 0; k < 8; ++k) { h = ar[k] * h + br[k]; P *= ar[k]; hl[k] = h; pp[k] = P; }
                        SA[wave * 64 + e] = P; SH[wave * 64 + e] = h;
                        __syncthreads();
                        float Hin = 0.f, Ain = 1.f;
                        for (int q = 0; q < wave; ++q) { const float a_ = SA[q * 64 + e]; Hin = a_ * Hin + SH[q * 64 + e]; Ain *= a_; }
#pragma unroll
                        for (int k = 0; k < 8; ++k) { hl[k] += pp[k] * Hin; pp[k] *= Ain; const size_t o = (size_t)(row0 + wave * 8 + k) * DR + ch; HL[o] = hl[k]; PP[o] = pp[k]; }
                        if (wave == 7) { SEGA[(size_t)(b * NSEG + seg) * DR + ch] = pp[7]; SEGH[(size_t)(b * NSEG + seg) * DR + ch] = hl[7]; }
                        if (seg == NSEG - 1 && wave < 3) out[O_CP + ((size_t)b * 3 + wave) * DR + ch] = xs[(64 + wave) * 64 + e];
                    } else {
#pragma unroll
                        for (int bq = 0; bq < 2; ++bq) { const int bb = wave * 2 + bq, bg = b0 + bb; float h = args.in[I_SH][(size_t)bg * DR + ch];
#pragma unroll
                            for (int t = 0; t < 4; ++t) { const int k = bq * 4 + t; h = ar[k] * h + br[k]; const size_t row = (size_t)NP + bg * 4 + t;
                                const float gr = bf2f(PROJ[row * INC + DR + ch]); YAB[row * DM + ch] = (bf16_t)f2bf(h * gelu_tanh(gr)); }
                            out[O_HS + (size_t)bg * DR + ch] = h;
#pragma unroll
                            for (int j = 0; j < 3; ++j) out[O_CS + ((size_t)bg * 3 + j) * DR + ch] = xs[(bb * 7 + 4 + j) * 64 + e]; }
                    }
                }
            }
            __syncthreads();
            {
                LAS float* vn = (LAS float*)lds;
                LAS float* wt = (LAS float*)(lds + 65536);
                LAS float* st = (LAS float*)(lds + 131072);
                const float* lg = args.in[I_GLNG]; const float* lb = args.in[I_GLNB];
                for (int it = bx; it < 512; it += G) {
                    const int g = it & 7, c = (it >> 3) & 15, b = it >> 7, row0 = b * SEQ + c * 128;
                    __syncthreads();
                    for (int k = 0; k < 16; ++k) { const int tt = wave * 16 + k; const bf16_t* gvp = PROJ + (size_t)(row0 + tt) * INC + 3072;
                        const u32x4 p0 = *(const u32x4*)(gvp + lane * 8), p1 = *(const u32x4*)(gvp + 512 + lane * 8); float xv[16];
#pragma unroll
                        for (int q = 0; q < 4; ++q) { xv[2 * q] = bflo(p0[q]); xv[2 * q + 1] = bfhi(p0[q]); xv[8 + 2 * q] = bflo(p1[q]); xv[8 + 2 * q + 1] = bfhi(p1[q]); }
                        float s = 0.f;
#pragma unroll
                        for (int q = 0; q < 16; ++q) s += xv[q];
                        const float mean = wave_sum(s) * (1.0f / DR); float qq = 0.f;
#pragma unroll
                        for (int q = 0; q < 16; ++q) { const float d = xv[q] - mean; qq += d * d; }
                        const float rstd = 1.0f / sqrtf(wave_sum(qq) * (1.0f / DR) + LN_EPS);
                        if (lane == 0) { st[tt * 2] = mean; st[tt * 2 + 1] = rstd; } }
                    for (int i = tid; i < 128 * 128; i += 512) { const int t = i >> 7, s = i & 127; wt[i] = s <= t ? args.in[I_GWS][(size_t)g * 16384 + i] : 0.f; }
                    __syncthreads();
                    { const int d = tid & 127, chn = g * 128 + d; const float gg = lg[chn], bbv = lb[chn];
                        for (int i = 0; i < 32; ++i) { const int s = (tid >> 7) + 4 * i; const float x = bf2f(PROJ[(size_t)(row0 + s) * INC + 3072 + chn]); vn[s * 128 + d] = (x - st[s * 2]) * st[s * 2 + 1] * gg + bbv; } }
                    __syncthreads();
                    { const int d = tid & 127, tq = tid >> 7, chn = g * 128 + d;
                        for (int i = 0; i < 32; ++i) { const int t = tq + 4 * i; float acc = args.in[I_GBS][g * 128 + t];
                            const int s4n = (t >> 2) + 1;
                            for (int s4 = 0; s4 < s4n; ++s4) { const f32x4 w = *(const LAS f32x4*)(wt + t * 128 + s4 * 4);
                                acc += w[0] * vn[(s4 * 4 + 0) * 128 + d] + w[1] * vn[(s4 * 4 + 1) * 128 + d] + w[2] * vn[(s4 * 4 + 2) * 128 + d] + w[3] * vn[(s4 * 4 + 3) * 128 + d]; }
                            const size_t row = (size_t)(row0 + t); const float gu = bf2f(PROJ[row * INC + 2048 + chn]);
                            YAB[row * DM + DR + chn] = (bf16_t)f2bf(gu * acc); } }
                }
            }
            for (int bg = gw; bg < 128; bg += NGW) {
                float vnv[4][16];
#pragma unroll
                for (int t = 0; t < 4; ++t) { const bf16_t* gvp = PROJ + (size_t)(NP + bg * 4 + t) * INC + 3072;
                    const u32x4 p0 = *(const u32x4*)(gvp + lane * 8), p1 = *(const u32x4*)(gvp + 512 + lane * 8);
#pragma unroll
                    for (int q = 0; q < 4; ++q) { vnv[t][2 * q] = bflo(p0[q]); vnv[t][2 * q + 1] = bfhi(p0[q]); vnv[t][8 + 2 * q] = bflo(p1[q]); vnv[t][8 + 2 * q + 1] = bfhi(p1[q]); }
                    float s = 0.f;
#pragma unroll
                    for (int q = 0; q < 16; ++q) s += vnv[t][q];
                    const float mean = wave_sum(s) * (1.0f / DR); float qq = 0.f;
#pragma unroll
                    for (int q = 0; q < 16; ++q) { const float d = vnv[t][q] - mean; qq += d * d; }
                    const float rstd = 1.0f / sqrtf(wave_sum(qq) * (1.0f / DR) + LN_EPS);
#pragma unroll
                    for (int q = 0; q < 16; ++q) { const int chn = (q >> 3) * 512 + lane * 8 + (q & 7); vnv[t][q] = (vnv[t][q] - mean) * rstd * args.in[I_GLNG][chn] + args.in[I_GLNB][chn]; }
                    float* vo = out + O_VS + (size_t)(bg * 4 + t) * DR;
#pragma unroll
                    for (int j = 0; j < 2; ++j) { *(f32x4*)(vo + j * 512 + lane * 8) = (f32x4){vnv[t][j * 8 + 0], vnv[t][j * 8 + 1], vnv[t][j * 8 + 2], vnv[t][j * 8 + 3]};
                        *(f32x4*)(vo + j * 512 + lane * 8 + 4) = (f32x4){vnv[t][j * 8 + 4], vnv[t][j * 8 + 5], vnv[t][j * 8 + 6], vnv[t][j * 8 + 7]}; }
                }
#pragma unroll
                for (int j = 0; j < 2; ++j) { const int g = (lane >> 4) + 4 * j; const float* wg = args.in[I_GWS] + (size_t)g * 16384; const float* bsg = args.in[I_GBS] + g * 128;
#pragma unroll
                    for (int t = 0; t < 4; ++t) { const size_t row = (size_t)NP + bg * 4 + t; const u32x4 gu = *(const u32x4*)(PROJ + row * INC + 2048 + j * 512 + lane * 8); float o[8];
#pragma unroll
                        for (int q = 0; q < 8; ++q) { float acc = bsg[t];
#pragma unroll
                            for (int s = 0; s < 4; ++s) if (s <= t) acc += wg[t * 128 + s] * vnv[s][j * 8 + q];
                            const float guv = (q & 1) ? bfhi(gu[q >> 1]) : bflo(gu[q >> 1]); o[q] = guv * acc; }
                        u32x4 w; w.x = pk2(o[0], o[1]); w.y = pk2(o[2], o[3]); w.z = pk2(o[4], o[5]); w.w = pk2(o[6], o[7]);
                        *(u32x4*)(YAB + row * DM + DR + j * 512 + lane * 8) = w; } }
            }
        }
        if constexpr (KIND == 8) {
            const bf16_t* PROJ = HP;
            for (int it = bx; it < 256; it += G) {
                const int half = it & 1, seg = (it >> 1) & 31, b = it >> 6, ch = tid * 2;
                f32x2 h = (f32x2){0.f, 0.f};
                for (int s = 0; s < seg; ++s) { const f32x2 a = *(const f32x2*)(SEGA + (size_t)(b * NSEG + s) * DR + ch), hh = *(const f32x2*)(SEGH + (size_t)(b * NSEG + s) * DR + ch); h = a * h + hh; }
#pragma unroll 4
                for (int k = 0; k < 32; ++k) { const int tt = half * 32 + k; const size_t row = (size_t)b * SEQ + seg * SEGL + tt;
                    const f32x2 hl = *(const f32x2*)(HL + row * DR + ch), pp = *(const f32x2*)(PP + row * DR + ch); const f32x2 y = hl + pp * h;
                    const unsigned gr = *(const unsigned*)(PROJ + row * INC + DR + ch);
                    *(unsigned*)(YAB + row * DM + ch) = pk2(y[0] * gelu_tanh(bflo(gr)), y[1] * gelu_tanh(bfhi(gr)));
                    if (seg == NSEG - 1 && tt == SEGL - 1) *(f32x2*)(out + O_HP + (size_t)b * DR + ch) = y; }
            }
        }
        if constexpr (KIND == 9) {
            pg8::Gemm g{DM, DM}; pg8::TileSched S; S.init(YAB, WPAB, DM, DM, MR, DM, DM, G, bx);
            pg8::EpiMerge E{HP, U};
            pg8::gemm_phase<pg8::EpiMerge, pg8::TileSched>(lds, g, S, E);
        }
}

__global__ void __launch_bounds__(NWAVES * 64, 2) fwd(Args args) {
    extern __shared__ __attribute__((aligned(16))) unsigned char lds_raw[];
    LAS unsigned char* lds = (LAS unsigned char*)lds_raw;
    cg::grid_group grid = cg::this_grid();
    for (int ph_ = args.ph_lo; ph_ < args.ph_hi + (REPEAT_PH >= 0 ? 1 : 0); ++ph_) {
        const int ph = (REPEAT_PH >= 0 && ph_ > REPEAT_PH) ? ph_ - 1 : ph_;
        switch (ph) {
        case 0: phase_body<0>(args, ph, lds); break;
        case 1: phase_body<1>(args, ph, lds); break;
        case 2: phase_body<2>(args, ph, lds); break;
        case 3: case 12: phase_body<3>(args, ph, lds); break;
        case 4: case 10: case 13: phase_body<4>(args, ph, lds); break;
        case 5: case 11: case 14: phase_body<5>(args, ph, lds); break;
        case 6: phase_body<6>(args, ph, lds); break;
        case 7: phase_body<7>(args, ph, lds); break;
        case 8: phase_body<8>(args, ph, lds); break;
        case 9: phase_body<9>(args, ph, lds); break;
        default: break;
        }
        if (ph_ + 1 < args.ph_hi + (REPEAT_PH >= 0 ? 1 : 0)) grid.sync();
    }
}


#ifdef DIAG_KINDS
template <int KIND> __global__ void __launch_bounds__(NWAVES * 64, 2) diag(Args args) {
    extern __shared__ __attribute__((aligned(16))) unsigned char lds_raw[];
    phase_body<KIND>(args, args.ph_lo, (LAS unsigned char*)lds_raw);
}
template __global__ void diag<0>(Args); template __global__ void diag<1>(Args); template __global__ void diag<2>(Args); template __global__ void diag<3>(Args); template __global__ void diag<4>(Args);
template __global__ void diag<5>(Args); template __global__ void diag<6>(Args); template __global__ void diag<7>(Args); template __global__ void diag<8>(Args); template __global__ void diag<9>(Args);
#endif
extern "C" void kernel_launch(void* const* d_in, const int* in_sizes, int n_in, void* d_out, int out_size, void* d_ws, size_t ws_size, hipStream_t stream) {
    static int grid = 0;
    if (grid == 0) {
        if (n_in != 29 || ws_size < WS_END) { fprintf(stderr, "kernel_launch: need 29 inputs and %zu bytes of ws; got %d, %zu\n", (size_t)WS_END, n_in, ws_size); grid = -1; return; }
        int dev = 0, cus = 0, per_cu = 0;
        hipGetDevice(&dev); hipDeviceGetAttribute(&cus, hipDeviceAttributeMultiprocessorCount, dev);
        if (hipFuncSetAttribute((const void*)fwd, hipFuncAttributeMaxDynamicSharedMemorySize, LDS_BYTES) != hipSuccess) { fprintf(stderr, "kernel_launch: hipFuncSetAttribute failed\n"); grid = -1; return; }
        if (hipOccupancyMaxActiveBlocksPerMultiprocessor(&per_cu, (const void*)fwd, NWAVES * 64, LDS_BYTES) != hipSuccess || per_cu < 1) { fprintf(stderr, "kernel_launch: occupancy query says %d\n", per_cu); per_cu = 1; }
        (void)hipGetLastError();
        grid = cus;
    }
    if (grid < 0) return;
    Args a{};
    for (int i = 0; i < 29; ++i) a.in[i] = (const float*)d_in[i];
    a.out = (float*)d_out; a.ws = (unsigned char*)d_ws;
#if ONE_LAUNCH
    a.ph_lo = 0; a.ph_hi = NPHASE;
    { void* kargs[] = {&a}; hipError_t e = hipLaunchCooperativeKernel((const void*)fwd, dim3(grid), dim3(NWAVES * 64), kargs, LDS_BYTES, stream);
      if (e != hipSuccess) fprintf(stderr, "cooperative launch failed: %s (grid %d)\n", hipGetErrorString(e), grid); }
#else
    for (int ph = 0; ph < NPHASE; ++ph) { a.ph_lo = ph; a.ph_hi = ph + 1; void* kargs[] = {&a};
        hipError_t e = hipLaunchCooperativeKernel((const void*)fwd, dim3(grid), dim3(NWAVES * 64), kargs, LDS_BYTES, stream);
        if (e != hipSuccess) { fprintf(stderr, "cooperative launch %d failed: %s (grid %d)\n", ph, hipGetErrorString(e), grid); break; } }
#endif
}
```

```cpp
#include <hip/hip_runtime.h>
#include <hip/hip_cooperative_groups.h>
#include <cstdio>
#include <cstdint>
namespace cg = cooperative_groups;

#define REPEAT_PH -1
#ifndef ONE_LAUNCH
#define ONE_LAUNCH 1
#endif

#define LAS __attribute__((address_space(3)))
typedef unsigned short bf16_t;
typedef short bf16x8 __attribute__((ext_vector_type(8)));
typedef float f32x4 __attribute__((ext_vector_type(4)));
typedef float f32x2 __attribute__((ext_vector_type(2)));
typedef unsigned u32x4 __attribute__((ext_vector_type(4)));
typedef unsigned u32x2 __attribute__((ext_vector_type(2)));

constexpr int DM = 2048, NP = 8192, NS = 512, MR = NP + NS, DFF = 5632, DR = 1024, INC = 8192, NMOD = 9 * DM;
constexpr int SEQ = 2048, NSEG = 32, SEGL = 64;
constexpr float ALPHA = 1.189207115002721f;
constexpr float LN_EPS = 1e-5f;
constexpr int NWAVES = 8;

constexpr size_t MiB = 1u << 20;
constexpr size_t OFF_W1GU = 1 * MiB, OFF_W1D = 45 * MiB, OFF_W2GU = 67 * MiB, OFF_W2D = 111 * MiB, OFF_WIN = 133 * MiB, OFF_WPAB = 165 * MiB, OFF_WOUT = 173 * MiB;
constexpr size_t OFF_WLRU = 181 * MiB, OFF_SC = 182 * MiB, OFF_MOD = 183 * MiB, OFF_U = 201 * MiB, OFF_YAB = 235 * MiB, OFF_X = 269 * MiB, OFF_HP = 337 * MiB, OFF_WADA = 473 * MiB;
constexpr size_t OFF_HL = OFF_WADA, OFF_PP = OFF_WADA + 32 * MiB, OFF_SEG = OFF_WADA + 64 * MiB, WS_END = 545 * MiB;

constexpr size_t O_Y = 0, O_CP = 17825792, O_HP = 17838080, O_CS = 17842176, O_HS = 18235392, O_VS = 18366464;

constexpr int LDS_BYTES = 131072 + 1024;

__device__ __forceinline__ unsigned f2bf(float f) { unsigned u = __builtin_bit_cast(unsigned, f); return (u + 0x7fffu + ((u >> 16) & 1u)) >> 16; }
__device__ __forceinline__ unsigned pk2(float lo, float hi) { return f2bf(lo) | (f2bf(hi) << 16); }
__device__ __forceinline__ float bflo(unsigned w) { return __builtin_bit_cast(float, w << 16); }
__device__ __forceinline__ float bfhi(unsigned w) { return __builtin_bit_cast(float, w & 0xffff0000u); }
__device__ __forceinline__ float bf2f(bf16_t b) { return __builtin_bit_cast(float, ((unsigned)b) << 16); }
__device__ __forceinline__ float wave_sum(float v) {
#pragma unroll
    for (int o = 1; o < 64; o <<= 1) v += __shfl_xor(v, o);
    return v;
}
__device__ __forceinline__ float sigmoid_fast(float x) { return __builtin_amdgcn_rcpf(1.0f + __expf(-x)); }
__device__ __forceinline__ float gelu_tanh(float x) { const float z = 0.7978845608028654f * (x + 0.044715f * x * x * x); return x * sigmoid_fast(2.0f * z); }
__device__ __forceinline__ int modrow(int r) { return r < NP ? (r >> 11) : 4 + ((r - NP) >> 2); }
#define LDS_WAIT() asm volatile("s_waitcnt lgkmcnt(0)" ::: "memory")

namespace pg8 {
constexpr int BM = 256, BK = 64, HALF = 128, HTB = HALF * BK * 2, STAGE_BYTES = 8 * HTB, NXCD = 8, WGM = 8;
__host__ __device__ __forceinline__ int lds_byte(int r, int c) { const int st = (r >> 4) * 2 + (c >> 5), rr = r & 15, cc = c & 31, ob = rr * 64 + cc * 2; return st * 1024 + (ob ^ (((ob >> 9) & 1) << 5)); }
__host__ __device__ __forceinline__ void stage_rc(int b, int& R, int& C) { const int st = b / 1024, sb = b % 1024, swz = sb ^ (((sb >> 9) & 1) << 5); R = (st >> 1) * 16 + swz / 64; C = (st & 1) * 32 + (swz % 64) / 2; }
__host__ __device__ __forceinline__ int perm32(int rho) { const int n = rho >> 4, i = rho & 15; return 8 * (i >> 2) + 4 * n + (i & 3); }

struct Unit { const char* a; const char* b; int nt, pm, pn, ks; };
struct Gemm { int lda, ldb; };

struct TileSched {
    const char* A; const char* Bt; size_t tA, tB;
    int nM, nN, nt, nwg, G, c, s_pm0, s_nM, s_splits, s_nt;
    __device__ void init(const bf16_t* A_, const bf16_t* Bt_, int lda, int ldb, int M, int N, int K, int G_, int c_) {
        A = (const char*)A_; Bt = (const char*)Bt_; tA = (size_t)BM * lda * 2; tB = (size_t)BM * ldb * 2; nM = M / BM; nN = N / BM; nt = K / BK; nwg = nM * nN; G = G_; c = c_; s_pm0 = 0; s_nM = 0; s_splits = 0; s_nt = 0; }
    __device__ bool next(int i, Unit& u) const {
        long L = (long)i * G + c;
        if (L < nwg) {
            int wgid = (int)L; { const int q = nwg / NXCD, r = nwg % NXCD, xcd = wgid % NXCD, off = wgid / NXCD; wgid = (xcd < r ? xcd * (q + 1) : r * (q + 1) + (xcd - r) * q) + off; }
            const int nig = WGM * nN, gid = wgid / nig, fm = gid * WGM, gsz = (nM - fm) < WGM ? (nM - fm) : WGM;
            u.pm = fm + ((wgid % nig) % gsz); u.pn = (wgid % nig) / gsz; u.nt = nt; u.ks = -1;
            u.a = A + (size_t)u.pm * tA; u.b = Bt + (size_t)u.pn * tB; return true; }
        L -= nwg; const int per = s_nM * nN;
        if (L >= (long)per * s_splits) return false;
        const int ks = (int)L / per, rem = (int)L % per;
        u.pm = s_pm0 + rem % s_nM; u.pn = rem / s_nM; u.nt = s_nt; u.ks = ks;
        u.a = A + (size_t)u.pm * tA + (size_t)ks * s_nt * (BK * 2); u.b = Bt + (size_t)u.pn * tB + (size_t)ks * s_nt * (BK * 2); return true;
    }
};

__device__ __forceinline__ unsigned cvt_pk_bf16(float lo, float hi) { unsigned r; asm volatile("v_cvt_pk_bf16_f32 %0, %1, %2" : "=v"(r) : "v"(lo), "v"(hi)); return r; }

struct EpiF32 {
    static constexpr bool PERM = false, HAS_MID = false;
    float* C; int ldc; const float* bias;
    __device__ __forceinline__ void mid(f32x4 (&acc)[2][2][4][2], const Unit& u, int wr, int wc, int fr, int fq) const {}
    __device__ __forceinline__ void operator()(const f32x4 (&acc)[2][2][4][2], const Unit& u, int wr, int wc, int fr, int fq) const {
        const int row0 = u.pm * BM + wr * 64 + fr, col0 = u.pn * BM + wc * 32 + 4 * fq;
        f32x4 bv[2][2];
#pragma unroll
        for (int bj = 0; bj < 2; ++bj)
#pragma unroll
            for (int n = 0; n < 2; ++n) bv[bj][n] = *(const f32x4*)(bias + col0 + bj * HALF + n * 16);
#pragma unroll
        for (int ai = 0; ai < 2; ++ai)
#pragma unroll
            for (int m = 0; m < 4; ++m) { float* rowp = C + (size_t)(row0 + ai * HALF + m * 16) * ldc + col0;
#pragma unroll
                for (int bj = 0; bj < 2; ++bj)
#pragma unroll
                    for (int n = 0; n < 2; ++n) *(f32x4*)(rowp + bj * HALF + n * 16) = acc[ai][bj][m][n] + bv[bj][n]; }
    }
};
struct EpiBf16 {
    static constexpr bool PERM = true, HAS_MID = false;
    bf16_t* O; int ldc;
    __device__ __forceinline__ void mid(f32x4 (&acc)[2][2][4][2], const Unit& u, int wr, int wc, int fr, int fq) const {}
    __device__ __forceinline__ void operator()(const f32x4 (&acc)[2][2][4][2], const Unit& u, int wr, int wc, int fr, int fq) const {
        const int row0 = u.pm * BM + wr * 64 + fr, col0 = u.pn * BM + wc * 32 + 8 * fq;
#pragma unroll
        for (int ai = 0; ai < 2; ++ai)
#pragma unroll
            for (int m = 0; m < 4; ++m) { bf16_t* rowp = O + (size_t)(row0 + ai * HALF + m * 16) * ldc + col0;
#pragma unroll
                for (int bj = 0; bj < 2; ++bj) { const f32x4 v0 = acc[ai][bj][m][0], v1 = acc[ai][bj][m][1];
                    u32x4 w; w.x = cvt_pk_bf16(v0[0], v0[1]); w.y = cvt_pk_bf16(v0[2], v0[3]); w.z = cvt_pk_bf16(v1[0], v1[1]); w.w = cvt_pk_bf16(v1[2], v1[3]);
                    *(u32x4*)(rowp + bj * HALF) = w; } }
    }
};
struct EpiSwiglu {
    static constexpr bool PERM = true, HAS_MID = false;
    bf16_t* H;
    __device__ __forceinline__ void mid(f32x4 (&acc)[2][2][4][2], const Unit& u, int wr, int wc, int fr, int fq) const {}
    __device__ __forceinline__ void operator()(const f32x4 (&acc)[2][2][4][2], const Unit& u, int wr, int wc, int fr, int fq) const {
        const int row0 = u.pm * BM + wr * 64 + fr, col0 = u.pn * HALF + wc * 32 + 8 * fq;
#pragma unroll
        for (int ai = 0; ai < 2; ++ai)
#pragma unroll
            for (int m = 0; m < 4; ++m) { bf16_t* rowp = H + (size_t)(row0 + ai * HALF + m * 16) * DFF + col0;
                float o[8];
#pragma unroll
                for (int n = 0; n < 2; ++n)
#pragma unroll
                    for (int j = 0; j < 4; ++j) { const float g = acc[ai][0][m][n][j], v = acc[ai][1][m][n][j]; o[n * 4 + j] = g * sigmoid_fast(g) * v; }
                u32x4 w; w.x = cvt_pk_bf16(o[0], o[1]); w.y = cvt_pk_bf16(o[2], o[3]); w.z = cvt_pk_bf16(o[4], o[5]); w.w = cvt_pk_bf16(o[6], o[7]);
                *(u32x4*)rowp = w; }
    }
};
struct EpiResid {
    static constexpr bool PERM = false, HAS_MID = false;
    const float* xp; const float* xs; float* X; const float* MOD; int gk; float coef; float* PART;
    __device__ __forceinline__ void mid(f32x4 (&acc)[2][2][4][2], const Unit& u, int wr, int wc, int fr, int fq) const {}
    __device__ __forceinline__ void operator()(const f32x4 (&acc)[2][2][4][2], const Unit& u, int wr, int wc, int fr, int fq) const {
        const int row0 = u.pm * BM + wr * 64 + fr, col0 = u.pn * BM + wc * 32 + 4 * fq;
        if (u.ks >= 0) {
#pragma unroll
            for (int ai = 0; ai < 2; ++ai)
#pragma unroll
                for (int m = 0; m < 4; ++m) { float* orow = PART + ((size_t)u.ks * NS + (row0 + ai * HALF + m * 16 - NP)) * DM + col0;
#pragma unroll
                    for (int bj = 0; bj < 2; ++bj)
#pragma unroll
                        for (int n = 0; n < 2; ++n) *(f32x4*)(orow + bj * HALF + n * 16) = acc[ai][bj][m][n]; }
            return; }
        const bool samp = u.pm >= NP / BM;
        f32x4 gv[2][2];
        if (!samp) { const float* md = MOD + (size_t)(u.pm >> 3) * NMOD + gk * DM + col0;
#pragma unroll
            for (int bj = 0; bj < 2; ++bj)
#pragma unroll
                for (int n = 0; n < 2; ++n) gv[bj][n] = *(const f32x4*)(md + bj * HALF + n * 16) * coef; }
#pragma unroll
        for (int ai = 0; ai < 2; ++ai)
#pragma unroll
            for (int m = 0; m < 4; ++m) { const int row = row0 + ai * HALF + m * 16;
                const float* xrow = (samp ? xs + (size_t)(row - NP) * DM : xp + (size_t)row * DM) + col0;
                if (samp) { const float* md = MOD + (size_t)(4 + ((row - NP) >> 2)) * NMOD + gk * DM + col0;
#pragma unroll
                    for (int bj = 0; bj < 2; ++bj)
#pragma unroll
                        for (int n = 0; n < 2; ++n) gv[bj][n] = *(const f32x4*)(md + bj * HALF + n * 16) * coef; }
                float* orow = X + (size_t)row * DM + col0;
#pragma unroll
                for (int bj = 0; bj < 2; ++bj)
#pragma unroll
                    for (int n = 0; n < 2; ++n) { const f32x4 xv = *(const f32x4*)(xrow + bj * HALF + n * 16); *(f32x4*)(orow + bj * HALF + n * 16) = xv * ALPHA + gv[bj][n] * acc[ai][bj][m][n]; }
                asm volatile("" ::: "memory"); }
    }
};
struct EpiMerge {
    static constexpr bool PERM = true, HAS_MID = true;
    const bf16_t* PROJ; bf16_t* O;
    __device__ __forceinline__ void mid(f32x4 (&acc)[2][2][4][2], const Unit& u, int wr, int wc, int fr, int fq) const {
        unsigned off = (unsigned)((u.pm * BM + wr * 64 + fr) * INC + u.pn * BM + wc * 32 + 8 * fq) * 2u;
        asm volatile("" : "+v"(off));
        const char* base = (const char*)PROJ;
#pragma unroll
        for (int ai = 0; ai < 2; ++ai) {
#pragma unroll
            for (int m = 0; m < 4; ++m) { const unsigned ro = off + (unsigned)((ai * HALF + m * 16) * INC * 2);
#pragma unroll
                for (int bj = 0; bj < 2; ++bj) { const u32x4 a = *(const u32x4*)(base + ro + (4096 + bj * HALF) * 2), b = *(const u32x4*)(base + ro + (6144 + bj * HALF) * 2);
#pragma unroll
                    for (int q = 0; q < 4; ++q) { const float a0 = fminf(fmaxf(bflo(a[q]), -30.f), 30.f), a1 = fminf(fmaxf(bfhi(a[q]), -30.f), 30.f), b0 = fminf(fmaxf(bflo(b[q]), -30.f), 30.f), b1 = fminf(fmaxf(bfhi(b[q]), -30.f), 30.f);
                        const float r0 = (1.0f + __expf(-b0)) * __builtin_amdgcn_rcpf(1.0f + __expf(-a0)), r1 = (1.0f + __expf(-b1)) * __builtin_amdgcn_rcpf(1.0f + __expf(-a1));
                        acc[ai][bj][m][q >> 1][(q & 1) * 2] *= r0; acc[ai][bj][m][q >> 1][(q & 1) * 2 + 1] *= r1; } } }
            asm volatile("" ::: "memory"); }
    }
    __device__ __forceinline__ void operator()(const f32x4 (&acc)[2][2][4][2], const Unit& u, int wr, int wc, int fr, int fq) const {
        const int row0 = u.pm * BM + wr * 64 + fr, col0 = u.pn * BM + wc * 32 + 8 * fq;
#pragma unroll
        for (int ai = 0; ai < 2; ++ai)
#pragma unroll
            for (int m = 0; m < 4; ++m) { const size_t row = (size_t)(row0 + ai * HALF + m * 16); const bf16_t* pr = PROJ + row * INC + 6144 + col0; bf16_t* orow = O + row * DM + col0;
#pragma unroll
                for (int bj = 0; bj < 2; ++bj) { const u32x4 b = *(const u32x4*)(pr + bj * HALF); u32x4 w;
#pragma unroll
                    for (int q = 0; q < 4; ++q) { const float b0 = fminf(fmaxf(bflo(b[q]), -30.f), 30.f), b1 = fminf(fmaxf(bfhi(b[q]), -30.f), 30.f);
                        w[q] = cvt_pk_bf16(acc[ai][bj][m][q >> 1][(q & 1) * 2] * sigmoid_fast(b0), acc[ai][bj][m][q >> 1][(q & 1) * 2 + 1] * sigmoid_fast(b1)); }
                    *(u32x4*)(orow + bj * HALF) = w; }
                asm volatile("" ::: "memory"); }
    }
};

template <class Epi, class Sched>
__device__ __forceinline__ void gemm_phase(LAS unsigned char* lds, const Gemm g, const Sched& S, const Epi& E) {
    int tid_ = threadIdx.x; asm volatile("" : "+v"(tid_));
    const int tid = tid_, wid = __builtin_amdgcn_readfirstlane(tid >> 6), lane = tid & 63, wr = wid >> 2, wc = wid & 3, fr = lane & 15, fq = lane >> 4;
    unsigned voffA[2], voffB[2];
#pragma unroll
    for (int i = 0; i < 2; ++i) { int R, C; stage_rc(tid * 16 + i * 8192, R, C); const int Rb = Epi::PERM ? ((R & ~31) + perm32(R & 31)) : R;
        voffA[i] = (unsigned)(R * g.lda + C) * 2u; voffB[i] = (unsigned)(Rb * g.ldb + C) * 2u; }
    const size_t kstep = (size_t)(BK * 2);
    const size_t hA = (size_t)HALF * g.lda * 2, hB = (size_t)HALF * g.ldb * 2;
    const unsigned ldsw = (unsigned)wid * 1024u;
    const int aoff = lds_byte(wr * 64 + fr, fq * 8), boff = lds_byte(wc * 32 + fr, fq * 8);
#define PG8_SA(b, h) (((b) * 2 + (h)) * HTB)
#define PG8_SB(b, h) ((4 + (b) * 2 + (h)) * HTB)
#define PG8_STAGE(bufoff, gbase, voff) do { _Pragma("unroll") for (int _i = 0; _i < 2; ++_i) \
        __builtin_amdgcn_global_load_lds((const unsigned*)((const char*)(gbase) + (voff)[_i]), (LAS unsigned*)(lds + (bufoff) + ldsw + _i * 8192), 16, 0, 0); } while (0)
#define PG8_LDA(dst, b, h) do { _Pragma("unroll") for (int m = 0; m < 4; ++m) _Pragma("unroll") for (int k = 0; k < 2; ++k) dst[m][k] = *(const LAS bf16x8*)(lds + PG8_SA(b, h) + aoff + m * 2048 + k * 1024); } while (0)
#define PG8_LDB(dst, b, h) do { _Pragma("unroll") for (int n = 0; n < 2; ++n) _Pragma("unroll") for (int k = 0; k < 2; ++k) dst[n][k] = *(const LAS bf16x8*)(lds + PG8_SB(b, h) + boff + n * 2048 + k * 1024); } while (0)
#define PG8_MMA(ai, bj, At, Bt) do { __builtin_amdgcn_s_setprio(1); _Pragma("unroll") for (int m = 0; m < 4; ++m) _Pragma("unroll") for (int n = 0; n < 2; ++n) _Pragma("unroll") for (int k = 0; k < 2; ++k) \
        acc[ai][bj][m][n] = __builtin_amdgcn_mfma_f32_16x16x32_bf16(Bt[n][k], At[m][k], acc[ai][bj][m][n], 0, 0, 0); __builtin_amdgcn_s_setprio(0); } while (0)
#define PG8_WAIT_V(n) asm volatile("s_waitcnt vmcnt(" #n ")" ::: "memory")
#define PG8_WAIT_L(n) asm volatile("s_waitcnt lgkmcnt(" #n ")" ::: "memory")
#define PG8_BAR __builtin_amdgcn_s_barrier()
#define PG8_SCHED __builtin_amdgcn_sched_barrier(0)
    Unit cur, nxt; int ui = 0;
    if (!S.next(0, cur)) return;
    f32x4 acc[2][2][4][2];
#pragma unroll
    for (int a = 0; a < 2; ++a)
#pragma unroll
        for (int b = 0; b < 2; ++b)
#pragma unroll
            for (int m = 0; m < 4; ++m)
#pragma unroll
                for (int n = 0; n < 2; ++n) acc[a][b][m][n] = (f32x4){0.f, 0.f, 0.f, 0.f};
    bf16x8 At[4][2], B0[2][2], B1[2][2];
    const char* cA = cur.a; const char* cB = cur.b;
    PG8_STAGE(PG8_SB(0, 0), cB, voffB); PG8_STAGE(PG8_SB(0, 1), cB + hB, voffB); PG8_STAGE(PG8_SA(0, 0), cA, voffA); PG8_STAGE(PG8_SA(0, 1), cA + hA, voffA);
    if (wr == 1) PG8_BAR;
    PG8_WAIT_V(2); PG8_BAR;
    PG8_STAGE(PG8_SB(1, 0), cB + kstep, voffB); PG8_STAGE(PG8_SA(1, 0), cA + kstep, voffA); PG8_STAGE(PG8_SB(1, 1), cB + hB + kstep, voffB);
    PG8_WAIT_V(6); PG8_BAR;
    for (;;) {
        const bool has_next = S.next(ui + 1, nxt);
        const char* nA = has_next ? nxt.a : cA; const char* nB = has_next ? nxt.b : cB;
        const int nt = cur.nt, tmid = nt >> 1;
        for (int t = 0; t < nt; t += 2) {
            const bool last = (t == nt - 2);
            const char* a1 = cA + (size_t)(t + 1) * kstep;
            const char* a2 = last ? nA : cA + (size_t)(t + 2) * kstep; const char* b2 = last ? nB : cB + (size_t)(t + 2) * kstep;
            const char* a3 = a2 + kstep; const char* b3 = b2 + kstep;
            if constexpr (Epi::HAS_MID) { if (t == tmid) E.mid(acc, cur, wr, wc, fr, fq); }
            PG8_LDB(B0, 0, 0); PG8_LDB(B1, 0, 1); PG8_SCHED; PG8_LDA(At, 0, 0); PG8_STAGE(PG8_SA(1, 1), a1 + hA, voffA);
            PG8_WAIT_V(8); PG8_WAIT_L(0); PG8_BAR; PG8_MMA(0, 0, At, B0); PG8_MMA(0, 1, At, B1); PG8_BAR; PG8_SCHED;
            PG8_LDA(At, 0, 1); PG8_STAGE(PG8_SB(0, 0), b2, voffB); PG8_STAGE(PG8_SB(0, 1), b2 + hB, voffB); PG8_STAGE(PG8_SA(0, 0), a2, voffA);
            PG8_WAIT_V(8); PG8_WAIT_L(0); PG8_BAR; PG8_MMA(1, 0, At, B0); PG8_MMA(1, 1, At, B1); PG8_BAR; PG8_SCHED;
            PG8_LDB(B0, 1, 0); PG8_LDB(B1, 1, 1); PG8_SCHED; PG8_LDA(At, 1, 0); PG8_STAGE(PG8_SA(0, 1), a2 + hA, voffA);
            PG8_WAIT_V(8); PG8_WAIT_L(0); PG8_BAR; PG8_MMA(0, 0, At, B0); PG8_MMA(0, 1, At, B1); PG8_BAR; PG8_SCHED;
            PG8_LDA(At, 1, 1); PG8_STAGE(PG8_SB(1, 0), b3, voffB); PG8_STAGE(PG8_SB(1, 1), b3 + hB, voffB); PG8_STAGE(PG8_SA(1, 0), a3, voffA);
            PG8_WAIT_V(8); PG8_WAIT_L(0); PG8_BAR; PG8_MMA(1, 0, At, B0); PG8_MMA(1, 1, At, B1); PG8_BAR; PG8_SCHED;
        }
        if (wr == 0) PG8_BAR;
        E(acc, cur, wr, wc, fr, fq);
        if (!has_next) break;
#pragma unroll
        for (int a = 0; a < 2; ++a)
#pragma unroll
            for (int b = 0; b < 2; ++b)
#pragma unroll
                for (int m = 0; m < 4; ++m)
#pragma unroll
                    for (int n = 0; n < 2; ++n) acc[a][b][m][n] = (f32x4){0.f, 0.f, 0.f, 0.f};
        cur = nxt; cA = nA; cB = nB; ++ui;
        if (wr == 1) PG8_BAR;
    }
    PG8_WAIT_V(0);
    PG8_BAR;
#undef PG8_SA
#undef PG8_SB
#undef PG8_STAGE
#undef PG8_LDA
#undef PG8_LDB
#undef PG8_MMA
#undef PG8_WAIT_V
#undef PG8_WAIT_L
#undef PG8_BAR
#undef PG8_SCHED
}
}

struct Args { const float* in[29]; float* out; unsigned char* ws; int ph_lo, ph_hi; };
enum { I_XP = 0, I_XS, I_SCONV, I_SH, I_CP, I_CS, I_WADA, I_BADA, I_F1GU, I_F1D, I_F2GU, I_F2D, I_WIN, I_CONVW, I_CONVB, I_LWA, I_LBA, I_LWX, I_LBX, I_LAM, I_GLNG, I_GLNB, I_GWS, I_GBS, I_WPA, I_WPB, I_WOUT, I_LNG, I_LNB };
constexpr int NPHASE = 15;

__device__ __forceinline__ void transpose_item(const float* W, int N, bf16_t* WT, int ldd, int koff, int mode, LAS float* scr, int item, int lane) {
    const int nblk = N / 32, kb = item / nblk, nb = item % nblk, k0 = 64 * kb, n0 = 32 * nb;
#pragma unroll 8
    for (int i = 0; i < 32; ++i) { const int kk = 2 * i + (lane >> 5); scr[kk * 33 + (lane & 31)] = W[(size_t)(k0 + kk) * N + n0 + (lane & 31)]; }
    LDS_WAIT(); asm volatile("" ::: "memory");
    int d0 = n0;
    if (mode == 1) { const int half = n0 >= DFF ? 1 : 0, jj = n0 - half * DFF; d0 = 256 * (jj >> 7) + 128 * half + (jj & 127); }
    const int c = lane & 7;
#pragma unroll
    for (int j = 0; j < 4; ++j) { const int n = (lane >> 3) + 8 * j; const LAS float* s = scr + (8 * c) * 33 + n;
        u32x4 o; o.x = pk2(s[0 * 33], s[1 * 33]); o.y = pk2(s[2 * 33], s[3 * 33]); o.z = pk2(s[4 * 33], s[5 * 33]); o.w = pk2(s[6 * 33], s[7 * 33]);
        *(u32x4*)(WT + (size_t)(d0 + n) * ldd + koff + k0 + 8 * c) = o; }
    LDS_WAIT(); asm volatile("" ::: "memory");
}


template <int MODE> __device__ __forceinline__ void lru_item(const Args& args, const bf16_t* PROJ, const bf16_t* WLRU, bf16_t* YAB, float* SEGA, float* SEGH, float* out, LAS unsigned char* wl, int it, int lane) {
    const int n = it & 15, e = lane, ch = n * 64 + e, fr = lane & 15, fq = lane >> 4;
    int b = 0, seg = 0, row0, b0 = 0;
    if (MODE == 2) { b0 = (it >> 4) * 16; row0 = NP + b0 * 4; } else { const int idx = it >> 4; b = idx >> 5; seg = idx & 31; row0 = b * SEQ + seg * SEGL; }
    LAS bf16_t* XA = (LAS bf16_t*)wl; LAS float* PR = (LAS float*)(wl + 2304); LAS float* PI = (LAS float*)(wl + 6400);
    bf16x8 wfa[4][2], wfx[4][2];
#pragma unroll
    for (int et = 0; et < 4; ++et)
#pragma unroll
        for (int kc = 0; kc < 2; ++kc) { wfa[et][kc] = *(const bf16x8*)(WLRU + ((size_t)(n * 64 + 16 * et + fr)) * 64 + 32 * kc + 8 * fq); wfx[et][kc] = *(const bf16x8*)(WLRU + ((size_t)((16 + n) * 64 + 16 * et + fr)) * 64 + 32 * kc + 8 * fq); }
    const float cw0 = args.in[I_CONVW][ch], cw1 = args.in[I_CONVW][DR + ch], cw2 = args.in[I_CONVW][2 * DR + ch], cw3 = args.in[I_CONVW][3 * DR + ch], cbv = args.in[I_CONVB][ch];
    const float ba = args.in[I_LBA][ch], bxv = args.in[I_LBX][ch];
    const float sp8 = -8.0f * log1pf(expf(-args.in[I_LAM][ch]));
    float x1 = 0.f, x2 = 0.f, x3 = 0.f, h = 0.f, P = 1.f;
    if (MODE != 2 && seg > 0) { x1 = bf2f(PROJ[(size_t)(row0 - 1) * INC + ch]); x2 = bf2f(PROJ[(size_t)(row0 - 2) * INC + ch]); x3 = bf2f(PROJ[(size_t)(row0 - 3) * INC + ch]); }
    if (MODE == 1) {
        for (int s = 0; s < seg; ++s) { const float a_ = SEGA[(size_t)(b * NSEG + s) * DR + ch], h_ = SEGH[(size_t)(b * NSEG + s) * DR + ch]; h = a_ * h + h_; }
    }
    for (int tile = 0; tile < 4; ++tile) {
        float xv[16], grv[16], xc[16];
#pragma unroll
        for (int t = 0; t < 16; ++t) { const size_t row = (size_t)(row0 + tile * 16 + t); xv[t] = bf2f(PROJ[row * INC + ch]); if (MODE != 0) grv[t] = bf2f(PROJ[row * INC + DR + ch]); }
#pragma unroll
        for (int t = 0; t < 16; ++t) {
            if (MODE == 2 && (t & 3) == 0) { const size_t bg = (size_t)(b0 + tile * 4 + (t >> 2)); x3 = args.in[I_SCONV][(bg * 3 + 0) * DR + ch]; x2 = args.in[I_SCONV][(bg * 3 + 1) * DR + ch]; x1 = args.in[I_SCONV][(bg * 3 + 2) * DR + ch]; }
            xc[t] = cbv + cw0 * x3 + cw1 * x2 + cw2 * x1 + cw3 * xv[t];
            x3 = x2; x2 = x1; x1 = xv[t];
            XA[t * 72 + e] = (bf16_t)f2bf(xc[t]); }
        LDS_WAIT();
        bf16x8 yf[2];
#pragma unroll
        for (int kc = 0; kc < 2; ++kc) yf[kc] = *(const LAS bf16x8*)(XA + fr * 72 + 32 * kc + 8 * fq);
#pragma unroll
        for (int et = 0; et < 4; ++et) { f32x4 dr = (f32x4){0.f, 0.f, 0.f, 0.f}, di = (f32x4){0.f, 0.f, 0.f, 0.f};
            dr = __builtin_amdgcn_mfma_f32_16x16x32_bf16(yf[0], wfa[et][0], dr, 0, 0, 0); dr = __builtin_amdgcn_mfma_f32_16x16x32_bf16(yf[1], wfa[et][1], dr, 0, 0, 0);
            di = __builtin_amdgcn_mfma_f32_16x16x32_bf16(yf[0], wfx[et][0], di, 0, 0, 0); di = __builtin_amdgcn_mfma_f32_16x16x32_bf16(yf[1], wfx[et][1], di, 0, 0, 0);
#pragma unroll
            for (int r = 0; r < 4; ++r) { PR[(4 * fq + r) * 64 + 16 * et + fr] = dr[r]; PI[(4 * fq + r) * 64 + 16 * et + fr] = di[r]; } }
        LDS_WAIT();
#pragma unroll
        for (int t = 0; t < 16; ++t) {
            const float pr = PR[t * 64 + e] + ba, pi = PI[t * 64 + e] + bxv;
            const float rg = sigmoid_fast(pr), ig = sigmoid_fast(pi);
            const float la = sp8 * rg, a = __expf(la), x = 2.0f * la;
            const float em = -x * (1.0f + x * (0.5f + x * (0.16666667f + x * (0.041666668f + x * (0.0083333338f + x * 0.0013888889f)))));
            float mult = sqrtf(em);
            if (MODE != 2 && seg == 0 && tile == 0 && t == 0) mult = 1.0f;
            if (MODE == 2 && (t & 3) == 0) h = args.in[I_SH][(size_t)(b0 + tile * 4 + (t >> 2)) * DR + ch];
            h = a * h + mult * ig * xc[t];
            if (MODE == 0) P *= a;
            if (MODE != 0) { const size_t row = (size_t)(row0 + tile * 16 + t); YAB[row * DM + ch] = (bf16_t)f2bf(h * gelu_tanh(grv[t])); }
            if (MODE == 2) { const size_t bg = (size_t)(b0 + tile * 4 + (t >> 2)); if ((t & 3) == 3) out[O_HS + bg * DR + ch] = h; if ((t & 3) != 0) out[O_CS + (bg * 3 + (t & 3) - 1) * DR + ch] = xv[t]; }
            if (MODE == 1 && seg == NSEG - 1 && tile == 3) { if (t == 15) out[O_HP + (size_t)b * DR + ch] = h; if (t >= 13) out[O_CP + ((size_t)b * 3 + (t - 13)) * DR + ch] = xv[t]; }
        }
        LDS_WAIT();
    }
    if (MODE == 0) { SEGA[(size_t)(b * NSEG + seg) * DR + ch] = P; SEGH[(size_t)(b * NSEG + seg) * DR + ch] = h; }
}

template <int KIND> __device__ __forceinline__ void phase_body(const Args& args, const int ph, LAS unsigned char* lds) {

    int tid_ = threadIdx.x; asm volatile("" : "+v"(tid_));
    const int tid = tid_, lane = tid & 63, wave = __builtin_amdgcn_readfirstlane(tid >> 6);
    int bx_ = blockIdx.x; asm volatile("" : "+s"(bx_));
    const int G = gridDim.x, bx = bx_;
    const int gw = bx * NWAVES + wave, NGW = G * NWAVES;
    unsigned char* ws = args.ws; asm volatile("" : "+s"(ws));
    bf16_t* W1GU = (bf16_t*)(ws + OFF_W1GU); bf16_t* W1D = (bf16_t*)(ws + OFF_W1D); bf16_t* W2GU = (bf16_t*)(ws + OFF_W2GU); bf16_t* W2D = (bf16_t*)(ws + OFF_W2D);
    bf16_t* WIN = (bf16_t*)(ws + OFF_WIN); bf16_t* WPAB = (bf16_t*)(ws + OFF_WPAB); bf16_t* WOUT = (bf16_t*)(ws + OFF_WOUT); bf16_t* WADA = (bf16_t*)(ws + OFF_WADA);
    bf16_t* SC = (bf16_t*)(ws + OFF_SC); float* MOD = (float*)(ws + OFF_MOD); bf16_t* U = (bf16_t*)(ws + OFF_U); bf16_t* YAB = (bf16_t*)(ws + OFF_YAB);
    float* X = (float*)(ws + OFF_X); bf16_t* HP = (bf16_t*)(ws + OFF_HP); float* HL = (float*)(ws + OFF_HL); float* PP = (float*)(ws + OFF_PP);
    float* SEGA = (float*)(ws + OFF_SEG); float* SEGH = SEGA + 4 * NSEG * DR;
    float* out = args.out;

        if constexpr (KIND == 0) {
            LAS float* scr = (LAS float*)(lds + wave * 16384);
            constexpr int I_ADA = 32 * (NMOD / 32), I_GU = 32 * (2 * DFF / 32), I_D = (DFF / 64) * (DM / 32), I_IN = 32 * (INC / 32), I_PA = (DR / 64) * (DM / 32), I_OUT = 32 * (DM / 32);
            constexpr int NIT = I_ADA + 2 * I_GU + 2 * I_D + I_IN + 2 * I_PA + I_OUT;
            for (int it = gw; it < NIT; it += NGW) {
                int r = it;
                if (r < I_ADA) { transpose_item(args.in[I_WADA], NMOD, WADA, DM, 0, 0, scr, r, lane); continue; } r -= I_ADA;
                if (r < I_GU) { transpose_item(args.in[I_F1GU], 2 * DFF, W1GU, DM, 0, 1, scr, r, lane); continue; } r -= I_GU;
                if (r < I_D) { transpose_item(args.in[I_F1D], DM, W1D, DFF, 0, 0, scr, r, lane); continue; } r -= I_D;
                if (r < I_IN) { transpose_item(args.in[I_WIN], INC, WIN, DM, 0, 0, scr, r, lane); continue; } r -= I_IN;
                if (r < I_PA) { transpose_item(args.in[I_WPA], DM, WPAB, DM, 0, 0, scr, r, lane); continue; } r -= I_PA;
                if (r < I_PA) { transpose_item(args.in[I_WPB], DM, WPAB, DM, DR, 0, scr, r, lane); continue; } r -= I_PA;
                if (r < I_OUT) { transpose_item(args.in[I_WOUT], DM, WOUT, DM, 0, 0, scr, r, lane); continue; } r -= I_OUT;
                if (r < I_GU) { transpose_item(args.in[I_F2GU], 2 * DFF, W2GU, DM, 0, 1, scr, r, lane); continue; } r -= I_GU;
                transpose_item(args.in[I_F2D], DM, W2D, DFF, 0, 0, scr, r, lane);
            }
            for (int i = bx * 512 + tid; i < 256 * DM / 2; i += G * 512) { const int row = i / (DM / 2), c2 = (i % (DM / 2)) * 2;
                float v0 = 0.f, v1 = 0.f;
                if (row < 132) { const float* cp = row < 4 ? args.in[I_CP] + (size_t)row * DM : args.in[I_CS] + (size_t)(row - 4) * DM; const float a = cp[c2], b = cp[c2 + 1]; v0 = a / (1.0f + expf(-a)); v1 = b / (1.0f + expf(-b)); }
                ((unsigned*)SC)[i] = pk2(v0, v1); }
            for (int i = bx * 512 + tid; i < 2 * 16 * 64 * 64; i += G * 512) { const int gate = i >> 16, n = (i >> 12) & 15, e = (i >> 6) & 63, d = i & 63;
                ((bf16_t*)(ws + OFF_WLRU))[i] = (bf16_t)f2bf(args.in[gate ? I_LWX : I_LWA][(size_t)n * 4096 + d * 64 + e]); }
        }
        if constexpr (KIND == 1) {
            pg8::Gemm g{DM, DM}; pg8::TileSched S; S.init(SC, WADA, DM, DM, 256, NMOD, DM, G, bx);
            pg8::EpiF32 E{MOD, NMOD, args.in[I_BADA]};
            pg8::gemm_phase<pg8::EpiF32, pg8::TileSched>(lds, g, S, E);
        }
        if constexpr (KIND == 2) {
            for (int r = gw; r < MR; r += NGW) {
                const float* xr = r < NP ? args.in[I_XP] + (size_t)r * DM : args.in[I_XS] + (size_t)(r - NP) * DM;
                const float* md = MOD + (size_t)modrow(r) * NMOD;
#pragma unroll
                for (int j = 0; j < 8; ++j) { const int c = lane * 4 + 256 * j; const f32x4 x = *(const f32x4*)(xr + c), sh = *(const f32x4*)(md + c), sc = *(const f32x4*)(md + DM + c);
                    const f32x4 u = x * (1.0f + sc) + sh; u32x2 w; w.x = pk2(u[0], u[1]); w.y = pk2(u[2], u[3]); *(u32x2*)(U + (size_t)r * DM + c) = w; }
            }
        }
        if constexpr (KIND == 3) {
            pg8::Gemm g{DM, DM}; pg8::TileSched S; S.init(U, ph == 3 ? W1GU : W2GU, DM, DM, MR, 2 * DFF, DM, G, bx);
            pg8::EpiSwiglu E{HP};
            pg8::gemm_phase<pg8::EpiSwiglu, pg8::TileSched>(lds, g, S, E);
        }
        if constexpr (KIND == 4) {
            const int Kd = ph == 10 ? DM : DFF;
            pg8::Gemm g{Kd, Kd}; pg8::TileSched S; S.init(ph == 10 ? U : HP, ph == 4 ? W1D : (ph == 10 ? WOUT : W2D), Kd, Kd, NP, DM, Kd, G, bx);
            S.s_pm0 = NP / 256; S.s_nM = NS / 256; S.s_splits = ph == 10 ? 8 : 11; S.s_nt = ph == 10 ? 4 : 8;
            pg8::EpiResid E{ph == 4 ? args.in[I_XP] : X, ph == 4 ? args.in[I_XS] : X + (size_t)NP * DM, X, MOD, ph == 4 ? 2 : (ph == 10 ? 5 : 8), ph == 10 ? 1.0f : 0.5f, (float*)(ws + OFF_WADA)};
            pg8::gemm_phase<pg8::EpiResid, pg8::TileSched>(lds, g, S, E);
        }
        if constexpr (KIND == 5) {
            const int li = ph == 5 ? 0 : (ph == 11 ? 1 : 2);
            const float* lg = args.in[I_LNG] + li * DM; const float* lb = args.in[I_LNB] + li * DM;
            float* dst = ph == 14 ? out + O_Y : X;
            for (int r = gw; r < MR; r += NGW) {
                const float* xr = X + (size_t)r * DM; f32x4 v[8]; float s = 0.f;
                if (r < NP) {
#pragma unroll
                    for (int j = 0; j < 8; ++j) v[j] = *(const f32x4*)(xr + lane * 4 + 256 * j);
                } else {
                    const float* xsrc = li == 0 ? args.in[I_XS] + (size_t)(r - NP) * DM : xr;
                    const float* gt = MOD + (size_t)modrow(r) * NMOD + (3 * li + 2) * DM; const float coef = li == 1 ? 1.0f : 0.5f; const int nsl = li == 1 ? 8 : 11;
                    const float* pt = (const float*)(ws + OFF_WADA) + (size_t)(r - NP) * DM;
#pragma unroll
                    for (int j = 0; j < 8; ++j) { const int c = lane * 4 + 256 * j; f32x4 a = *(const f32x4*)(pt + c);
                        for (int k = 1; k < nsl; ++k) a += *(const f32x4*)(pt + (size_t)k * NS * DM + c);
                        v[j] = *(const f32x4*)(xsrc + c) * ALPHA + *(const f32x4*)(gt + c) * coef * a; }
                }
#pragma unroll
                for (int j = 0; j < 8; ++j) s += (v[j][0] + v[j][1]) + (v[j][2] + v[j][3]);
                const float mean = wave_sum(s) * (1.0f / DM); float q = 0.f;
#pragma unroll
                for (int j = 0; j < 8; ++j) { v[j] = v[j] - mean; q += (v[j][0] * v[j][0] + v[j][1] * v[j][1]) + (v[j][2] * v[j][2] + v[j][3] * v[j][3]); }
                const float rstd = 1.0f / sqrtf(wave_sum(q) * (1.0f / DM) + LN_EPS);
                const float* md = MOD + (size_t)modrow(r) * NMOD + (3 * (li + 1)) * DM;
#pragma unroll
                for (int j = 0; j < 8; ++j) { const int c = lane * 4 + 256 * j; const f32x4 y = v[j] * rstd * *(const f32x4*)(lg + c) + *(const f32x4*)(lb + c);
                    *(f32x4*)(dst + (size_t)r * DM + c) = y;
                    if (ph != 14) { const f32x4 sh = *(const f32x4*)(md + c), sc = *(const f32x4*)(md + DM + c); const f32x4 u = y * (1.0f + sc) + sh; u32x2 w; w.x = pk2(u[0], u[1]); w.y = pk2(u[2], u[3]); *(u32x2*)(U + (size_t)r * DM + c) = w; } }
            }
        }
        if constexpr (KIND == 6) {
            pg8::Gemm g{DM, DM}; pg8::TileSched S; S.init(U, WIN, DM, DM, MR, INC, DM, G, bx);
            pg8::EpiBf16 E{HP, INC};
            pg8::gemm_phase<pg8::EpiBf16, pg8::TileSched>(lds, g, S, E);
        }
        if constexpr (KIND == 7) {
            const bf16_t* PROJ = HP; const bf16_t* WLRU = (const bf16_t*)(ws + OFF_WLRU);
            for (int it = gw; it < 2048 * 16 / 16 + 128; it += NGW) {
                if (it < 2048) lru_item<0>(args, PROJ, WLRU, YAB, SEGA, SEGH, out, lds + wave * 10496, it, lane);
                else lru_item<2>(args, PROJ, WLRU, YAB, SEGA, SEGH, out, lds + wave * 10496, it - 2048, lane);
            }
            __syncthreads();
            {
                LAS bf16_t* VN = (LAS bf16_t*)lds;
                LAS bf16_t* WT = (LAS bf16_t*)(lds + 34816);
                LAS float* st = (LAS float*)(lds + 69632);
                const float* lg = args.in[I_GLNG]; const float* lb = args.in[I_GLNB];
                const int fr = lane & 15, fq = lane >> 4;
                int g_loaded = -1;
                for (int it = bx; it < 512; it += G) {
                    const int g = it & 7, pc = it >> 3, b = pc >> 4, c = pc & 15, row0 = b * SEQ + c * 128;
                    __syncthreads();
                    if (g != g_loaded) { g_loaded = g;
                        for (int i = tid; i < 128 * 32; i += 512) { const int t = i >> 5, s4 = (i & 31) * 4; const f32x4 w = *(const f32x4*)(args.in[I_GWS] + (size_t)g * 16384 + t * 128 + s4);
                            u32x2 o; o.x = pk2(s4 + 0 <= t ? w[0] : 0.f, s4 + 1 <= t ? w[1] : 0.f); o.y = pk2(s4 + 2 <= t ? w[2] : 0.f, s4 + 3 <= t ? w[3] : 0.f); *(LAS u32x2*)(WT + t * 136 + s4) = o; } }
                    for (int k = 0; k < 16; ++k) { const int tt = wave * 16 + k; const bf16_t* gvp = PROJ + (size_t)(row0 + tt) * INC + 3072;
                        const u32x4 p0 = *(const u32x4*)(gvp + lane * 8), p1 = *(const u32x4*)(gvp + 512 + lane * 8); float s = 0.f, q = 0.f;
#pragma unroll
                        for (int j = 0; j < 4; ++j) { const float a0 = bflo(p0[j]), a1 = bfhi(p0[j]), a2 = bflo(p1[j]), a3 = bfhi(p1[j]); s += (a0 + a1) + (a2 + a3); q += (a0 * a0 + a1 * a1) + (a2 * a2 + a3 * a3); }
#pragma unroll
                        for (int o = 1; o < 64; o <<= 1) { s += __shfl_xor(s, o); q += __shfl_xor(q, o); }
                        const float mean = s * (1.0f / DR), var = fmaxf(q * (1.0f / DR) - mean * mean, 0.f);
                        if (lane == 0) { st[tt * 2] = mean; st[tt * 2 + 1] = 1.0f / sqrtf(var + LN_EPS); } }
                    __syncthreads();
#pragma unroll
                    for (int i = 0; i < 4; ++i) { const int task = tid + 512 * i, s = task >> 4, dc = task & 15, chn = g * 128 + dc * 8;
                        const u32x4 p = *(const u32x4*)(PROJ + (size_t)(row0 + s) * INC + 3072 + chn); const float mean = st[s * 2], rstd = st[s * 2 + 1];
                        const f32x4 g0 = *(const f32x4*)(lg + chn), g1 = *(const f32x4*)(lg + chn + 4), b0v = *(const f32x4*)(lb + chn), b1v = *(const f32x4*)(lb + chn + 4);
                        u32x4 o; o.x = pk2((bflo(p[0]) - mean) * rstd * g0[0] + b0v[0], (bfhi(p[0]) - mean) * rstd * g0[1] + b0v[1]); o.y = pk2((bflo(p[1]) - mean) * rstd * g0[2] + b0v[2], (bfhi(p[1]) - mean) * rstd * g0[3] + b0v[3]);
                        o.z = pk2((bflo(p[2]) - mean) * rstd * g1[0] + b1v[0], (bfhi(p[2]) - mean) * rstd * g1[1] + b1v[1]); o.w = pk2((bflo(p[3]) - mean) * rstd * g1[2] + b1v[2], (bfhi(p[3]) - mean) * rstd * g1[3] + b1v[3]);
                        *(LAS u32x4*)(VN + s * 136 + dc * 8) = o; }
                    __syncthreads();
                    bf16x8 vf[4];
#pragma unroll
                    for (int kc = 0; kc < 4; ++kc) { short tmp[8];
#pragma unroll
                        for (int j = 0; j < 8; ++j) tmp[j] = (short)VN[(32 * kc + 8 * fq + j) * 136 + 16 * wave + fr];
                        vf[kc] = (bf16x8){tmp[0], tmp[1], tmp[2], tmp[3], tmp[4], tmp[5], tmp[6], tmp[7]}; }
#pragma unroll
                    for (int tt = 0; tt < 8; ++tt) { f32x4 acc = (f32x4){0.f, 0.f, 0.f, 0.f};
#pragma unroll
                        for (int kc = 0; kc <= (16 * tt + 15) / 32; ++kc) { const bf16x8 wf = *(const LAS bf16x8*)(WT + (16 * tt + fr) * 136 + 32 * kc + 8 * fq); acc = __builtin_amdgcn_mfma_f32_16x16x32_bf16(vf[kc], wf, acc, 0, 0, 0); }
                        const int t = 16 * tt + fr, col = g * 128 + 16 * wave + 4 * fq; const size_t row = (size_t)(row0 + t);
                        const float bsv = args.in[I_GBS][g * 128 + t]; const u32x2 gu = *(const u32x2*)(PROJ + row * INC + 2048 + col);
                        u32x2 o; o.x = pk2(bflo(gu.x) * (acc[0] + bsv), bfhi(gu.x) * (acc[1] + bsv)); o.y = pk2(bflo(gu.y) * (acc[2] + bsv), bfhi(gu.y) * (acc[3] + bsv));
                        *(u32x2*)(YAB + row * DM + DR + col) = o; }
                }
            }
            for (int bg = gw; bg < 128; bg += NGW) {
                float vnv[4][16];
#pragma unroll
                for (int t = 0; t < 4; ++t) { const bf16_t* gvp = PROJ + (size_t)(NP + bg * 4 + t) * INC + 3072;
                    const u32x4 p0 = *(const u32x4*)(gvp + lane * 8), p1 = *(const u32x4*)(gvp + 512 + lane * 8);
#pragma unroll
                    for (int q = 0; q < 4; ++q) { vnv[t][2 * q] = bflo(p0[q]); vnv[t][2 * q + 1] = bfhi(p0[q]); vnv[t][8 + 2 * q] = bflo(p1[q]); vnv[t][8 + 2 * q + 1] = bfhi(p1[q]); }
                    float s = 0.f;
#pragma unroll
                    for (int q = 0; q < 16; ++q) s += vnv[t][q];
                    const float mean = wave_sum(s) * (1.0f / DR); float qq = 0.f;
#pragma unroll
                    for (int q = 0; q < 16; ++q) { const float d = vnv[t][q] - mean; qq += d * d; }
                    const float rstd = 1.0f / sqrtf(wave_sum(qq) * (1.0f / DR) + LN_EPS);
#pragma unroll
                    for (int q = 0; q < 16; ++q) { const int chn = (q >> 3) * 512 + lane * 8 + (q & 7); vnv[t][q] = (vnv[t][q] - mean) * rstd * args.in[I_GLNG][chn] + args.in[I_GLNB][chn]; }
                    float* vo = out + O_VS + (size_t)(bg * 4 + t) * DR;
#pragma unroll
                    for (int j = 0; j < 2; ++j) { *(f32x4*)(vo + j * 512 + lane * 8) = (f32x4){vnv[t][j * 8 + 0], vnv[t][j * 8 + 1], vnv[t][j * 8 + 2], vnv[t][j * 8 + 3]};
                        *(f32x4*)(vo + j * 512 + lane * 8 + 4) = (f32x4){vnv[t][j * 8 + 4], vnv[t][j * 8 + 5], vnv[t][j * 8 + 6], vnv[t][j * 8 + 7]}; }
                }
#pragma unroll
                for (int j = 0; j < 2; ++j) { const int g = (lane >> 4) + 4 * j; const float* wg = args.in[I_GWS] + (size_t)g * 16384; const float* bsg = args.in[I_GBS] + g * 128;
#pragma unroll
                    for (int t = 0; t < 4; ++t) { const size_t row = (size_t)NP + bg * 4 + t; const u32x4 gu = *(const u32x4*)(PROJ + row * INC + 2048 + j * 512 + lane * 8); float o[8];
#pragma unroll
                        for (int q = 0; q < 8; ++q) { float acc = bsg[t];
#pragma unroll
                            for (int s = 0; s < 4; ++s) if (s <= t) acc += wg[t * 128 + s] * vnv[s][j * 8 + q];
                            const float guv = (q & 1) ? bfhi(gu[q >> 1]) : bflo(gu[q >> 1]); o[q] = guv * acc; }
                        u32x4 w; w.x = pk2(o[0], o[1]); w.y = pk2(o[2], o[3]); w.z = pk2(o[4], o[5]); w.w = pk2(o[6], o[7]);
                        *(u32x4*)(YAB + row * DM + DR + j * 512 + lane * 8) = w; } }
            }
        }
        if constexpr (KIND == 8) {
            const bf16_t* PROJ = HP; const bf16_t* WLRU = (const bf16_t*)(ws + OFF_WLRU);
            for (int it = gw; it < 2048; it += NGW) lru_item<1>(args, PROJ, WLRU, YAB, SEGA, SEGH, out, lds + wave * 10496, it, lane);
        }
        if constexpr (KIND == 9) {
            pg8::Gemm g{DM, DM}; pg8::TileSched S; S.init(YAB, WPAB, DM, DM, MR, DM, DM, G, bx);
            pg8::EpiMerge E{HP, U};
            pg8::gemm_phase<pg8::EpiMerge, pg8::TileSched>(lds, g, S, E);
        }
}

__global__ void __launch_bounds__(NWAVES * 64, 2) fwd(Args args) {
    extern __shared__ __attribute__((aligned(16))) unsigned char lds_raw[];
    LAS unsigned char* lds = (LAS unsigned char*)lds_raw;
    cg::grid_group grid = cg::this_grid();
    for (int ph_ = args.ph_lo; ph_ < args.ph_hi + (REPEAT_PH >= 0 ? 1 : 0); ++ph_) {
        const int ph = (REPEAT_PH >= 0 && ph_ > REPEAT_PH) ? ph_ - 1 : ph_;
        switch (ph) {
        case 0: phase_body<0>(args, ph, lds); break;
        case 1: phase_body<1>(args, ph, lds); break;
        case 2: phase_body<2>(args, ph, lds); break;
        case 3: case 12: phase_body<3>(args, ph, lds); break;
        case 4: case 10: case 13: phase_body<4>(args, ph, lds); break;
        case 5: case 11: case 14: phase_body<5>(args, ph, lds); break;
        case 6: phase_body<6>(args, ph, lds); break;
        case 7: phase_body<7>(args, ph, lds); break;
        case 8: phase_body<8>(args, ph, lds); break;
        case 9: phase_body<9>(args, ph, lds); break;
        default: break;
        }
        if (ph_ + 1 < args.ph_hi + (REPEAT_PH >= 0 ? 1 : 0)) grid.sync();
    }
}


#ifdef DIAG_KINDS
template <int KIND> __global__ void __launch_bounds__(NWAVES * 64, 2) diag(Args args) {
    extern __shared__ __attribute__((aligned(16))) unsigned char lds_raw[];
    phase_body<KIND>(args, args.ph_lo, (LAS unsigned char*)lds_raw);
}
template __global__ void diag<0>(Args); template __global__ void diag<1>(Args); template __global__ void diag<2>(Args); template __global__ void diag<3>(Args); template __global__ void diag<4>(Args);
template __global__ void diag<5>(Args); template __global__ void diag<6>(Args); template __global__ void diag<7>(Args); template __global__ void diag<8>(Args); template __global__ void diag<9>(Args);
#endif
extern "C" void kernel_launch(void* const* d_in, const int* in_sizes, int n_in, void* d_out, int out_size, void* d_ws, size_t ws_size, hipStream_t stream) {
    static int grid = 0;
    if (grid == 0) {
        if (n_in != 29 || ws_size < WS_END) { fprintf(stderr, "kernel_launch: need 29 inputs and %zu bytes of ws; got %d, %zu\n", (size_t)WS_END, n_in, ws_size); grid = -1; return; }
        int dev = 0, cus = 0, per_cu = 0;
        hipGetDevice(&dev); hipDeviceGetAttribute(&cus, hipDeviceAttributeMultiprocessorCount, dev);
        if (hipFuncSetAttribute((const void*)fwd, hipFuncAttributeMaxDynamicSharedMemorySize, LDS_BYTES) != hipSuccess) { fprintf(stderr, "kernel_launch: hipFuncSetAttribute failed\n"); grid = -1; return; }
        if (hipOccupancyMaxActiveBlocksPerMultiprocessor(&per_cu, (const void*)fwd, NWAVES * 64, LDS_BYTES) != hipSuccess || per_cu < 1) { fprintf(stderr, "kernel_launch: occupancy query says %d\n", per_cu); per_cu = 1; }
        (void)hipGetLastError();
        grid = cus;
    }
    if (grid < 0) return;
    Args a{};
    for (int i = 0; i < 29; ++i) a.in[i] = (const float*)d_in[i];
    a.out = (float*)d_out; a.ws = (unsigned char*)d_ws;
#if ONE_LAUNCH
    a.ph_lo = 0; a.ph_hi = NPHASE;
    { void* kargs[] = {&a}; hipError_t e = hipLaunchCooperativeKernel((const void*)fwd, dim3(grid), dim3(NWAVES * 64), kargs, LDS_BYTES, stream);
      if (e != hipSuccess) fprintf(stderr, "cooperative launch failed: %s (grid %d)\n", hipGetErrorString(e), grid); }
#else
    for (int ph = 0; ph < NPHASE; ++ph) { a.ph_lo = ph; a.ph_hi = ph + 1; void* kargs[] = {&a};
        hipError_t e = hipLaunchCooperativeKernel((const void*)fwd, dim3(grid), dim3(NWAVES * 64), kargs, LDS_BYTES, stream);
        if (e != hipSuccess) { fprintf(stderr, "cooperative launch %d failed: %s (grid %d)\n", ph, hipGetErrorString(e), grid); break; } }
#endif
}
```

```cpp
#include <hip/hip_runtime.h>
#include <hip/hip_cooperative_groups.h>
#include <cstdio>
#include <cstdint>
namespace cg = cooperative_groups;

#define REPEAT_PH -1
#ifndef ONE_LAUNCH
#define ONE_LAUNCH 1
#endif

#define LAS __attribute__((address_space(3)))
typedef unsigned short bf16_t;
typedef short bf16x8 __attribute__((ext_vector_type(8)));
typedef float f32x4 __attribute__((ext_vector_type(4)));
typedef float f32x2 __attribute__((ext_vector_type(2)));
typedef unsigned u32x4 __attribute__((ext_vector_type(4)));
typedef unsigned u32x2 __attribute__((ext_vector_type(2)));

constexpr int DM = 2048, NP = 8192, NS = 512, MR = NP + NS, DFF = 5632, DR = 1024, INC = 8192, NMOD = 9 * DM;
constexpr int SEQ = 2048, NSEG = 32, SEGL = 64;
constexpr float ALPHA = 1.189207115002721f;
constexpr float LN_EPS = 1e-5f;
constexpr int NWAVES = 8;

constexpr size_t MiB = 1u << 20;
constexpr size_t OFF_W1GU = 1 * MiB, OFF_W1D = 45 * MiB, OFF_W2GU = 67 * MiB, OFF_W2D = 111 * MiB, OFF_WIN = 133 * MiB, OFF_WPAB = 165 * MiB, OFF_WOUT = 173 * MiB;
constexpr size_t OFF_WLRU = 181 * MiB, OFF_SC = 182 * MiB, OFF_MOD = 183 * MiB, OFF_U = 201 * MiB, OFF_YAB = 235 * MiB, OFF_X = 269 * MiB, OFF_HP = 337 * MiB, OFF_WADA = 473 * MiB;
constexpr size_t OFF_HL = OFF_WADA, OFF_PP = OFF_WADA + 32 * MiB, OFF_SEG = OFF_WADA + 64 * MiB, WS_END = 545 * MiB;

constexpr size_t O_Y = 0, O_CP = 17825792, O_HP = 17838080, O_CS = 17842176, O_HS = 18235392, O_VS = 18366464;

constexpr int LDS_BYTES = 131072 + 1024;

__device__ __forceinline__ unsigned f2bf(float f) { unsigned u = __builtin_bit_cast(unsigned, f); return (u + 0x7fffu + ((u >> 16) & 1u)) >> 16; }
__device__ __forceinline__ unsigned pk2(float lo, float hi) { return f2bf(lo) | (f2bf(hi) << 16); }
__device__ __forceinline__ float bflo(unsigned w) { return __builtin_bit_cast(float, w << 16); }
__device__ __forceinline__ float bfhi(unsigned w) { return __builtin_bit_cast(float, w & 0xffff0000u); }
__device__ __forceinline__ float bf2f(bf16_t b) { return __builtin_bit_cast(float, ((unsigned)b) << 16); }
__device__ __forceinline__ float wave_sum(float v) {
#pragma unroll
    for (int o = 1; o < 64; o <<= 1) v += __shfl_xor(v, o);
    return v;
}
__device__ __forceinline__ float sigmoid_fast(float x) { return __builtin_amdgcn_rcpf(1.0f + __expf(-x)); }
__device__ __forceinline__ float gelu_tanh(float x) { const float z = 0.7978845608028654f * (x + 0.044715f * x * x * x); return x * sigmoid_fast(2.0f * z); }
__device__ __forceinline__ int modrow(int r) { return r < NP ? (r >> 11) : 4 + ((r - NP) >> 2); }
#define LDS_WAIT() asm volatile("s_waitcnt lgkmcnt(0)" ::: "memory")

namespace pg8 {
constexpr int BM = 256, BK = 64, HALF = 128, HTB = HALF * BK * 2, STAGE_BYTES = 8 * HTB, NXCD = 8, WGM = 8;
__host__ __device__ __forceinline__ int lds_byte(int r, int c) { const int st = (r >> 4) * 2 + (c >> 5), rr = r & 15, cc = c & 31, ob = rr * 64 + cc * 2; return st * 1024 + (ob ^ (((ob >> 9) & 1) << 5)); }
__host__ __device__ __forceinline__ void stage_rc(int b, int& R, int& C) { const int st = b / 1024, sb = b % 1024, swz = sb ^ (((sb >> 9) & 1) << 5); R = (st >> 1) * 16 + swz / 64; C = (st & 1) * 32 + (swz % 64) / 2; }
__host__ __device__ __forceinline__ int perm32(int rho) { const int n = rho >> 4, i = rho & 15; return 8 * (i >> 2) + 4 * n + (i & 3); }

struct Unit { const char* a; const char* b; int nt, pm, pn, ks; };
struct Gemm { int lda, ldb; };

struct TileSched {
    const char* A; const char* Bt; size_t tA, tB;
    int nM, nN, nt, nwg, G, c, s_pm0, s_nM, s_splits, s_nt;
    __device__ void init(const bf16_t* A_, const bf16_t* Bt_, int lda, int ldb, int M, int N, int K, int G_, int c_) {
        A = (const char*)A_; Bt = (const char*)Bt_; tA = (size_t)BM * lda * 2; tB = (size_t)BM * ldb * 2; nM = M / BM; nN = N / BM; nt = K / BK; nwg = nM * nN; G = G_; c = c_; s_pm0 = 0; s_nM = 0; s_splits = 0; s_nt = 0; }
    __device__ bool next(int i, Unit& u) const {
        long L = (long)i * G + c;
        if (L < nwg) {
            int wgid = (int)L; { const int q = nwg / NXCD, r = nwg % NXCD, xcd = wgid % NXCD, off = wgid / NXCD; wgid = (xcd < r ? xcd * (q + 1) : r * (q + 1) + (xcd - r) * q) + off; }
            const int nig = WGM * nN, gid = wgid / nig, fm = gid * WGM, gsz = (nM - fm) < WGM ? (nM - fm) : WGM;
            u.pm = fm + ((wgid % nig) % gsz); u.pn = (wgid % nig) / gsz; u.nt = nt; u.ks = -1;
            u.a = A + (size_t)u.pm * tA; u.b = Bt + (size_t)u.pn * tB; return true; }
        L -= nwg; const int per = s_nM * nN;
        if (L >= (long)per * s_splits) return false;
        const int ks = (int)L / per, rem = (int)L % per;
        u.pm = s_pm0 + rem % s_nM; u.pn = rem / s_nM; u.nt = s_nt; u.ks = ks;
        u.a = A + (size_t)u.pm * tA + (size_t)ks * s_nt * (BK * 2); u.b = Bt + (size_t)u.pn * tB + (size_t)ks * s_nt * (BK * 2); return true;
    }
};

__device__ __forceinline__ unsigned cvt_pk_bf16(float lo, float hi) { unsigned r; asm volatile("v_cvt_pk_bf16_f32 %0, %1, %2" : "=v"(r) : "v"(lo), "v"(hi)); return r; }

struct EpiF32 {
    static constexpr bool PERM = false, HAS_MID = false;
    float* C; int ldc; const float* bias;
    __device__ __forceinline__ void mid(f32x4 (&acc)[2][2][4][2], const Unit& u, int wr, int wc, int fr, int fq) const {}
    __device__ __forceinline__ void operator()(const f32x4 (&acc)[2][2][4][2], const Unit& u, int wr, int wc, int fr, int fq) const {
        const int row0 = u.pm * BM + wr * 64 + fr, col0 = u.pn * BM + wc * 32 + 4 * fq;
        f32x4 bv[2][2];
#pragma unroll
        for (int bj = 0; bj < 2; ++bj)
#pragma unroll
            for (int n = 0; n < 2; ++n) bv[bj][n] = *(const f32x4*)(bias + col0 + bj * HALF + n * 16);
#pragma unroll
        for (int ai = 0; ai < 2; ++ai)
#pragma unroll
            for (int m = 0; m < 4; ++m) { float* rowp = C + (size_t)(row0 + ai * HALF + m * 16) * ldc + col0;
#pragma unroll
                for (int bj = 0; bj < 2; ++bj)
#pragma unroll
                    for (int n = 0; n < 2; ++n) *(f32x4*)(rowp + bj * HALF + n * 16) = acc[ai][bj][m][n] + bv[bj][n]; }
    }
};
struct EpiBf16 {
    static constexpr bool PERM = true, HAS_MID = false;
    bf16_t* O; int ldc;
    __device__ __forceinline__ void mid(f32x4 (&acc)[2][2][4][2], const Unit& u, int wr, int wc, int fr, int fq) const {}
    __device__ __forceinline__ void operator()(const f32x4 (&acc)[2][2][4][2], const Unit& u, int wr, int wc, int fr, int fq) const {
        const int row0 = u.pm * BM + wr * 64 + fr, col0 = u.pn * BM + wc * 32 + 8 * fq;
#pragma unroll
        for (int ai = 0; ai < 2; ++ai)
#pragma unroll
            for (int m = 0; m < 4; ++m) { bf16_t* rowp = O + (size_t)(row0 + ai * HALF + m * 16) * ldc + col0;
#pragma unroll
                for (int bj = 0; bj < 2; ++bj) { const f32x4 v0 = acc[ai][bj][m][0], v1 = acc[ai][bj][m][1];
                    u32x4 w; w.x = cvt_pk_bf16(v0[0], v0[1]); w.y = cvt_pk_bf16(v0[2], v0[3]); w.z = cvt_pk_bf16(v1[0], v1[1]); w.w = cvt_pk_bf16(v1[2], v1[3]);
                    *(u32x4*)(rowp + bj * HALF) = w; } }
    }
};
struct EpiSwiglu {
    static constexpr bool PERM = true, HAS_MID = false;
    bf16_t* H;
    __device__ __forceinline__ void mid(f32x4 (&acc)[2][2][4][2], const Unit& u, int wr, int wc, int fr, int fq) const {}
    __device__ __forceinline__ void operator()(const f32x4 (&acc)[2][2][4][2], const Unit& u, int wr, int wc, int fr, int fq) const {
        const int row0 = u.pm * BM + wr * 64 + fr, col0 = u.pn * HALF + wc * 32 + 8 * fq;
#pragma unroll
        for (int ai = 0; ai < 2; ++ai)
#pragma unroll
            for (int m = 0; m < 4; ++m) { bf16_t* rowp = H + (size_t)(row0 + ai * HALF + m * 16) * DFF + col0;
                float o[8];
#pragma unroll
                for (int n = 0; n < 2; ++n)
#pragma unroll
                    for (int j = 0; j < 4; ++j) { const float g = acc[ai][0][m][n][j], v = acc[ai][1][m][n][j]; o[n * 4 + j] = g * sigmoid_fast(g) * v; }
                u32x4 w; w.x = cvt_pk_bf16(o[0], o[1]); w.y = cvt_pk_bf16(o[2], o[3]); w.z = cvt_pk_bf16(o[4], o[5]); w.w = cvt_pk_bf16(o[6], o[7]);
                *(u32x4*)rowp = w; }
    }
};
struct EpiResid {
    static constexpr bool PERM = false, HAS_MID = false;
    const float* xp; const float* xs; float* X; const float* MOD; int gk; float coef; float* PART;
    __device__ __forceinline__ void mid(f32x4 (&acc)[2][2][4][2], const Unit& u, int wr, int wc, int fr, int fq) const {}
    __device__ __forceinline__ void operator()(const f32x4 (&acc)[2][2][4][2], const Unit& u, int wr, int wc, int fr, int fq) const {
        const int row0 = u.pm * BM + wr * 64 + fr, col0 = u.pn * BM + wc * 32 + 4 * fq;
        if (u.ks >= 0) {
#pragma unroll
            for (int ai = 0; ai < 2; ++ai)
#pragma unroll
                for (int m = 0; m < 4; ++m) { float* orow = PART + ((size_t)u.ks * NS + (row0 + ai * HALF + m * 16 - NP)) * DM + col0;
#pragma unroll
                    for (int bj = 0; bj < 2; ++bj)
#pragma unroll
                        for (int n = 0; n < 2; ++n) *(f32x4*)(orow + bj * HALF + n * 16) = acc[ai][bj][m][n]; }
            return; }
        const bool samp = u.pm >= NP / BM;
        f32x4 gv[2][2];
        if (!samp) { const float* md = MOD + (size_t)(u.pm >> 3) * NMOD + gk * DM + col0;
#pragma unroll
            for (int bj = 0; bj < 2; ++bj)
#pragma unroll
                for (int n = 0; n < 2; ++n) gv[bj][n] = *(const f32x4*)(md + bj * HALF + n * 16) * coef; }
#pragma unroll
        for (int ai = 0; ai < 2; ++ai)
#pragma unroll
            for (int m = 0; m < 4; ++m) { const int row = row0 + ai * HALF + m * 16;
                const float* xrow = (samp ? xs + (size_t)(row - NP) * DM : xp + (size_t)row * DM) + col0;
                if (samp) { const float* md = MOD + (size_t)(4 + ((row - NP) >> 2)) * NMOD + gk * DM + col0;
#pragma unroll
                    for (int bj = 0; bj < 2; ++bj)
#pragma unroll
                        for (int n = 0; n < 2; ++n) gv[bj][n] = *(const f32x4*)(md + bj * HALF + n * 16) * coef; }
                float* orow = X + (size_t)row * DM + col0;
#pragma unroll
                for (int bj = 0; bj < 2; ++bj)
#pragma unroll
                    for (int n = 0; n < 2; ++n) { const f32x4 xv = *(const f32x4*)(xrow + bj * HALF + n * 16); *(f32x4*)(orow + bj * HALF + n * 16) = xv * ALPHA + gv[bj][n] * acc[ai][bj][m][n]; }
                asm volatile("" ::: "memory"); }
    }
};
struct EpiMerge {
    static constexpr bool PERM = true, HAS_MID = true;
    const bf16_t* PROJ; bf16_t* O;
    __device__ __forceinline__ void mid(f32x4 (&acc)[2][2][4][2], const Unit& u, int wr, int wc, int fr, int fq) const {
        unsigned off = (unsigned)((u.pm * BM + wr * 64 + fr) * INC + u.pn * BM + wc * 32 + 8 * fq) * 2u;
        asm volatile("" : "+v"(off));
        const char* base = (const char*)PROJ;
#pragma unroll
        for (int ai = 0; ai < 2; ++ai) {
#pragma unroll
            for (int m = 0; m < 4; ++m) { const unsigned ro = off + (unsigned)((ai * HALF + m * 16) * INC * 2);
#pragma unroll
                for (int bj = 0; bj < 2; ++bj) { const u32x4 a = *(const u32x4*)(base + ro + (4096 + bj * HALF) * 2), b = *(const u32x4*)(base + ro + (6144 + bj * HALF) * 2);
#pragma unroll
                    for (int q = 0; q < 4; ++q) { const float a0 = fminf(fmaxf(bflo(a[q]), -30.f), 30.f), a1 = fminf(fmaxf(bfhi(a[q]), -30.f), 30.f), b0 = fminf(fmaxf(bflo(b[q]), -30.f), 30.f), b1 = fminf(fmaxf(bfhi(b[q]), -30.f), 30.f);
                        const float r0 = (1.0f + __expf(-b0)) * __builtin_amdgcn_rcpf(1.0f + __expf(-a0)), r1 = (1.0f + __expf(-b1)) * __builtin_amdgcn_rcpf(1.0f + __expf(-a1));
                        acc[ai][bj][m][q >> 1][(q & 1) * 2] *= r0; acc[ai][bj][m][q >> 1][(q & 1) * 2 + 1] *= r1; } } }
            asm volatile("" ::: "memory"); }
    }
    __device__ __forceinline__ void operator()(const f32x4 (&acc)[2][2][4][2], const Unit& u, int wr, int wc, int fr, int fq) const {
        const int row0 = u.pm * BM + wr * 64 + fr, col0 = u.pn * BM + wc * 32 + 8 * fq;
#pragma unroll
        for (int ai = 0; ai < 2; ++ai)
#pragma unroll
            for (int m = 0; m < 4; ++m) { const size_t row = (size_t)(row0 + ai * HALF + m * 16); const bf16_t* pr = PROJ + row * INC + 6144 + col0; bf16_t* orow = O + row * DM + col0;
#pragma unroll
                for (int bj = 0; bj < 2; ++bj) { const u32x4 b = *(const u32x4*)(pr + bj * HALF); u32x4 w;
#pragma unroll
                    for (int q = 0; q < 4; ++q) { const float b0 = fminf(fmaxf(bflo(b[q]), -30.f), 30.f), b1 = fminf(fmaxf(bfhi(b[q]), -30.f), 30.f);
                        w[q] = cvt_pk_bf16(acc[ai][bj][m][q >> 1][(q & 1) * 2] * sigmoid_fast(b0), acc[ai][bj][m][q >> 1][(q & 1) * 2 + 1] * sigmoid_fast(b1)); }
                    *(u32x4*)(orow + bj * HALF) = w; }
                asm volatile("" ::: "memory"); }
    }
};

template <class Epi, class Sched>
__device__ __forceinline__ void gemm_phase(LAS unsigned char* lds, const Gemm g, const Sched& S, const Epi& E) {
    int tid_ = threadIdx.x; asm volatile("" : "+v"(tid_));
    const int tid = tid_, wid = __builtin_amdgcn_readfirstlane(tid >> 6), lane = tid & 63, wr = wid >> 2, wc = wid & 3, fr = lane & 15, fq = lane >> 4;
    unsigned voffA[2], voffB[2];
#pragma unroll
    for (int i = 0; i < 2; ++i) { int R, C; stage_rc(tid * 16 + i * 8192, R, C); const int Rb = Epi::PERM ? ((R & ~31) + perm32(R & 31)) : R;
        voffA[i] = (unsigned)(R * g.lda + C) * 2u; voffB[i] = (unsigned)(Rb * g.ldb + C) * 2u; }
    const size_t kstep = (size_t)(BK * 2);
    const size_t hA = (size_t)HALF * g.lda * 2, hB = (size_t)HALF * g.ldb * 2;
    const unsigned ldsw = (unsigned)wid * 1024u;
    const int aoff = lds_byte(wr * 64 + fr, fq * 8), boff = lds_byte(wc * 32 + fr, fq * 8);
#define PG8_SA(b, h) (((b) * 2 + (h)) * HTB)
#define PG8_SB(b, h) ((4 + (b) * 2 + (h)) * HTB)
#define PG8_STAGE(bufoff, gbase, voff) do { _Pragma("unroll") for (int _i = 0; _i < 2; ++_i) \
        __builtin_amdgcn_global_load_lds((const unsigned*)((const char*)(gbase) + (voff)[_i]), (LAS unsigned*)(lds + (bufoff) + ldsw + _i * 8192), 16, 0, 0); } while (0)
#define PG8_LDA(dst, b, h) do { _Pragma("unroll") for (int m = 0; m < 4; ++m) _Pragma("unroll") for (int k = 0; k < 2; ++k) dst[m][k] = *(const LAS bf16x8*)(lds + PG8_SA(b, h) + aoff + m * 2048 + k * 1024); } while (0)
#define PG8_LDB(dst, b, h) do { _Pragma("unroll") for (int n = 0; n < 2; ++n) _Pragma("unroll") for (int k = 0; k < 2; ++k) dst[n][k] = *(const LAS bf16x8*)(lds + PG8_SB(b, h) + boff + n * 2048 + k * 1024); } while (0)
#define PG8_MMA(ai, bj, At, Bt) do { __builtin_amdgcn_s_setprio(1); _Pragma("unroll") for (int m = 0; m < 4; ++m) _Pragma("unroll") for (int n = 0; n < 2; ++n) _Pragma("unroll") for (int k = 0; k < 2; ++k) \
        acc[ai][bj][m][n] = __builtin_amdgcn_mfma_f32_16x16x32_bf16(Bt[n][k], At[m][k], acc[ai][bj][m][n], 0, 0, 0); __builtin_amdgcn_s_setprio(0); } while (0)
#define PG8_WAIT_V(n) asm volatile("s_waitcnt vmcnt(" #n ")" ::: "memory")
#define PG8_WAIT_L(n) asm volatile("s_waitcnt lgkmcnt(" #n ")" ::: "memory")
#define PG8_BAR __builtin_amdgcn_s_barrier()
#define PG8_SCHED __builtin_amdgcn_sched_barrier(0)
    Unit cur, nxt; int ui = 0;
    if (!S.next(0, cur)) return;
    f32x4 acc[2][2][4][2];
#pragma unroll
    for (int a = 0; a < 2; ++a)
#pragma unroll
        for (int b = 0; b < 2; ++b)
#pragma unroll
            for (int m = 0; m < 4; ++m)
#pragma unroll
                for (int n = 0; n < 2; ++n) acc[a][b][m][n] = (f32x4){0.f, 0.f, 0.f, 0.f};
    bf16x8 At[4][2], B0[2][2], B1[2][2];
    const char* cA = cur.a; const char* cB = cur.b;
    PG8_STAGE(PG8_SB(0, 0), cB, voffB); PG8_STAGE(PG8_SB(0, 1), cB + hB, voffB); PG8_STAGE(PG8_SA(0, 0), cA, voffA); PG8_STAGE(PG8_SA(0, 1), cA + hA, voffA);
    if (wr == 1) PG8_BAR;
    PG8_WAIT_V(2); PG8_BAR;
    PG8_STAGE(PG8_SB(1, 0), cB + kstep, voffB); PG8_STAGE(PG8_SA(1, 0), cA + kstep, voffA); PG8_STAGE(PG8_SB(1, 1), cB + hB + kstep, voffB);
    PG8_WAIT_V(6); PG8_BAR;
    for (;;) {
        const bool has_next = S.next(ui + 1, nxt);
        const char* nA = has_next ? nxt.a : cA; const char* nB = has_next ? nxt.b : cB;
        const int nt = cur.nt, tmid = nt >> 1;
        for (int t = 0; t < nt; t += 2) {
            const bool last = (t == nt - 2);
            const char* a1 = cA + (size_t)(t + 1) * kstep;
            const char* a2 = last ? nA : cA + (size_t)(t + 2) * kstep; const char* b2 = last ? nB : cB + (size_t)(t + 2) * kstep;
            const char* a3 = a2 + kstep; const char* b3 = b2 + kstep;
            if constexpr (Epi::HAS_MID) { if (t == tmid) E.mid(acc, cur, wr, wc, fr, fq); }
            PG8_LDB(B0, 0, 0); PG8_LDB(B1, 0, 1); PG8_SCHED; PG8_LDA(At, 0, 0); PG8_STAGE(PG8_SA(1, 1), a1 + hA, voffA);
            PG8_WAIT_V(8); PG8_WAIT_L(0); PG8_BAR; PG8_MMA(0, 0, At, B0); PG8_MMA(0, 1, At, B1); PG8_BAR; PG8_SCHED;
            PG8_LDA(At, 0, 1); PG8_STAGE(PG8_SB(0, 0), b2, voffB); PG8_STAGE(PG8_SB(0, 1), b2 + hB, voffB); PG8_STAGE(PG8_SA(0, 0), a2, voffA);
            PG8_WAIT_V(8); PG8_WAIT_L(0); PG8_BAR; PG8_MMA(1, 0, At, B0); PG8_MMA(1, 1, At, B1); PG8_BAR; PG8_SCHED;
            PG8_LDB(B0, 1, 0); PG8_LDB(B1, 1, 1); PG8_SCHED; PG8_LDA(At, 1, 0); PG8_STAGE(PG8_SA(0, 1), a2 + hA, voffA);
            PG8_WAIT_V(8); PG8_WAIT_L(0); PG8_BAR; PG8_MMA(0, 0, At, B0); PG8_MMA(0, 1, At, B1); PG8_BAR; PG8_SCHED;
            PG8_LDA(At, 1, 1); PG8_STAGE(PG8_SB(1, 0), b3, voffB); PG8_STAGE(PG8_SB(1, 1), b3 + hB, voffB); PG8_STAGE(PG8_SA(1, 0), a3, voffA);
            PG8_WAIT_V(8); PG8_WAIT_L(0); PG8_BAR; PG8_MMA(1, 0, At, B0); PG8_MMA(1, 1, At, B1); PG8_BAR; PG8_SCHED;
        }
        if (wr == 0) PG8_BAR;
        E(acc, cur, wr, wc, fr, fq);
        if (!has_next) break;
#pragma unroll
        for (int a = 0; a < 2; ++a)
#pragma unroll
            for (int b = 0; b < 2; ++b)
#pragma unroll
                for (int m = 0; m < 4; ++m)
#pragma unroll
                    for (int n = 0; n < 2; ++n) acc[a][b][m][n] = (f32x4){0.f, 0.f, 0.f, 0.f};
        cur = nxt; cA = nA; cB = nB; ++ui;
        if (wr == 1) PG8_BAR;
    }
    PG8_WAIT_V(0);
    PG8_BAR;
#undef PG8_SA
#undef PG8_SB
#undef PG8_STAGE
#undef PG8_LDA
#undef PG8_LDB
#undef PG8_MMA
#undef PG8_WAIT_V
#undef PG8_WAIT_L
#undef PG8_BAR
#undef PG8_SCHED
}
}

struct Args { const float* in[29]; float* out; unsigned char* ws; int ph_lo, ph_hi; };
enum { I_XP = 0, I_XS, I_SCONV, I_SH, I_CP, I_CS, I_WADA, I_BADA, I_F1GU, I_F1D, I_F2GU, I_F2D, I_WIN, I_CONVW, I_CONVB, I_LWA, I_LBA, I_LWX, I_LBX, I_LAM, I_GLNG, I_GLNB, I_GWS, I_GBS, I_WPA, I_WPB, I_WOUT, I_LNG, I_LNB };
constexpr int NPHASE = 15;

__device__ __forceinline__ void transpose_item(const float* W, int N, bf16_t* WT, int ldd, int koff, int mode, LAS float* scr, int item, int lane) {
    const int nblk = N / 32, kb = item / nblk, nb = item % nblk, k0 = 64 * kb, n0 = 32 * nb;
#pragma unroll 8
    for (int i = 0; i < 32; ++i) { const int kk = 2 * i + (lane >> 5); scr[kk * 33 + (lane & 31)] = W[(size_t)(k0 + kk) * N + n0 + (lane & 31)]; }
    LDS_WAIT(); asm volatile("" ::: "memory");
    int d0 = n0;
    if (mode == 1) { const int half = n0 >= DFF ? 1 : 0, jj = n0 - half * DFF; d0 = 256 * (jj >> 7) + 128 * half + (jj & 127); }
    const int c = lane & 7;
#pragma unroll
    for (int j = 0; j < 4; ++j) { const int n = (lane >> 3) + 8 * j; const LAS float* s = scr + (8 * c) * 33 + n;
        u32x4 o; o.x = pk2(s[0 * 33], s[1 * 33]); o.y = pk2(s[2 * 33], s[3 * 33]); o.z = pk2(s[4 * 33], s[5 * 33]); o.w = pk2(s[6 * 33], s[7 * 33]);
        *(u32x4*)(WT + (size_t)(d0 + n) * ldd + koff + k0 + 8 * c) = o; }
    LDS_WAIT(); asm volatile("" ::: "memory");
}


template <int MODE> __device__ __forceinline__ void lru_item(const Args& args, const bf16_t* PROJ, const bf16_t* WLRU, bf16_t* YAB, float* SEGA, float* SEGH, float* out, LAS unsigned char* wl, int it, int lane) {
    const int n = it & 15, e = lane, ch = n * 64 + e, fr = lane & 15, fq = lane >> 4;
    int b = 0, seg = 0, row0, b0 = 0;
    if (MODE == 2) { b0 = (it >> 4) * 4; row0 = NP + b0 * 4; } else { const int idx = it >> 4; b = idx >> 5; seg = idx & 31; row0 = b * SEQ + seg * SEGL; }
    LAS bf16_t* XA = (LAS bf16_t*)wl; LAS float* PR = (LAS float*)(wl + 2304); LAS float* PI = (LAS float*)(wl + 6400);
    bf16x8 wfa[4][2], wfx[4][2];
#pragma unroll
    for (int et = 0; et < 4; ++et)
#pragma unroll
        for (int kc = 0; kc < 2; ++kc) { wfa[et][kc] = *(const bf16x8*)(WLRU + ((size_t)(n * 64 + 16 * et + fr)) * 64 + 32 * kc + 8 * fq); wfx[et][kc] = *(const bf16x8*)(WLRU + ((size_t)((16 + n) * 64 + 16 * et + fr)) * 64 + 32 * kc + 8 * fq); }
    const float cw0 = args.in[I_CONVW][ch], cw1 = args.in[I_CONVW][DR + ch], cw2 = args.in[I_CONVW][2 * DR + ch], cw3 = args.in[I_CONVW][3 * DR + ch], cbv = args.in[I_CONVB][ch];
    const float ba = args.in[I_LBA][ch], bxv = args.in[I_LBX][ch];
    const float sp8 = -8.0f * log1pf(expf(-args.in[I_LAM][ch]));
    float x1 = 0.f, x2 = 0.f, x3 = 0.f, h = 0.f, P = 1.f;
    if (MODE != 2 && seg > 0) { x1 = bf2f(PROJ[(size_t)(row0 - 1) * INC + ch]); x2 = bf2f(PROJ[(size_t)(row0 - 2) * INC + ch]); x3 = bf2f(PROJ[(size_t)(row0 - 3) * INC + ch]); }
    if (MODE == 1) {
        for (int s0 = 0; s0 < seg; s0 += 8) { float av[8], hv[8];
#pragma unroll
            for (int j = 0; j < 8; ++j) { const int s = s0 + j < seg ? s0 + j : seg - 1; av[j] = SEGA[(size_t)(b * NSEG + s) * DR + ch]; hv[j] = SEGH[(size_t)(b * NSEG + s) * DR + ch]; }
#pragma unroll
            for (int j = 0; j < 8; ++j) if (s0 + j < seg) h = av[j] * h + hv[j]; }
    }
    constexpr int NTILE = MODE == 2 ? 1 : 4;
    bf16_t xn[16], gn[16];
#pragma unroll
    for (int t = 0; t < 16; ++t) { const size_t row = (size_t)(row0 + t); xn[t] = PROJ[row * INC + ch]; if (MODE != 0) gn[t] = PROJ[row * INC + DR + ch]; }
    for (int tile = 0; tile < NTILE; ++tile) {
        float xv[16], grv[16], xc[16];
#pragma unroll
        for (int t = 0; t < 16; ++t) { xv[t] = bf2f(xn[t]); if (MODE != 0) grv[t] = bf2f(gn[t]); }
        if (tile + 1 < NTILE) {
#pragma unroll
            for (int t = 0; t < 16; ++t) { const size_t row = (size_t)(row0 + (tile + 1) * 16 + t); xn[t] = PROJ[row * INC + ch]; if (MODE != 0) gn[t] = PROJ[row * INC + DR + ch]; } }
#pragma unroll
        for (int t = 0; t < 16; ++t) {
            if (MODE == 2 && (t & 3) == 0) { const size_t bg = (size_t)(b0 + tile * 4 + (t >> 2)); x3 = args.in[I_SCONV][(bg * 3 + 0) * DR + ch]; x2 = args.in[I_SCONV][(bg * 3 + 1) * DR + ch]; x1 = args.in[I_SCONV][(bg * 3 + 2) * DR + ch]; }
            xc[t] = cbv + cw0 * x3 + cw1 * x2 + cw2 * x1 + cw3 * xv[t];
            x3 = x2; x2 = x1; x1 = xv[t];
            XA[t * 72 + e] = (bf16_t)f2bf(xc[t]); }
        LDS_WAIT();
        bf16x8 yf[2];
#pragma unroll
        for (int kc = 0; kc < 2; ++kc) yf[kc] = *(const LAS bf16x8*)(XA + fr * 72 + 32 * kc + 8 * fq);
#pragma unroll
        for (int et = 0; et < 4; ++et) { f32x4 dr = (f32x4){0.f, 0.f, 0.f, 0.f}, di = (f32x4){0.f, 0.f, 0.f, 0.f};
            dr = __builtin_amdgcn_mfma_f32_16x16x32_bf16(yf[0], wfa[et][0], dr, 0, 0, 0); dr = __builtin_amdgcn_mfma_f32_16x16x32_bf16(yf[1], wfa[et][1], dr, 0, 0, 0);
            di = __builtin_amdgcn_mfma_f32_16x16x32_bf16(yf[0], wfx[et][0], di, 0, 0, 0); di = __builtin_amdgcn_mfma_f32_16x16x32_bf16(yf[1], wfx[et][1], di, 0, 0, 0);
#pragma unroll
            for (int r = 0; r < 4; ++r) { PR[(4 * fq + r) * 64 + 16 * et + fr] = dr[r]; PI[(4 * fq + r) * 64 + 16 * et + fr] = di[r]; } }
        LDS_WAIT();
#pragma unroll
        for (int t = 0; t < 16; ++t) {
            const float pr = PR[t * 64 + e] + ba, pi = PI[t * 64 + e] + bxv;
            const float rg = sigmoid_fast(pr), ig = sigmoid_fast(pi);
            const float la = sp8 * rg, a = __expf(la), x = 2.0f * la;
            const float em = -x * (1.0f + x * (0.5f + x * (0.16666667f + x * (0.041666668f + x * (0.0083333338f + x * 0.0013888889f)))));
            float mult = sqrtf(em);
            if (MODE != 2 && seg == 0 && tile == 0 && t == 0) mult = 1.0f;
            if (MODE == 2 && (t & 3) == 0) h = args.in[I_SH][(size_t)(b0 + tile * 4 + (t >> 2)) * DR + ch];
            h = a * h + mult * ig * xc[t];
            if (MODE == 0) P *= a;
            if (MODE != 0) { const size_t row = (size_t)(row0 + tile * 16 + t); YAB[row * DM + ch] = (bf16_t)f2bf(h * gelu_tanh(grv[t])); }
            if (MODE == 2) { const size_t bg = (size_t)(b0 + tile * 4 + (t >> 2)); if ((t & 3) == 3) out[O_HS + bg * DR + ch] = h; if ((t & 3) != 0) out[O_CS + (bg * 3 + (t & 3) - 1) * DR + ch] = xv[t]; }
            if (MODE == 1 && seg == NSEG - 1 && tile == 3) { if (t == 15) out[O_HP + (size_t)b * DR + ch] = h; if (t >= 13) out[O_CP + ((size_t)b * 3 + (t - 13)) * DR + ch] = xv[t]; }
        }
        LDS_WAIT();
    }
    if (MODE == 0) { SEGA[(size_t)(b * NSEG + seg) * DR + ch] = P; SEGH[(size_t)(b * NSEG + seg) * DR + ch] = h; }
}

template <int KIND> __device__ __forceinline__ void phase_body(const Args& args, const int ph, LAS unsigned char* lds) {

    int tid_ = threadIdx.x; asm volatile("" : "+v"(tid_));
    const int tid = tid_, lane = tid & 63, wave = __builtin_amdgcn_readfirstlane(tid >> 6);
    int bx_ = blockIdx.x; asm volatile("" : "+s"(bx_));
    const int G = gridDim.x, bx = bx_;
    const int gw = bx * NWAVES + wave, NGW = G * NWAVES;
    unsigned char* ws = args.ws; asm volatile("" : "+s"(ws));
    bf16_t* W1GU = (bf16_t*)(ws + OFF_W1GU); bf16_t* W1D = (bf16_t*)(ws + OFF_W1D); bf16_t* W2GU = (bf16_t*)(ws + OFF_W2GU); bf16_t* W2D = (bf16_t*)(ws + OFF_W2D);
    bf16_t* WIN = (bf16_t*)(ws + OFF_WIN); bf16_t* WPAB = (bf16_t*)(ws + OFF_WPAB); bf16_t* WOUT = (bf16_t*)(ws + OFF_WOUT); bf16_t* WADA = (bf16_t*)(ws + OFF_WADA);
    bf16_t* SC = (bf16_t*)(ws + OFF_SC); float* MOD = (float*)(ws + OFF_MOD); bf16_t* U = (bf16_t*)(ws + OFF_U); bf16_t* YAB = (bf16_t*)(ws + OFF_YAB);
    float* X = (float*)(ws + OFF_X); bf16_t* HP = (bf16_t*)(ws + OFF_HP); float* HL = (float*)(ws + OFF_HL); float* PP = (float*)(ws + OFF_PP);
    float* SEGA = (float*)(ws + OFF_SEG); float* SEGH = SEGA + 4 * NSEG * DR;
    float* out = args.out;

        if constexpr (KIND == 0) {
            LAS float* scr = (LAS float*)(lds + wave * 16384);
            constexpr int I_ADA = 32 * (NMOD / 32), I_GU = 32 * (2 * DFF / 32), I_D = (DFF / 64) * (DM / 32), I_IN = 32 * (INC / 32), I_PA = (DR / 64) * (DM / 32), I_OUT = 32 * (DM / 32);
            constexpr int NIT = I_ADA + 2 * I_GU + 2 * I_D + I_IN + 2 * I_PA + I_OUT;
            for (int it = gw; it < NIT; it += NGW) {
                int r = it;
                if (r < I_ADA) { transpose_item(args.in[I_WADA], NMOD, WADA, DM, 0, 0, scr, r, lane); continue; } r -= I_ADA;
                if (r < I_GU) { transpose_item(args.in[I_F1GU], 2 * DFF, W1GU, DM, 0, 1, scr, r, lane); continue; } r -= I_GU;
                if (r < I_D) { transpose_item(args.in[I_F1D], DM, W1D, DFF, 0, 0, scr, r, lane); continue; } r -= I_D;
                if (r < I_IN) { transpose_item(args.in[I_WIN], INC, WIN, DM, 0, 0, scr, r, lane); continue; } r -= I_IN;
                if (r < I_PA) { transpose_item(args.in[I_WPA], DM, WPAB, DM, 0, 0, scr, r, lane); continue; } r -= I_PA;
                if (r < I_PA) { transpose_item(args.in[I_WPB], DM, WPAB, DM, DR, 0, scr, r, lane); continue; } r -= I_PA;
                if (r < I_OUT) { transpose_item(args.in[I_WOUT], DM, WOUT, DM, 0, 0, scr, r, lane); continue; } r -= I_OUT;
                if (r < I_GU) { transpose_item(args.in[I_F2GU], 2 * DFF, W2GU, DM, 0, 1, scr, r, lane); continue; } r -= I_GU;
                transpose_item(args.in[I_F2D], DM, W2D, DFF, 0, 0, scr, r, lane);
            }
            for (int i = bx * 512 + tid; i < 256 * DM / 2; i += G * 512) { const int row = i / (DM / 2), c2 = (i % (DM / 2)) * 2;
                float v0 = 0.f, v1 = 0.f;
                if (row < 132) { const float* cp = row < 4 ? args.in[I_CP] + (size_t)row * DM : args.in[I_CS] + (size_t)(row - 4) * DM; const float a = cp[c2], b = cp[c2 + 1]; v0 = a / (1.0f + expf(-a)); v1 = b / (1.0f + expf(-b)); }
                ((unsigned*)SC)[i] = pk2(v0, v1); }
            for (int i = bx * 512 + tid; i < 2 * 16 * 64 * 64; i += G * 512) { const int gate = i >> 16, n = (i >> 12) & 15, e = (i >> 6) & 63, d = i & 63;
                ((bf16_t*)(ws + OFF_WLRU))[i] = (bf16_t)f2bf(args.in[gate ? I_LWX : I_LWA][(size_t)n * 4096 + d * 64 + e]); }
        }
        if constexpr (KIND == 1) {
            pg8::Gemm g{DM, DM}; pg8::TileSched S; S.init(SC, WADA, DM, DM, 256, NMOD, DM, G, bx);
            pg8::EpiF32 E{MOD, NMOD, args.in[I_BADA]};
            pg8::gemm_phase<pg8::EpiF32, pg8::TileSched>(lds, g, S, E);
        }
        if constexpr (KIND == 2) {
            for (int r = gw; r < MR; r += NGW) {
                const float* xr = r < NP ? args.in[I_XP] + (size_t)r * DM : args.in[I_XS] + (size_t)(r - NP) * DM;
                const float* md = MOD + (size_t)modrow(r) * NMOD;
#pragma unroll
                for (int j = 0; j < 8; ++j) { const int c = lane * 4 + 256 * j; const f32x4 x = *(const f32x4*)(xr + c), sh = *(const f32x4*)(md + c), sc = *(const f32x4*)(md + DM + c);
                    const f32x4 u = x * (1.0f + sc) + sh; u32x2 w; w.x = pk2(u[0], u[1]); w.y = pk2(u[2], u[3]); *(u32x2*)(U + (size_t)r * DM + c) = w; }
            }
        }
        if constexpr (KIND == 3) {
            pg8::Gemm g{DM, DM}; pg8::TileSched S; S.init(U, ph == 3 ? W1GU : W2GU, DM, DM, MR, 2 * DFF, DM, G, bx);
            pg8::EpiSwiglu E{HP};
            pg8::gemm_phase<pg8::EpiSwiglu, pg8::TileSched>(lds, g, S, E);
        }
        if constexpr (KIND == 4) {
            const int Kd = ph == 10 ? DM : DFF;
            pg8::Gemm g{Kd, Kd}; pg8::TileSched S; S.init(ph == 10 ? U : HP, ph == 4 ? W1D : (ph == 10 ? WOUT : W2D), Kd, Kd, NP, DM, Kd, G, bx);
            S.s_pm0 = NP / 256; S.s_nM = NS / 256; S.s_splits = ph == 10 ? 8 : 11; S.s_nt = ph == 10 ? 4 : 8;
            pg8::EpiResid E{ph == 4 ? args.in[I_XP] : X, ph == 4 ? args.in[I_XS] : X + (size_t)NP * DM, X, MOD, ph == 4 ? 2 : (ph == 10 ? 5 : 8), ph == 10 ? 1.0f : 0.5f, (float*)(ws + OFF_WADA)};
            pg8::gemm_phase<pg8::EpiResid, pg8::TileSched>(lds, g, S, E);
        }
        if constexpr (KIND == 5) {
            const int li = ph == 5 ? 0 : (ph == 11 ? 1 : 2);
            const float* lg = args.in[I_LNG] + li * DM; const float* lb = args.in[I_LNB] + li * DM;
            float* dst = ph == 14 ? out + O_Y : X;
            for (int r = gw; r < MR; r += NGW) {
                const float* xr = X + (size_t)r * DM; f32x4 v[8]; float s = 0.f;
                if (r < NP) {
#pragma unroll
                    for (int j = 0; j < 8; ++j) v[j] = *(const f32x4*)(xr + lane * 4 + 256 * j);
                } else {
                    const float* xsrc = li == 0 ? args.in[I_XS] + (size_t)(r - NP) * DM : xr;
                    const float* gt = MOD + (size_t)modrow(r) * NMOD + (3 * li + 2) * DM; const float coef = li == 1 ? 1.0f : 0.5f; const int nsl = li == 1 ? 8 : 11;
                    const float* pt = (const float*)(ws + OFF_WADA) + (size_t)(r - NP) * DM;
#pragma unroll
                    for (int j = 0; j < 8; ++j) { const int c = lane * 4 + 256 * j; f32x4 a = *(const f32x4*)(pt + c);
                        for (int k = 1; k < nsl; ++k) a += *(const f32x4*)(pt + (size_t)k * NS * DM + c);
                        v[j] = *(const f32x4*)(xsrc + c) * ALPHA + *(const f32x4*)(gt + c) * coef * a; }
                }
#pragma unroll
                for (int j = 0; j < 8; ++j) s += (v[j][0] + v[j][1]) + (v[j][2] + v[j][3]);
                const float mean = wave_sum(s) * (1.0f / DM); float q = 0.f;
#pragma unroll
                for (int j = 0; j < 8; ++j) { v[j] = v[j] - mean; q += (v[j][0] * v[j][0] + v[j][1] * v[j][1]) + (v[j][2] * v[j][2] + v[j][3] * v[j][3]); }
                const float rstd = 1.0f / sqrtf(wave_sum(q) * (1.0f / DM) + LN_EPS);
                const float* md = MOD + (size_t)modrow(r) * NMOD + (3 * (li + 1)) * DM;
#pragma unroll
                for (int j = 0; j < 8; ++j) { const int c = lane * 4 + 256 * j; const f32x4 y = v[j] * rstd * *(const f32x4*)(lg + c) + *(const f32x4*)(lb + c);
                    *(f32x4*)(dst + (size_t)r * DM + c) = y;
                    if (ph != 14) { const f32x4 sh = *(const f32x4*)(md + c), sc = *(const f32x4*)(md + DM + c); const f32x4 u = y * (1.0f + sc) + sh; u32x2 w; w.x = pk2(u[0], u[1]); w.y = pk2(u[2], u[3]); *(u32x2*)(U + (size_t)r * DM + c) = w; } }
            }
        }
        if constexpr (KIND == 6) {
            pg8::Gemm g{DM, DM}; pg8::TileSched S; S.init(U, WIN, DM, DM, MR, INC, DM, G, bx);
            pg8::EpiBf16 E{HP, INC};
            pg8::gemm_phase<pg8::EpiBf16, pg8::TileSched>(lds, g, S, E);
        }
        if constexpr (KIND == 7) {
            const bf16_t* PROJ = HP; const bf16_t* WLRU = (const bf16_t*)(ws + OFF_WLRU);
            for (int it = gw; it < 2048; it += NGW) lru_item<0>(args, PROJ, WLRU, YAB, SEGA, SEGH, out, lds + wave * 10496, it, lane);
            for (int it = (gw * 4) % NGW + (gw * 4) / NGW; it < 512; it += NGW) lru_item<2>(args, PROJ, WLRU, YAB, SEGA, SEGH, out, lds + wave * 10496, it, lane);
            __syncthreads();
            {
                LAS bf16_t* VN = (LAS bf16_t*)lds;
                LAS bf16_t* WT = (LAS bf16_t*)(lds + 34816);
                LAS float* st = (LAS float*)(lds + 69632);
                const float* lg = args.in[I_GLNG]; const float* lb = args.in[I_GLNB];
                const int fr = lane & 15, fq = lane >> 4;
                int g_loaded = -1;
                for (int it = bx; it < 512; it += G) {
                    const int g = it & 7, pc = it >> 3, b = pc >> 4, c = pc & 15, row0 = b * SEQ + c * 128;
                    __syncthreads();
                    if (g != g_loaded) { g_loaded = g;
                        for (int i = tid; i < 128 * 32; i += 512) { const int t = i >> 5, s4 = (i & 31) * 4; const f32x4 w = *(const f32x4*)(args.in[I_GWS] + (size_t)g * 16384 + t * 128 + s4);
                            u32x2 o; o.x = pk2(s4 + 0 <= t ? w[0] : 0.f, s4 + 1 <= t ? w[1] : 0.f); o.y = pk2(s4 + 2 <= t ? w[2] : 0.f, s4 + 3 <= t ? w[3] : 0.f); *(LAS u32x2*)(WT + t * 136 + s4) = o; } }
                    for (int k0 = 0; k0 < 16; k0 += 8) { u32x4 p0[8], p1[8];
#pragma unroll
                        for (int k = 0; k < 8; ++k) { const bf16_t* gvp = PROJ + (size_t)(row0 + wave * 16 + k0 + k) * INC + 3072; p0[k] = *(const u32x4*)(gvp + lane * 8); p1[k] = *(const u32x4*)(gvp + 512 + lane * 8); }
                        float s[8], q[8];
#pragma unroll
                        for (int k = 0; k < 8; ++k) { s[k] = 0.f; q[k] = 0.f;
#pragma unroll
                            for (int j = 0; j < 4; ++j) { const float a0 = bflo(p0[k][j]), a1 = bfhi(p0[k][j]), a2 = bflo(p1[k][j]), a3 = bfhi(p1[k][j]); s[k] += (a0 + a1) + (a2 + a3); q[k] += (a0 * a0 + a1 * a1) + (a2 * a2 + a3 * a3); } }
#pragma unroll
                        for (int o = 1; o < 64; o <<= 1) {
#pragma unroll
                            for (int k = 0; k < 8; ++k) { s[k] += __shfl_xor(s[k], o); q[k] += __shfl_xor(q[k], o); } }
#pragma unroll
                        for (int k = 0; k < 8; ++k) { const int tt = wave * 16 + k0 + k; const float mean = s[k] * (1.0f / DR), var = fmaxf(q[k] * (1.0f / DR) - mean * mean, 0.f);
                            if (lane == 0) { st[tt * 2] = mean; st[tt * 2 + 1] = 1.0f / sqrtf(var + LN_EPS); } } }
                    __syncthreads();
#pragma unroll
                    for (int i = 0; i < 4; ++i) { const int task = tid + 512 * i, s = task >> 4, dc = task & 15, chn = g * 128 + dc * 8;
                        const u32x4 p = *(const u32x4*)(PROJ + (size_t)(row0 + s) * INC + 3072 + chn); const float mean = st[s * 2], rstd = st[s * 2 + 1];
                        const f32x4 g0 = *(const f32x4*)(lg + chn), g1 = *(const f32x4*)(lg + chn + 4), b0v = *(const f32x4*)(lb + chn), b1v = *(const f32x4*)(lb + chn + 4);
                        u32x4 o; o.x = pk2((bflo(p[0]) - mean) * rstd * g0[0] + b0v[0], (bfhi(p[0]) - mean) * rstd * g0[1] + b0v[1]); o.y = pk2((bflo(p[1]) - mean) * rstd * g0[2] + b0v[2], (bfhi(p[1]) - mean) * rstd * g0[3] + b0v[3]);
                        o.z = pk2((bflo(p[2]) - mean) * rstd * g1[0] + b1v[0], (bfhi(p[2]) - mean) * rstd * g1[1] + b1v[1]); o.w = pk2((bflo(p[3]) - mean) * rstd * g1[2] + b1v[2], (bfhi(p[3]) - mean) * rstd * g1[3] + b1v[3]);
                        *(LAS u32x4*)(VN + s * 136 + dc * 8) = o; }
                    __syncthreads();
                    bf16x8 vf[4];
#pragma unroll
                    for (int kc = 0; kc < 4; ++kc) { short tmp[8];
#pragma unroll
                        for (int j = 0; j < 8; ++j) tmp[j] = (short)VN[(32 * kc + 8 * fq + j) * 136 + 16 * wave + fr];
                        vf[kc] = (bf16x8){tmp[0], tmp[1], tmp[2], tmp[3], tmp[4], tmp[5], tmp[6], tmp[7]}; }
#pragma unroll
                    for (int tt = 0; tt < 8; ++tt) { f32x4 acc = (f32x4){0.f, 0.f, 0.f, 0.f};
#pragma unroll
                        for (int kc = 0; kc <= (16 * tt + 15) / 32; ++kc) { const bf16x8 wf = *(const LAS bf16x8*)(WT + (16 * tt + fr) * 136 + 32 * kc + 8 * fq); acc = __builtin_amdgcn_mfma_f32_16x16x32_bf16(vf[kc], wf, acc, 0, 0, 0); }
                        const int t = 16 * tt + fr, col = g * 128 + 16 * wave + 4 * fq; const size_t row = (size_t)(row0 + t);
                        const float bsv = args.in[I_GBS][g * 128 + t]; const u32x2 gu = *(const u32x2*)(PROJ + row * INC + 2048 + col);
                        u32x2 o; o.x = pk2(bflo(gu.x) * (acc[0] + bsv), bfhi(gu.x) * (acc[1] + bsv)); o.y = pk2(bflo(gu.y) * (acc[2] + bsv), bfhi(gu.y) * (acc[3] + bsv));
                        *(u32x2*)(YAB + row * DM + DR + col) = o; }
                }
            }
            for (int bg = gw; bg < 128; bg += NGW) {
                float vnv[4][16];
#pragma unroll
                for (int t = 0; t < 4; ++t) { const bf16_t* gvp = PROJ + (size_t)(NP + bg * 4 + t) * INC + 3072;
                    const u32x4 p0 = *(const u32x4*)(gvp + lane * 8), p1 = *(const u32x4*)(gvp + 512 + lane * 8);
#pragma unroll
                    for (int q = 0; q < 4; ++q) { vnv[t][2 * q] = bflo(p0[q]); vnv[t][2 * q + 1] = bfhi(p0[q]); vnv[t][8 + 2 * q] = bflo(p1[q]); vnv[t][8 + 2 * q + 1] = bfhi(p1[q]); }
                    float s = 0.f;
#pragma unroll
                    for (int q = 0; q < 16; ++q) s += vnv[t][q];
                    const float mean = wave_sum(s) * (1.0f / DR); float qq = 0.f;
#pragma unroll
                    for (int q = 0; q < 16; ++q) { const float d = vnv[t][q] - mean; qq += d * d; }
                    const float rstd = 1.0f / sqrtf(wave_sum(qq) * (1.0f / DR) + LN_EPS);
#pragma unroll
                    for (int q = 0; q < 16; ++q) { const int chn = (q >> 3) * 512 + lane * 8 + (q & 7); vnv[t][q] = (vnv[t][q] - mean) * rstd * args.in[I_GLNG][chn] + args.in[I_GLNB][chn]; }
                    float* vo = out + O_VS + (size_t)(bg * 4 + t) * DR;
#pragma unroll
                    for (int j = 0; j < 2; ++j) { *(f32x4*)(vo + j * 512 + lane * 8) = (f32x4){vnv[t][j * 8 + 0], vnv[t][j * 8 + 1], vnv[t][j * 8 + 2], vnv[t][j * 8 + 3]};
                        *(f32x4*)(vo + j * 512 + lane * 8 + 4) = (f32x4){vnv[t][j * 8 + 4], vnv[t][j * 8 + 5], vnv[t][j * 8 + 6], vnv[t][j * 8 + 7]}; }
                }
#pragma unroll
                for (int j = 0; j < 2; ++j) { const int g = (lane >> 4) + 4 * j; const float* wg = args.in[I_GWS] + (size_t)g * 16384; const float* bsg = args.in[I_GBS] + g * 128;
#pragma unroll
                    for (int t = 0; t < 4; ++t) { const size_t row = (size_t)NP + bg * 4 + t; const u32x4 gu = *(const u32x4*)(PROJ + row * INC + 2048 + j * 512 + lane * 8); float o[8];
#pragma unroll
                        for (int q = 0; q < 8; ++q) { float acc = bsg[t];
#pragma unroll
                            for (int s = 0; s < 4; ++s) if (s <= t) acc += wg[t * 128 + s] * vnv[s][j * 8 + q];
                            const float guv = (q & 1) ? bfhi(gu[q >> 1]) : bflo(gu[q >> 1]); o[q] = guv * acc; }
                        u32x4 w; w.x = pk2(o[0], o[1]); w.y = pk2(o[2], o[3]); w.z = pk2(o[4], o[5]); w.w = pk2(o[6], o[7]);
                        *(u32x4*)(YAB + row * DM + DR + j * 512 + lane * 8) = w; } }
            }
        }
        if constexpr (KIND == 8) {
            const bf16_t* PROJ = HP; const bf16_t* WLRU = (const bf16_t*)(ws + OFF_WLRU);
            for (int it = gw; it < 2048; it += NGW) lru_item<1>(args, PROJ, WLRU, YAB, SEGA, SEGH, out, lds + wave * 10496, it, lane);
        }
        if constexpr (KIND == 9) {
            pg8::Gemm g{DM, DM}; pg8::TileSched S; S.init(YAB, WPAB, DM, DM, MR, DM, DM, G, bx);
            pg8::EpiMerge E{HP, U};
            pg8::gemm_phase<pg8::EpiMerge, pg8::TileSched>(lds, g, S, E);
        }
}

__global__ void __launch_bounds__(NWAVES * 64, 2) fwd(Args args) {
    extern __shared__ __attribute__((aligned(16))) unsigned char lds_raw[];
    LAS unsigned char* lds = (LAS unsigned char*)lds_raw;
    cg::grid_group grid = cg::this_grid();
    for (int ph_ = args.ph_lo; ph_ < args.ph_hi + (REPEAT_PH >= 0 ? 1 : 0); ++ph_) {
        const int ph = (REPEAT_PH >= 0 && ph_ > REPEAT_PH) ? ph_ - 1 : ph_;
        switch (ph) {
        case 0: phase_body<0>(args, ph, lds); break;
        case 1: phase_body<1>(args, ph, lds); break;
        case 2: phase_body<2>(args, ph, lds); break;
        case 3: case 12: phase_body<3>(args, ph, lds); break;
        case 4: case 10: case 13: phase_body<4>(args, ph, lds); break;
        case 5: case 11: case 14: phase_body<5>(args, ph, lds); break;
        case 6: phase_body<6>(args, ph, lds); break;
        case 7: phase_body<7>(args, ph, lds); break;
        case 8: phase_body<8>(args, ph, lds); break;
        case 9: phase_body<9>(args, ph, lds); break;
        default: break;
        }
        if (ph_ + 1 < args.ph_hi + (REPEAT_PH >= 0 ? 1 : 0)) grid.sync();
    }
}


#ifdef DIAG_KINDS
template <int KIND> __global__ void __launch_bounds__(NWAVES * 64, 2) diag(Args args) {
    extern __shared__ __attribute__((aligned(16))) unsigned char lds_raw[];
    phase_body<KIND>(args, args.ph_lo, (LAS unsigned char*)lds_raw);
}
template __global__ void diag<0>(Args); template __global__ void diag<1>(Args); template __global__ void diag<2>(Args); template __global__ void diag<3>(Args); template __global__ void diag<4>(Args);
template __global__ void diag<5>(Args); template __global__ void diag<6>(Args); template __global__ void diag<7>(Args); template __global__ void diag<8>(Args); template __global__ void diag<9>(Args);
#endif
extern "C" void kernel_launch(void* const* d_in, const int* in_sizes, int n_in, void* d_out, int out_size, void* d_ws, size_t ws_size, hipStream_t stream) {
    static int grid = 0;
    if (grid == 0) {
        if (n_in != 29 || ws_size < WS_END) { fprintf(stderr, "kernel_launch: need 29 inputs and %zu bytes of ws; got %d, %zu\n", (size_t)WS_END, n_in, ws_size); grid = -1; return; }
        int dev = 0, cus = 0, per_cu = 0;
        hipGetDevice(&dev); hipDeviceGetAttribute(&cus, hipDeviceAttributeMultiprocessorCount, dev);
        if (hipFuncSetAttribute((const void*)fwd, hipFuncAttributeMaxDynamicSharedMemorySize, LDS_BYTES) != hipSuccess) { fprintf(stderr, "kernel_launch: hipFuncSetAttribute failed\n"); grid = -1; return; }
        if (hipOccupancyMaxActiveBlocksPerMultiprocessor(&per_cu, (const void*)fwd, NWAVES * 64, LDS_BYTES) != hipSuccess || per_cu < 1) { fprintf(stderr, "kernel_launch: occupancy query says %d\n", per_cu); per_cu = 1; }
        (void)hipGetLastError();
        grid = cus;
    }
    if (grid < 0) return;
    Args a{};
    for (int i = 0; i < 29; ++i) a.in[i] = (const float*)d_in[i];
    a.out = (float*)d_out; a.ws = (unsigned char*)d_ws;
#if ONE_LAUNCH
    a.ph_lo = 0; a.ph_hi = NPHASE;
    { void* kargs[] = {&a}; hipError_t e = hipLaunchCooperativeKernel((const void*)fwd, dim3(grid), dim3(NWAVES * 64), kargs, LDS_BYTES, stream);
      if (e != hipSuccess) fprintf(stderr, "cooperative launch failed: %s (grid %d)\n", hipGetErrorString(e), grid); }
#else
    for (int ph = 0; ph < NPHASE; ++ph) { a.ph_lo = ph; a.ph_hi = ph + 1; void* kargs[] = {&a};
        hipError_t e = hipLaunchCooperativeKernel((const void*)fwd, dim3(grid), dim3(NWAVES * 64), kargs, LDS_BYTES, stream);
        if (e != hipSuccess) { fprintf(stderr, "cooperative launch %d failed: %s (grid %d)\n", ph, hipGetErrorString(e), grid); break; } }
#endif
}
```

```cpp
#include <hip/hip_runtime.h>
#include <hip/hip_cooperative_groups.h>
#include <cstdio>
#include <cstdint>
namespace cg = cooperative_groups;

#define REPEAT_PH -1
#ifndef ONE_LAUNCH
#define ONE_LAUNCH 1
#endif

#define LAS __attribute__((address_space(3)))
typedef unsigned short bf16_t;
typedef short bf16x8 __attribute__((ext_vector_type(8)));
typedef float f32x4 __attribute__((ext_vector_type(4)));
typedef float f32x2 __attribute__((ext_vector_type(2)));
typedef unsigned u32x4 __attribute__((ext_vector_type(4)));
typedef unsigned u32x2 __attribute__((ext_vector_type(2)));

constexpr int DM = 2048, NP = 8192, NS = 512, MR = NP + NS, DFF = 5632, DR = 1024, INC = 8192, NMOD = 9 * DM;
constexpr int SEQ = 2048, NSEG = 32, SEGL = 64;
constexpr float ALPHA = 1.189207115002721f;
constexpr float LN_EPS = 1e-5f;
constexpr int NWAVES = 8;

constexpr size_t MiB = 1u << 20;
constexpr size_t OFF_W1GU = 1 * MiB, OFF_W1D = 45 * MiB, OFF_W2GU = 67 * MiB, OFF_W2D = 111 * MiB, OFF_WIN = 133 * MiB, OFF_WPAB = 165 * MiB, OFF_WOUT = 173 * MiB;
constexpr size_t OFF_WLRU = 181 * MiB, OFF_SC = 182 * MiB, OFF_MOD = 183 * MiB, OFF_U = 201 * MiB, OFF_YAB = 235 * MiB, OFF_X = 269 * MiB, OFF_HP = 337 * MiB, OFF_WADA = 473 * MiB;
constexpr size_t OFF_HL = OFF_WADA, OFF_PP = OFF_WADA + 32 * MiB, OFF_SEG = OFF_WADA + 64 * MiB, WS_END = 545 * MiB;

constexpr size_t O_Y = 0, O_CP = 17825792, O_HP = 17838080, O_CS = 17842176, O_HS = 18235392, O_VS = 18366464;

constexpr int LDS_BYTES = 131072 + 1024 + 64;

__device__ __forceinline__ unsigned f2bf(float f) { unsigned u = __builtin_bit_cast(unsigned, f); return (u + 0x7fffu + ((u >> 16) & 1u)) >> 16; }
__device__ __forceinline__ unsigned pk2(float lo, float hi) { return f2bf(lo) | (f2bf(hi) << 16); }
__device__ __forceinline__ float bflo(unsigned w) { return __builtin_bit_cast(float, w << 16); }
__device__ __forceinline__ float bfhi(unsigned w) { return __builtin_bit_cast(float, w & 0xffff0000u); }
__device__ __forceinline__ float bf2f(bf16_t b) { return __builtin_bit_cast(float, ((unsigned)b) << 16); }
__device__ __forceinline__ float wave_sum(float v) {
#pragma unroll
    for (int o = 1; o < 64; o <<= 1) v += __shfl_xor(v, o);
    return v;
}
__device__ __forceinline__ float sigmoid_fast(float x) { return __builtin_amdgcn_rcpf(1.0f + __expf(-x)); }
__device__ __forceinline__ float gelu_tanh(float x) { const float z = 0.7978845608028654f * (x + 0.044715f * x * x * x); return x * sigmoid_fast(2.0f * z); }
__device__ __forceinline__ int modrow(int r) { return r < NP ? (r >> 11) : 4 + ((r - NP) >> 2); }
#define LDS_WAIT() asm volatile("s_waitcnt lgkmcnt(0)" ::: "memory")

namespace pg8 {
constexpr int BM = 256, BK = 64, HALF = 128, HTB = HALF * BK * 2, STAGE_BYTES = 8 * HTB, NXCD = 8, WGM = 8;
__host__ __device__ __forceinline__ int lds_byte(int r, int c) { const int st = (r >> 4) * 2 + (c >> 5), rr = r & 15, cc = c & 31, ob = rr * 64 + cc * 2; return st * 1024 + (ob ^ (((ob >> 9) & 1) << 5)); }
__host__ __device__ __forceinline__ void stage_rc(int b, int& R, int& C) { const int st = b / 1024, sb = b % 1024, swz = sb ^ (((sb >> 9) & 1) << 5); R = (st >> 1) * 16 + swz / 64; C = (st & 1) * 32 + (swz % 64) / 2; }
__host__ __device__ __forceinline__ int perm32(int rho) { const int n = rho >> 4, i = rho & 15; return 8 * (i >> 2) + 4 * n + (i & 3); }

struct Unit { const char* a; const char* b; int nt, pm, pn, ks; };
struct Gemm { int lda, ldb; };

struct TileSched {
    const char* A; const char* Bt; size_t tA, tB;
    int nM, nN, nt, nwg, G, c, s_pm0, s_nM, s_splits, s_nt;
    __device__ void init(const bf16_t* A_, const bf16_t* Bt_, int lda, int ldb, int M, int N, int K, int G_, int c_) {
        A = (const char*)A_; Bt = (const char*)Bt_; tA = (size_t)BM * lda * 2; tB = (size_t)BM * ldb * 2; nM = M / BM; nN = N / BM; nt = K / BK; nwg = nM * nN; G = G_; c = c_; s_pm0 = 0; s_nM = 0; s_splits = 0; s_nt = 0; }
    __device__ bool next(int i, Unit& u) const {
        long L = (long)i * G + c;
        if (L < nwg) {
            int wgid = (int)L; { const int q = nwg / NXCD, r = nwg % NXCD, xcd = wgid % NXCD, off = wgid / NXCD; wgid = (xcd < r ? xcd * (q + 1) : r * (q + 1) + (xcd - r) * q) + off; }
            const int nig = WGM * nN, gid = wgid / nig, fm = gid * WGM, gsz = (nM - fm) < WGM ? (nM - fm) : WGM;
            u.pm = fm + ((wgid % nig) % gsz); u.pn = (wgid % nig) / gsz; u.nt = nt; u.ks = -1;
            u.a = A + (size_t)u.pm * tA; u.b = Bt + (size_t)u.pn * tB; return true; }
        L -= nwg; const int per = s_nM * nN;
        if (L >= (long)per * s_splits) return false;
        const int ks = (int)L / per, rem = (int)L % per;
        u.pm = s_pm0 + rem % s_nM; u.pn = rem / s_nM; u.nt = s_nt; u.ks = ks;
        u.a = A + (size_t)u.pm * tA + (size_t)ks * s_nt * (BK * 2); u.b = Bt + (size_t)u.pn * tB + (size_t)ks * s_nt * (BK * 2); return true;
    }
};

__device__ __forceinline__ unsigned cvt_pk_bf16(float lo, float hi) { unsigned r; asm volatile("v_cvt_pk_bf16_f32 %0, %1, %2" : "=v"(r) : "v"(lo), "v"(hi)); return r; }

struct EpiF32 {
    static constexpr bool PERM = false, HAS_MID = false;
    float* C; int ldc; const float* bias;
    __device__ __forceinline__ void mid(f32x4 (&acc)[2][2][4][2], const Unit& u, int wr, int wc, int fr, int fq) const {}
    __device__ __forceinline__ void operator()(const f32x4 (&acc)[2][2][4][2], const Unit& u, int wr, int wc, int fr, int fq) const {
        const int row0 = u.pm * BM + wr * 64 + fr, col0 = u.pn * BM + wc * 32 + 4 * fq;
        f32x4 bv[2][2];
#pragma unroll
        for (int bj = 0; bj < 2; ++bj)
#pragma unroll
            for (int n = 0; n < 2; ++n) bv[bj][n] = *(const f32x4*)(bias + col0 + bj * HALF + n * 16);
#pragma unroll
        for (int ai = 0; ai < 2; ++ai)
#pragma unroll
            for (int m = 0; m < 4; ++m) { float* rowp = C + (size_t)(row0 + ai * HALF + m * 16) * ldc + col0;
#pragma unroll
                for (int bj = 0; bj < 2; ++bj)
#pragma unroll
                    for (int n = 0; n < 2; ++n) *(f32x4*)(rowp + bj * HALF + n * 16) = acc[ai][bj][m][n] + bv[bj][n]; }
    }
};
struct EpiBf16 {
    static constexpr bool PERM = true, HAS_MID = false;
    bf16_t* O; int ldc;
    __device__ __forceinline__ void mid(f32x4 (&acc)[2][2][4][2], const Unit& u, int wr, int wc, int fr, int fq) const {}
    __device__ __forceinline__ void operator()(const f32x4 (&acc)[2][2][4][2], const Unit& u, int wr, int wc, int fr, int fq) const {
        const int row0 = u.pm * BM + wr * 64 + fr, col0 = u.pn * BM + wc * 32 + 8 * fq;
#pragma unroll
        for (int ai = 0; ai < 2; ++ai)
#pragma unroll
            for (int m = 0; m < 4; ++m) { bf16_t* rowp = O + (size_t)(row0 + ai * HALF + m * 16) * ldc + col0;
#pragma unroll
                for (int bj = 0; bj < 2; ++bj) { const f32x4 v0 = acc[ai][bj][m][0], v1 = acc[ai][bj][m][1];
                    u32x4 w; w.x = cvt_pk_bf16(v0[0], v0[1]); w.y = cvt_pk_bf16(v0[2], v0[3]); w.z = cvt_pk_bf16(v1[0], v1[1]); w.w = cvt_pk_bf16(v1[2], v1[3]);
                    *(u32x4*)(rowp + bj * HALF) = w; } }
    }
};
struct EpiSwiglu {
    static constexpr bool PERM = true, HAS_MID = false;
    bf16_t* H;
    __device__ __forceinline__ void mid(f32x4 (&acc)[2][2][4][2], const Unit& u, int wr, int wc, int fr, int fq) const {}
    __device__ __forceinline__ void operator()(const f32x4 (&acc)[2][2][4][2], const Unit& u, int wr, int wc, int fr, int fq) const {
        const int row0 = u.pm * BM + wr * 64 + fr, col0 = u.pn * HALF + wc * 32 + 8 * fq;
#pragma unroll
        for (int ai = 0; ai < 2; ++ai)
#pragma unroll
            for (int m = 0; m < 4; ++m) { bf16_t* rowp = H + (size_t)(row0 + ai * HALF + m * 16) * DFF + col0;
                float o[8];
#pragma unroll
                for (int n = 0; n < 2; ++n)
#pragma unroll
                    for (int j = 0; j < 4; ++j) { const float g = acc[ai][0][m][n][j], v = acc[ai][1][m][n][j]; o[n * 4 + j] = g * sigmoid_fast(g) * v; }
                u32x4 w; w.x = cvt_pk_bf16(o[0], o[1]); w.y = cvt_pk_bf16(o[2], o[3]); w.z = cvt_pk_bf16(o[4], o[5]); w.w = cvt_pk_bf16(o[6], o[7]);
                *(u32x4*)rowp = w; }
    }
};
struct EpiResid {
    static constexpr bool PERM = false, HAS_MID = false;
    const float* xp; const float* xs; float* X; const float* MOD; int gk; float coef; float* PART;
    __device__ __forceinline__ void mid(f32x4 (&acc)[2][2][4][2], const Unit& u, int wr, int wc, int fr, int fq) const {}
    __device__ __forceinline__ void operator()(const f32x4 (&acc)[2][2][4][2], const Unit& u, int wr, int wc, int fr, int fq) const {
        const int row0 = u.pm * BM + wr * 64 + fr, col0 = u.pn * BM + wc * 32 + 4 * fq;
        if (u.ks >= 0) {
#pragma unroll
            for (int ai = 0; ai < 2; ++ai)
#pragma unroll
                for (int m = 0; m < 4; ++m) { float* orow = PART + ((size_t)u.ks * NS + (row0 + ai * HALF + m * 16 - NP)) * DM + col0;
#pragma unroll
                    for (int bj = 0; bj < 2; ++bj)
#pragma unroll
                        for (int n = 0; n < 2; ++n) *(f32x4*)(orow + bj * HALF + n * 16) = acc[ai][bj][m][n]; }
            return; }
        const bool samp = u.pm >= NP / BM;
        f32x4 gv[2][2];
        if (!samp) { const float* md = MOD + (size_t)(u.pm >> 3) * NMOD + gk * DM + col0;
#pragma unroll
            for (int bj = 0; bj < 2; ++bj)
#pragma unroll
                for (int n = 0; n < 2; ++n) gv[bj][n] = *(const f32x4*)(md + bj * HALF + n * 16) * coef; }
#pragma unroll
        for (int ai = 0; ai < 2; ++ai)
#pragma unroll
            for (int m = 0; m < 4; ++m) { const int row = row0 + ai * HALF + m * 16;
                const float* xrow = (samp ? xs + (size_t)(row - NP) * DM : xp + (size_t)row * DM) + col0;
                if (samp) { const float* md = MOD + (size_t)(4 + ((row - NP) >> 2)) * NMOD + gk * DM + col0;
#pragma unroll
                    for (int bj = 0; bj < 2; ++bj)
#pragma unroll
                        for (int n = 0; n < 2; ++n) gv[bj][n] = *(const f32x4*)(md + bj * HALF + n * 16) * coef; }
                float* orow = X + (size_t)row * DM + col0;
#pragma unroll
                for (int bj = 0; bj < 2; ++bj)
#pragma unroll
                    for (int n = 0; n < 2; ++n) { const f32x4 xv = *(const f32x4*)(xrow + bj * HALF + n * 16); *(f32x4*)(orow + bj * HALF + n * 16) = xv * ALPHA + gv[bj][n] * acc[ai][bj][m][n]; }
                asm volatile("" ::: "memory"); }
    }
};
struct EpiMerge {
    static constexpr bool PERM = true, HAS_MID = true;
    const bf16_t* PROJ; bf16_t* O;
    __device__ __forceinline__ void mid(f32x4 (&acc)[2][2][4][2], const Unit& u, int wr, int wc, int fr, int fq) const {
        unsigned off = (unsigned)((u.pm * BM + wr * 64 + fr) * INC + u.pn * BM + wc * 32 + 8 * fq) * 2u;
        asm volatile("" : "+v"(off));
        const char* base = (const char*)PROJ;
#pragma unroll
        for (int ai = 0; ai < 2; ++ai) {
#pragma unroll
            for (int m = 0; m < 4; ++m) { const unsigned ro = off + (unsigned)((ai * HALF + m * 16) * INC * 2);
#pragma unroll
                for (int bj = 0; bj < 2; ++bj) { const u32x4 a = *(const u32x4*)(base + ro + (4096 + bj * HALF) * 2), b = *(const u32x4*)(base + ro + (6144 + bj * HALF) * 2);
#pragma unroll
                    for (int q = 0; q < 4; ++q) { const float a0 = fminf(fmaxf(bflo(a[q]), -30.f), 30.f), a1 = fminf(fmaxf(bfhi(a[q]), -30.f), 30.f), b0 = fminf(fmaxf(bflo(b[q]), -30.f), 30.f), b1 = fminf(fmaxf(bfhi(b[q]), -30.f), 30.f);
                        const float r0 = (1.0f + __expf(-b0)) * __builtin_amdgcn_rcpf(1.0f + __expf(-a0)), r1 = (1.0f + __expf(-b1)) * __builtin_amdgcn_rcpf(1.0f + __expf(-a1));
                        acc[ai][bj][m][q >> 1][(q & 1) * 2] *= r0; acc[ai][bj][m][q >> 1][(q & 1) * 2 + 1] *= r1; } } }
            asm volatile("" ::: "memory"); }
    }
    __device__ __forceinline__ void operator()(const f32x4 (&acc)[2][2][4][2], const Unit& u, int wr, int wc, int fr, int fq) const {
        const int row0 = u.pm * BM + wr * 64 + fr, col0 = u.pn * BM + wc * 32 + 8 * fq;
#pragma unroll
        for (int ai = 0; ai < 2; ++ai)
#pragma unroll
            for (int m = 0; m < 4; ++m) { const size_t row = (size_t)(row0 + ai * HALF + m * 16); const bf16_t* pr = PROJ + row * INC + 6144 + col0; bf16_t* orow = O + row * DM + col0;
#pragma unroll
                for (int bj = 0; bj < 2; ++bj) { const u32x4 b = *(const u32x4*)(pr + bj * HALF); u32x4 w;
#pragma unroll
                    for (int q = 0; q < 4; ++q) { const float b0 = fminf(fmaxf(bflo(b[q]), -30.f), 30.f), b1 = fminf(fmaxf(bfhi(b[q]), -30.f), 30.f);
                        w[q] = cvt_pk_bf16(acc[ai][bj][m][q >> 1][(q & 1) * 2] * sigmoid_fast(b0), acc[ai][bj][m][q >> 1][(q & 1) * 2 + 1] * sigmoid_fast(b1)); }
                    *(u32x4*)(orow + bj * HALF) = w; }
                asm volatile("" ::: "memory"); }
    }
};

template <class Epi, class Sched>
__device__ __forceinline__ void gemm_phase(LAS unsigned char* lds, const Gemm g, const Sched& S, const Epi& E) {
    int tid_ = threadIdx.x; asm volatile("" : "+v"(tid_));
    const int tid = tid_, wid = __builtin_amdgcn_readfirstlane(tid >> 6), lane = tid & 63, wr = wid >> 2, wc = wid & 3, fr = lane & 15, fq = lane >> 4;
    unsigned voffA[2], voffB[2];
#pragma unroll
    for (int i = 0; i < 2; ++i) { int R, C; stage_rc(tid * 16 + i * 8192, R, C); const int Rb = Epi::PERM ? ((R & ~31) + perm32(R & 31)) : R;
        voffA[i] = (unsigned)(R * g.lda + C) * 2u; voffB[i] = (unsigned)(Rb * g.ldb + C) * 2u; }
    const size_t kstep = (size_t)(BK * 2);
    const size_t hA = (size_t)HALF * g.lda * 2, hB = (size_t)HALF * g.ldb * 2;
    const unsigned ldsw = (unsigned)wid * 1024u;
    const int aoff = lds_byte(wr * 64 + fr, fq * 8), boff = lds_byte(wc * 32 + fr, fq * 8);
#define PG8_SA(b, h) (((b) * 2 + (h)) * HTB)
#define PG8_SB(b, h) ((4 + (b) * 2 + (h)) * HTB)
#define PG8_STAGE(bufoff, gbase, voff) do { _Pragma("unroll") for (int _i = 0; _i < 2; ++_i) \
        __builtin_amdgcn_global_load_lds((const unsigned*)((const char*)(gbase) + (voff)[_i]), (LAS unsigned*)(lds + (bufoff) + ldsw + _i * 8192), 16, 0, 0); } while (0)
#define PG8_LDA(dst, b, h) do { _Pragma("unroll") for (int m = 0; m < 4; ++m) _Pragma("unroll") for (int k = 0; k < 2; ++k) dst[m][k] = *(const LAS bf16x8*)(lds + PG8_SA(b, h) + aoff + m * 2048 + k * 1024); } while (0)
#define PG8_LDB(dst, b, h) do { _Pragma("unroll") for (int n = 0; n < 2; ++n) _Pragma("unroll") for (int k = 0; k < 2; ++k) dst[n][k] = *(const LAS bf16x8*)(lds + PG8_SB(b, h) + boff + n * 2048 + k * 1024); } while (0)
#define PG8_MMA(ai, bj, At, Bt) do { __builtin_amdgcn_s_setprio(1); _Pragma("unroll") for (int m = 0; m < 4; ++m) _Pragma("unroll") for (int n = 0; n < 2; ++n) _Pragma("unroll") for (int k = 0; k < 2; ++k) \
        acc[ai][bj][m][n] = __builtin_amdgcn_mfma_f32_16x16x32_bf16(Bt[n][k], At[m][k], acc[ai][bj][m][n], 0, 0, 0); __builtin_amdgcn_s_setprio(0); } while (0)
#define PG8_WAIT_V(n) asm volatile("s_waitcnt vmcnt(" #n ")" ::: "memory")
#define PG8_WAIT_L(n) asm volatile("s_waitcnt lgkmcnt(" #n ")" ::: "memory")
#define PG8_BAR __builtin_amdgcn_s_barrier()
#define PG8_SCHED __builtin_amdgcn_sched_barrier(0)
    Unit cur, nxt; int ui = 0;
    if (!S.next(0, cur)) return;
    f32x4 acc[2][2][4][2];
#pragma unroll
    for (int a = 0; a < 2; ++a)
#pragma unroll
        for (int b = 0; b < 2; ++b)
#pragma unroll
            for (int m = 0; m < 4; ++m)
#pragma unroll
                for (int n = 0; n < 2; ++n) acc[a][b][m][n] = (f32x4){0.f, 0.f, 0.f, 0.f};
    bf16x8 At[4][2], B0[2][2], B1[2][2];
    const char* cA = cur.a; const char* cB = cur.b;
    PG8_STAGE(PG8_SB(0, 0), cB, voffB); PG8_STAGE(PG8_SB(0, 1), cB + hB, voffB); PG8_STAGE(PG8_SA(0, 0), cA, voffA); PG8_STAGE(PG8_SA(0, 1), cA + hA, voffA);
    if (wr == 1) PG8_BAR;
    PG8_WAIT_V(2); PG8_BAR;
    PG8_STAGE(PG8_SB(1, 0), cB + kstep, voffB); PG8_STAGE(PG8_SA(1, 0), cA + kstep, voffA); PG8_STAGE(PG8_SB(1, 1), cB + hB + kstep, voffB);
    PG8_WAIT_V(6); PG8_BAR;
    for (;;) {
        const bool has_next = S.next(ui + 1, nxt);
        const char* nA = has_next ? nxt.a : cA; const char* nB = has_next ? nxt.b : cB;
        const int nt = cur.nt, tmid = nt >> 1;
        for (int t = 0; t < nt; t += 2) {
            const bool last = (t == nt - 2);
            const char* a1 = cA + (size_t)(t + 1) * kstep;
            const char* a2 = last ? nA : cA + (size_t)(t + 2) * kstep; const char* b2 = last ? nB : cB + (size_t)(t + 2) * kstep;
            const char* a3 = a2 + kstep; const char* b3 = b2 + kstep;
            if constexpr (Epi::HAS_MID) { if (t == tmid) E.mid(acc, cur, wr, wc, fr, fq); }
            PG8_LDB(B0, 0, 0); PG8_LDB(B1, 0, 1); PG8_SCHED; PG8_LDA(At, 0, 0); PG8_STAGE(PG8_SA(1, 1), a1 + hA, voffA);
            PG8_WAIT_V(8); PG8_WAIT_L(0); PG8_BAR; PG8_MMA(0, 0, At, B0); PG8_MMA(0, 1, At, B1); PG8_BAR; PG8_SCHED;
            PG8_LDA(At, 0, 1); PG8_STAGE(PG8_SB(0, 0), b2, voffB); PG8_STAGE(PG8_SB(0, 1), b2 + hB, voffB); PG8_STAGE(PG8_SA(0, 0), a2, voffA);
            PG8_WAIT_V(8); PG8_WAIT_L(0); PG8_BAR; PG8_MMA(1, 0, At, B0); PG8_MMA(1, 1, At, B1); PG8_BAR; PG8_SCHED;
            PG8_LDB(B0, 1, 0); PG8_LDB(B1, 1, 1); PG8_SCHED; PG8_LDA(At, 1, 0); PG8_STAGE(PG8_SA(0, 1), a2 + hA, voffA);
            PG8_WAIT_V(8); PG8_WAIT_L(0); PG8_BAR; PG8_MMA(0, 0, At, B0); PG8_MMA(0, 1, At, B1); PG8_BAR; PG8_SCHED;
            PG8_LDA(At, 1, 1); PG8_STAGE(PG8_SB(1, 0), b3, voffB); PG8_STAGE(PG8_SB(1, 1), b3 + hB, voffB); PG8_STAGE(PG8_SA(1, 0), a3, voffA);
            PG8_WAIT_V(8); PG8_WAIT_L(0); PG8_BAR; PG8_MMA(1, 0, At, B0); PG8_MMA(1, 1, At, B1); PG8_BAR; PG8_SCHED;
        }
        if (wr == 0) PG8_BAR;
        E(acc, cur, wr, wc, fr, fq);
        if (!has_next) break;
#pragma unroll
        for (int a = 0; a < 2; ++a)
#pragma unroll
            for (int b = 0; b < 2; ++b)
#pragma unroll
                for (int m = 0; m < 4; ++m)
#pragma unroll
                    for (int n = 0; n < 2; ++n) acc[a][b][m][n] = (f32x4){0.f, 0.f, 0.f, 0.f};
        cur = nxt; cA = nA; cB = nB; ++ui;
        if (wr == 1) PG8_BAR;
    }
    PG8_WAIT_V(0);
    PG8_BAR;
#undef PG8_SA
#undef PG8_SB
#undef PG8_STAGE
#undef PG8_LDA
#undef PG8_LDB
#undef PG8_MMA
#undef PG8_WAIT_V
#undef PG8_WAIT_L
#undef PG8_BAR
#undef PG8_SCHED
}
}


#define XB_TMO      128
#define XB_XCNT(j)  (256  + 64 * (j))
#define XB_XSUB(j)  (1280 + 64 * (j))
#define XB_XGEN(j)  (2304 + 64 * (j))
#define XB_TOP      3328
#define XB_TOPGEN   3392
#define XCD_BAR_WORDS 3456
#define XB_SPIN_CAP (1u << 18)
__device__ __forceinline__ unsigned xb_ld(unsigned* p)              { return __hip_atomic_load(p, __ATOMIC_RELAXED, __HIP_MEMORY_SCOPE_AGENT); }
__device__ __forceinline__ unsigned xb_add(unsigned* p, unsigned v) { return __hip_atomic_fetch_add(p, v, __ATOMIC_RELAXED, __HIP_MEMORY_SCOPE_AGENT); }
__device__ __forceinline__ unsigned xb_xcc_id() { return (unsigned)__builtin_amdgcn_s_getreg((3 << 11) | 20) & 0xFu; }
#define XB_SPIN(cond, bar) do { unsigned _sp = 0; while (cond) { __builtin_amdgcn_s_sleep(1); \
    if ((++_sp & 255u) == 0u) { if (xb_ld(&(bar)[XB_TMO])) break; if (_sp > XB_SPIN_CAP) { atomicAdd(&(bar)[XB_TMO], 1u); break; } } } } while (0)
struct XcdBarrier { unsigned* bar; unsigned x; volatile LAS unsigned* st; };
__device__ __forceinline__ XcdBarrier xcd_barrier_post(unsigned* bar, volatile LAS unsigned* st) {
    XcdBarrier b; b.bar = bar; b.x = xb_xcc_id(); b.st = st;
    if (threadIdx.x == 0) (void)xb_add(&bar[XB_XCNT(b.x)], 1u);
    return b;
}
__device__ __forceinline__ void xcd_barrier_complete(unsigned* bar, unsigned x, unsigned& nloc, unsigned& nx) {
    const unsigned G = gridDim.x * gridDim.y * gridDim.z;
    unsigned sum, cnt, mine, sp = 0u;
    for (;;) {
        sum = 0u; cnt = 0u; mine = 0u;
#pragma unroll
        for (unsigned j = 0; j < 16; ++j) { const unsigned c = xb_ld(&bar[XB_XCNT(j)]); sum += c; cnt += (c > 0u) ? 1u : 0u; mine = (j == x) ? c : mine; }
        if (sum == G) break;
        __builtin_amdgcn_s_sleep(1);
        if ((++sp & 255u) == 0u) { if (xb_ld(&bar[XB_TMO])) break; if (sp > XB_SPIN_CAP) { atomicAdd(&bar[XB_TMO], 1u); break; } }
    }
    nloc = mine > 0u ? mine : 1u; nx = cnt > 0u ? cnt : 1u;
}
__device__ __forceinline__ void xcd_barrier(const XcdBarrier& b) {
    asm volatile("s_waitcnt vmcnt(0)" ::: "memory");
    __syncthreads();
    if (threadIdx.x == 0) {
        unsigned* bar = b.bar;
        __builtin_amdgcn_s_waitcnt(0);
        unsigned nloc = b.st[0], nx = b.st[1];
        if (nloc == 0u) { xcd_barrier_complete(bar, b.x, nloc, nx); b.st[0] = nloc; b.st[1] = nx; }
        const unsigned old = xb_add(&bar[XB_XSUB(b.x)], 1u);
        const unsigned gen = old / nloc;
        if (old + 1u == (gen + 1u) * nloc) {
            __builtin_amdgcn_fence(__ATOMIC_RELEASE, "agent");
            asm volatile("s_waitcnt vmcnt(0)" ::: "memory");
            const unsigned og = xb_add(&bar[XB_TOP], 1u);
            const unsigned tg = og / nx;
            if (og + 1u == (tg + 1u) * nx) xb_add(&bar[XB_TOPGEN], 1u);
            else XB_SPIN(xb_ld(&bar[XB_TOPGEN]) == tg, bar);
            __builtin_amdgcn_fence(__ATOMIC_ACQUIRE, "agent");
            xb_add(&bar[XB_XGEN(b.x)], 1u);
            asm volatile("s_waitcnt vmcnt(0)" ::: "memory");
        } else {
            XB_SPIN(xb_ld(&bar[XB_XGEN(b.x)]) == gen, bar);
            __builtin_amdgcn_fence(__ATOMIC_ACQUIRE, "agent");
            asm volatile("s_waitcnt vmcnt(0)" ::: "memory");
        }
    }
    __syncthreads();
}

struct Args { const float* in[29]; float* out; unsigned char* ws; int ph_lo, ph_hi; };
enum { I_XP = 0, I_XS, I_SCONV, I_SH, I_CP, I_CS, I_WADA, I_BADA, I_F1GU, I_F1D, I_F2GU, I_F2D, I_WIN, I_CONVW, I_CONVB, I_LWA, I_LBA, I_LWX, I_LBX, I_LAM, I_GLNG, I_GLNB, I_GWS, I_GBS, I_WPA, I_WPB, I_WOUT, I_LNG, I_LNB };
constexpr int NPHASE = 15;

__device__ __forceinline__ void transpose_item(const float* W, int N, bf16_t* WT, int ldd, int koff, int mode, LAS float* scr, int item, int lane) {
    const int nblk = N / 32, kb = item / nblk, nb = item % nblk, k0 = 64 * kb, n0 = 32 * nb;
#pragma unroll 8
    for (int i = 0; i < 32; ++i) { const int kk = 2 * i + (lane >> 5); scr[kk * 33 + (lane & 31)] = W[(size_t)(k0 + kk) * N + n0 + (lane & 31)]; }
    LDS_WAIT(); asm volatile("" ::: "memory");
    int d0 = n0;
    if (mode == 1) { const int half = n0 >= DFF ? 1 : 0, jj = n0 - half * DFF; d0 = 256 * (jj >> 7) + 128 * half + (jj & 127); }
    const int c = lane & 7;
#pragma unroll
    for (int j = 0; j < 4; ++j) { const int n = (lane >> 3) + 8 * j; const LAS float* s = scr + (8 * c) * 33 + n;
        u32x4 o; o.x = pk2(s[0 * 33], s[1 * 33]); o.y = pk2(s[2 * 33], s[3 * 33]); o.z = pk2(s[4 * 33], s[5 * 33]); o.w = pk2(s[6 * 33], s[7 * 33]);
        *(u32x4*)(WT + (size_t)(d0 + n) * ldd + koff + k0 + 8 * c) = o; }
    LDS_WAIT(); asm volatile("" ::: "memory");
}


template <int MODE> __device__ __forceinline__ void lru_item(const Args& args, const bf16_t* PROJ, const bf16_t* WLRU, bf16_t* YAB, float* SEGA, float* SEGH, float* out, LAS unsigned char* wl, int it, int lane) {
    const int n = it & 15, e = lane, ch = n * 64 + e, fr = lane & 15, fq = lane >> 4;
    int b = 0, seg = 0, row0, b0 = 0;
    if (MODE == 2) { b0 = (it >> 4) * 4; row0 = NP + b0 * 4; } else { const int idx = it >> 4; b = idx >> 5; seg = idx & 31; row0 = b * SEQ + seg * SEGL; }
    LAS bf16_t* XA = (LAS bf16_t*)wl; LAS float* PR = (LAS float*)(wl + 2304); LAS float* PI = (LAS float*)(wl + 6400);
    bf16x8 wfa[4][2], wfx[4][2];
#pragma unroll
    for (int et = 0; et < 4; ++et)
#pragma unroll
        for (int kc = 0; kc < 2; ++kc) { wfa[et][kc] = *(const bf16x8*)(WLRU + ((size_t)(n * 64 + 16 * et + fr)) * 64 + 32 * kc + 8 * fq); wfx[et][kc] = *(const bf16x8*)(WLRU + ((size_t)((16 + n) * 64 + 16 * et + fr)) * 64 + 32 * kc + 8 * fq); }
    const float cw0 = args.in[I_CONVW][ch], cw1 = args.in[I_CONVW][DR + ch], cw2 = args.in[I_CONVW][2 * DR + ch], cw3 = args.in[I_CONVW][3 * DR + ch], cbv = args.in[I_CONVB][ch];
    const float ba = args.in[I_LBA][ch], bxv = args.in[I_LBX][ch];
    const float sp8 = -8.0f * log1pf(expf(-args.in[I_LAM][ch]));
    float x1 = 0.f, x2 = 0.f, x3 = 0.f, h = 0.f, P = 1.f;
    if (MODE != 2 && seg > 0) { x1 = bf2f(PROJ[(size_t)(row0 - 1) * INC + ch]); x2 = bf2f(PROJ[(size_t)(row0 - 2) * INC + ch]); x3 = bf2f(PROJ[(size_t)(row0 - 3) * INC + ch]); }
    if (MODE == 1) {
        for (int s0 = 0; s0 < seg; s0 += 8) { float av[8], hv[8];
#pragma unroll
            for (int j = 0; j < 8; ++j) { const int s = s0 + j < seg ? s0 + j : seg - 1; av[j] = SEGA[(size_t)(b * NSEG + s) * DR + ch]; hv[j] = SEGH[(size_t)(b * NSEG + s) * DR + ch]; }
#pragma unroll
            for (int j = 0; j < 8; ++j) if (s0 + j < seg) h = av[j] * h + hv[j]; }
    }
    constexpr int NTILE = MODE == 2 ? 1 : 4;
    bf16_t xn[16], gn[16];
#pragma unroll
    for (int t = 0; t < 16; ++t) { const size_t row = (size_t)(row0 + t); xn[t] = PROJ[row * INC + ch]; if (MODE != 0) gn[t] = PROJ[row * INC + DR + ch]; }
    for (int tile = 0; tile < NTILE; ++tile) {
        float xv[16], grv[16], xc[16];
#pragma unroll
        for (int t = 0; t < 16; ++t) { xv[t] = bf2f(xn[t]); if (MODE != 0) grv[t] = bf2f(gn[t]); }
        if (tile + 1 < NTILE) {
#pragma unroll
            for (int t = 0; t < 16; ++t) { const size_t row = (size_t)(row0 + (tile + 1) * 16 + t); xn[t] = PROJ[row * INC + ch]; if (MODE != 0) gn[t] = PROJ[row * INC + DR + ch]; } }
#pragma unroll
        for (int t = 0; t < 16; ++t) {
            if (MODE == 2 && (t & 3) == 0) { const size_t bg = (size_t)(b0 + tile * 4 + (t >> 2)); x3 = args.in[I_SCONV][(bg * 3 + 0) * DR + ch]; x2 = args.in[I_SCONV][(bg * 3 + 1) * DR + ch]; x1 = args.in[I_SCONV][(bg * 3 + 2) * DR + ch]; }
            xc[t] = cbv + cw0 * x3 + cw1 * x2 + cw2 * x1 + cw3 * xv[t];
            x3 = x2; x2 = x1; x1 = xv[t];
            XA[t * 72 + e] = (bf16_t)f2bf(xc[t]); }
        LDS_WAIT();
        bf16x8 yf[2];
#pragma unroll
        for (int kc = 0; kc < 2; ++kc) yf[kc] = *(const LAS bf16x8*)(XA + fr * 72 + 32 * kc + 8 * fq);
#pragma unroll
        for (int et = 0; et < 4; ++et) { f32x4 dr = (f32x4){0.f, 0.f, 0.f, 0.f}, di = (f32x4){0.f, 0.f, 0.f, 0.f};
            dr = __builtin_amdgcn_mfma_f32_16x16x32_bf16(yf[0], wfa[et][0], dr, 0, 0, 0); dr = __builtin_amdgcn_mfma_f32_16x16x32_bf16(yf[1], wfa[et][1], dr, 0, 0, 0);
            di = __builtin_amdgcn_mfma_f32_16x16x32_bf16(yf[0], wfx[et][0], di, 0, 0, 0); di = __builtin_amdgcn_mfma_f32_16x16x32_bf16(yf[1], wfx[et][1], di, 0, 0, 0);
#pragma unroll
            for (int r = 0; r < 4; ++r) { PR[(4 * fq + r) * 64 + 16 * et + fr] = dr[r]; PI[(4 * fq + r) * 64 + 16 * et + fr] = di[r]; } }
        LDS_WAIT();
#pragma unroll
        for (int t = 0; t < 16; ++t) {
            const float pr = PR[t * 64 + e] + ba, pi = PI[t * 64 + e] + bxv;
            const float rg = sigmoid_fast(pr), ig = sigmoid_fast(pi);
            const float la = sp8 * rg, a = __expf(la), x = 2.0f * la;
            const float em = -x * (1.0f + x * (0.5f + x * (0.16666667f + x * (0.041666668f + x * (0.0083333338f + x * 0.0013888889f)))));
            float mult = sqrtf(em);
            if (MODE != 2 && seg == 0 && tile == 0 && t == 0) mult = 1.0f;
            if (MODE == 2 && (t & 3) == 0) h = args.in[I_SH][(size_t)(b0 + tile * 4 + (t >> 2)) * DR + ch];
            h = a * h + mult * ig * xc[t];
            if (MODE == 0) P *= a;
            if (MODE != 0) { const size_t row = (size_t)(row0 + tile * 16 + t); YAB[row * DM + ch] = (bf16_t)f2bf(h * gelu_tanh(grv[t])); }
            if (MODE == 2) { const size_t bg = (size_t)(b0 + tile * 4 + (t >> 2)); if ((t & 3) == 3) out[O_HS + bg * DR + ch] = h; if ((t & 3) != 0) out[O_CS + (bg * 3 + (t & 3) - 1) * DR + ch] = xv[t]; }
            if (MODE == 1 && seg == NSEG - 1 && tile == 3) { if (t == 15) out[O_HP + (size_t)b * DR + ch] = h; if (t >= 13) out[O_CP + ((size_t)b * 3 + (t - 13)) * DR + ch] = xv[t]; }
        }
        LDS_WAIT();
    }
    if (MODE == 0) { SEGA[(size_t)(b * NSEG + seg) * DR + ch] = P; SEGH[(size_t)(b * NSEG + seg) * DR + ch] = h; }
}

template <int KIND> __device__ __forceinline__ void phase_body(const Args& args, const int ph, LAS unsigned char* lds) {

    int tid_ = threadIdx.x; asm volatile("" : "+v"(tid_));
    const int tid = tid_, lane = tid & 63, wave = __builtin_amdgcn_readfirstlane(tid >> 6);
    int bx_ = blockIdx.x; asm volatile("" : "+s"(bx_));
    const int G = gridDim.x, bx = bx_;
    const int gw = bx * NWAVES + wave, NGW = G * NWAVES;
    unsigned char* ws = args.ws; asm volatile("" : "+s"(ws));
    bf16_t* W1GU = (bf16_t*)(ws + OFF_W1GU); bf16_t* W1D = (bf16_t*)(ws + OFF_W1D); bf16_t* W2GU = (bf16_t*)(ws + OFF_W2GU); bf16_t* W2D = (bf16_t*)(ws + OFF_W2D);
    bf16_t* WIN = (bf16_t*)(ws + OFF_WIN); bf16_t* WPAB = (bf16_t*)(ws + OFF_WPAB); bf16_t* WOUT = (bf16_t*)(ws + OFF_WOUT); bf16_t* WADA = (bf16_t*)(ws + OFF_WADA);
    bf16_t* SC = (bf16_t*)(ws + OFF_SC); float* MOD = (float*)(ws + OFF_MOD); bf16_t* U = (bf16_t*)(ws + OFF_U); bf16_t* YAB = (bf16_t*)(ws + OFF_YAB);
    float* X = (float*)(ws + OFF_X); bf16_t* HP = (bf16_t*)(ws + OFF_HP); float* HL = (float*)(ws + OFF_HL); float* PP = (float*)(ws + OFF_PP);
    float* SEGA = (float*)(ws + OFF_SEG); float* SEGH = SEGA + 4 * NSEG * DR;
    float* out = args.out;

        if constexpr (KIND == 0) {
            LAS float* scr = (LAS float*)(lds + wave * 16384);
            constexpr int I_ADA = 32 * (NMOD / 32), I_GU = 32 * (2 * DFF / 32), I_D = (DFF / 64) * (DM / 32), I_IN = 32 * (INC / 32), I_PA = (DR / 64) * (DM / 32), I_OUT = 32 * (DM / 32);
            constexpr int NIT = I_ADA + 2 * I_GU + 2 * I_D + I_IN + 2 * I_PA + I_OUT;
            for (int it = gw; it < NIT; it += NGW) {
                int r = it;
                if (r < I_ADA) { transpose_item(args.in[I_WADA], NMOD, WADA, DM, 0, 0, scr, r, lane); continue; } r -= I_ADA;
                if (r < I_GU) { transpose_item(args.in[I_F1GU], 2 * DFF, W1GU, DM, 0, 1, scr, r, lane); continue; } r -= I_GU;
                if (r < I_D) { transpose_item(args.in[I_F1D], DM, W1D, DFF, 0, 0, scr, r, lane); continue; } r -= I_D;
                if (r < I_IN) { transpose_item(args.in[I_WIN], INC, WIN, DM, 0, 0, scr, r, lane); continue; } r -= I_IN;
                if (r < I_PA) { transpose_item(args.in[I_WPA], DM, WPAB, DM, 0, 0, scr, r, lane); continue; } r -= I_PA;
                if (r < I_PA) { transpose_item(args.in[I_WPB], DM, WPAB, DM, DR, 0, scr, r, lane); continue; } r -= I_PA;
                if (r < I_OUT) { transpose_item(args.in[I_WOUT], DM, WOUT, DM, 0, 0, scr, r, lane); continue; } r -= I_OUT;
                if (r < I_GU) { transpose_item(args.in[I_F2GU], 2 * DFF, W2GU, DM, 0, 1, scr, r, lane); continue; } r -= I_GU;
                transpose_item(args.in[I_F2D], DM, W2D, DFF, 0, 0, scr, r, lane);
            }
            for (int i = bx * 512 + tid; i < 256 * DM / 2; i += G * 512) { const int row = i / (DM / 2), c2 = (i % (DM / 2)) * 2;
                float v0 = 0.f, v1 = 0.f;
                if (row < 132) { const float* cp = row < 4 ? args.in[I_CP] + (size_t)row * DM : args.in[I_CS] + (size_t)(row - 4) * DM; const float a = cp[c2], b = cp[c2 + 1]; v0 = a / (1.0f + expf(-a)); v1 = b / (1.0f + expf(-b)); }
                ((unsigned*)SC)[i] = pk2(v0, v1); }
            for (int i = bx * 512 + tid; i < 2 * 16 * 64 * 64; i += G * 512) { const int gate = i >> 16, n = (i >> 12) & 15, e = (i >> 6) & 63, d = i & 63;
                ((bf16_t*)(ws + OFF_WLRU))[i] = (bf16_t)f2bf(args.in[gate ? I_LWX : I_LWA][(size_t)n * 4096 + d * 64 + e]); }
        }
        if constexpr (KIND == 1) {
            pg8::Gemm g{DM, DM}; pg8::TileSched S; S.init(SC, WADA, DM, DM, 256, NMOD, DM, G, bx);
            pg8::EpiF32 E{MOD, NMOD, args.in[I_BADA]};
            pg8::gemm_phase<pg8::EpiF32, pg8::TileSched>(lds, g, S, E);
        }
        if constexpr (KIND == 2) {
            for (int r = gw; r < MR; r += NGW) {
                const float* xr = r < NP ? args.in[I_XP] + (size_t)r * DM : args.in[I_XS] + (size_t)(r - NP) * DM;
                const float* md = MOD + (size_t)modrow(r) * NMOD;
#pragma unroll
                for (int j = 0; j < 8; ++j) { const int c = lane * 4 + 256 * j; const f32x4 x = *(const f32x4*)(xr + c), sh = *(const f32x4*)(md + c), sc = *(const f32x4*)(md + DM + c);
                    const f32x4 u = x * (1.0f + sc) + sh; u32x2 w; w.x = pk2(u[0], u[1]); w.y = pk2(u[2], u[3]); *(u32x2*)(U + (size_t)r * DM + c) = w; }
            }
        }
        if constexpr (KIND == 3) {
            pg8::Gemm g{DM, DM}; pg8::TileSched S; S.init(U, ph == 3 ? W1GU : W2GU, DM, DM, MR, 2 * DFF, DM, G, bx);
            pg8::EpiSwiglu E{HP};
            pg8::gemm_phase<pg8::EpiSwiglu, pg8::TileSched>(lds, g, S, E);
        }
        if constexpr (KIND == 4) {
            const int Kd = ph == 10 ? DM : DFF;
            pg8::Gemm g{Kd, Kd}; pg8::TileSched S; S.init(ph == 10 ? U : HP, ph == 4 ? W1D : (ph == 10 ? WOUT : W2D), Kd, Kd, NP, DM, Kd, G, bx);
            S.s_pm0 = NP / 256; S.s_nM = NS / 256; S.s_splits = ph == 10 ? 8 : 11; S.s_nt = ph == 10 ? 4 : 8;
            pg8::EpiResid E{ph == 4 ? args.in[I_XP] : X, ph == 4 ? args.in[I_XS] : X + (size_t)NP * DM, X, MOD, ph == 4 ? 2 : (ph == 10 ? 5 : 8), ph == 10 ? 1.0f : 0.5f, (float*)(ws + OFF_WADA)};
            pg8::gemm_phase<pg8::EpiResid, pg8::TileSched>(lds, g, S, E);
        }
        if constexpr (KIND == 5) {
            const int li = ph == 5 ? 0 : (ph == 11 ? 1 : 2);
            const float* lg = args.in[I_LNG] + li * DM; const float* lb = args.in[I_LNB] + li * DM;
            float* dst = ph == 14 ? out + O_Y : X;
            f32x4 lgv[8], lbv[8], nx[8];
#pragma unroll
            for (int j = 0; j < 8; ++j) { lgv[j] = *(const f32x4*)(lg + lane * 4 + 256 * j); lbv[j] = *(const f32x4*)(lb + lane * 4 + 256 * j); }
            int r = gw;
            if (r < NP) {
#pragma unroll
                for (int j = 0; j < 8; ++j) nx[j] = *(const f32x4*)(X + (size_t)r * DM + lane * 4 + 256 * j); }
            for (; r < MR; r += NGW) {
                f32x4 v[8]; float s = 0.f;
                if (r < NP) {
#pragma unroll
                    for (int j = 0; j < 8; ++j) v[j] = nx[j];
                } else {
                    const float* xsrc = li == 0 ? args.in[I_XS] + (size_t)(r - NP) * DM : X + (size_t)r * DM;
                    const float* gt = MOD + (size_t)modrow(r) * NMOD + (3 * li + 2) * DM; const float coef = li == 1 ? 1.0f : 0.5f;
                    const float* pt = (const float*)(ws + OFF_WADA) + (size_t)(r - NP) * DM;
#define SUMSLABS(NSL) _Pragma("unroll") for (int j = 0; j < 8; ++j) { const int c = lane * 4 + 256 * j; f32x4 a = *(const f32x4*)(pt + c); \
                        _Pragma("unroll") for (int k = 1; k < NSL; ++k) a += *(const f32x4*)(pt + (size_t)k * NS * DM + c); \
                        v[j] = *(const f32x4*)(xsrc + c) * ALPHA + *(const f32x4*)(gt + c) * coef * a; }
                    if (li == 1) { SUMSLABS(8) } else { SUMSLABS(11) }
#undef SUMSLABS
                }
                const int rn = r + NGW;
                if (rn < NP) {
#pragma unroll
                    for (int j = 0; j < 8; ++j) nx[j] = *(const f32x4*)(X + (size_t)rn * DM + lane * 4 + 256 * j); }
#pragma unroll
                for (int j = 0; j < 8; ++j) s += (v[j][0] + v[j][1]) + (v[j][2] + v[j][3]);
                const float mean = wave_sum(s) * (1.0f / DM); float q = 0.f;
#pragma unroll
                for (int j = 0; j < 8; ++j) { v[j] = v[j] - mean; q += (v[j][0] * v[j][0] + v[j][1] * v[j][1]) + (v[j][2] * v[j][2] + v[j][3] * v[j][3]); }
                const float rstd = 1.0f / sqrtf(wave_sum(q) * (1.0f / DM) + LN_EPS);
                const float* md = MOD + (size_t)modrow(r) * NMOD + (3 * (li + 1)) * DM;
#pragma unroll
                for (int j = 0; j < 8; ++j) { const int c = lane * 4 + 256 * j; const f32x4 y = v[j] * rstd * lgv[j] + lbv[j];
                    *(f32x4*)(dst + (size_t)r * DM + c) = y;
                    if (ph != 14) { const f32x4 sh = *(const f32x4*)(md + c), sc = *(const f32x4*)(md + DM + c); const f32x4 u = y * (1.0f + sc) + sh; u32x2 w; w.x = pk2(u[0], u[1]); w.y = pk2(u[2], u[3]); *(u32x2*)(U + (size_t)r * DM + c) = w; } }
            }
        }
        if constexpr (KIND == 6) {
            pg8::Gemm g{DM, DM}; pg8::TileSched S; S.init(U, WIN, DM, DM, MR, INC, DM, G, bx);
            pg8::EpiBf16 E{HP, INC};
            pg8::gemm_phase<pg8::EpiBf16, pg8::TileSched>(lds, g, S, E);
        }
        if constexpr (KIND == 7) {
            const bf16_t* PROJ = HP; const bf16_t* WLRU = (const bf16_t*)(ws + OFF_WLRU);
            for (int it = gw; it < 2048; it += NGW) lru_item<0>(args, PROJ, WLRU, YAB, SEGA, SEGH, out, lds + wave * 10496, it, lane);
            for (int it = (gw * 4) % NGW + (gw * 4) / NGW; it < 512; it += NGW) lru_item<2>(args, PROJ, WLRU, YAB, SEGA, SEGH, out, lds + wave * 10496, it, lane);
            __syncthreads();
            {
                LAS bf16_t* VN = (LAS bf16_t*)lds;
                LAS bf16_t* WT = (LAS bf16_t*)(lds + 34816);
                LAS float* st = (LAS float*)(lds + 69632);
                const float* lg = args.in[I_GLNG]; const float* lb = args.in[I_GLNB];
                const int fr = lane & 15, fq = lane >> 4;
                int g_loaded = -1;
                for (int it = bx; it < 512; it += G) {
                    const int g = it & 7, pc = it >> 3, b = pc >> 4, c = pc & 15, row0 = b * SEQ + c * 128;
                    __syncthreads();
                    if (g != g_loaded) { g_loaded = g;
                        for (int i = tid; i < 128 * 32; i += 512) { const int t = i >> 5, s4 = (i & 31) * 4; const f32x4 w = *(const f32x4*)(args.in[I_GWS] + (size_t)g * 16384 + t * 128 + s4);
                            u32x2 o; o.x = pk2(s4 + 0 <= t ? w[0] : 0.f, s4 + 1 <= t ? w[1] : 0.f); o.y = pk2(s4 + 2 <= t ? w[2] : 0.f, s4 + 3 <= t ? w[3] : 0.f); *(LAS u32x2*)(WT + t * 136 + s4) = o; } }
                    for (int k0 = 0; k0 < 16; k0 += 8) { u32x4 p0[8], p1[8];
#pragma unroll
                        for (int k = 0; k < 8; ++k) { const bf16_t* gvp = PROJ + (size_t)(row0 + wave * 16 + k0 + k) * INC + 3072; p0[k] = *(const u32x4*)(gvp + lane * 8); p1[k] = *(const u32x4*)(gvp + 512 + lane * 8); }
                        float s[8], q[8];
#pragma unroll
                        for (int k = 0; k < 8; ++k) { s[k] = 0.f; q[k] = 0.f;
#pragma unroll
                            for (int j = 0; j < 4; ++j) { const float a0 = bflo(p0[k][j]), a1 = bfhi(p0[k][j]), a2 = bflo(p1[k][j]), a3 = bfhi(p1[k][j]); s[k] += (a0 + a1) + (a2 + a3); q[k] += (a0 * a0 + a1 * a1) + (a2 * a2 + a3 * a3); } }
#pragma unroll
                        for (int o = 1; o < 64; o <<= 1) {
#pragma unroll
                            for (int k = 0; k < 8; ++k) { s[k] += __shfl_xor(s[k], o); q[k] += __shfl_xor(q[k], o); } }
#pragma unroll
                        for (int k = 0; k < 8; ++k) { const int tt = wave * 16 + k0 + k; const float mean = s[k] * (1.0f / DR), var = fmaxf(q[k] * (1.0f / DR) - mean * mean, 0.f);
                            if (lane == 0) { st[tt * 2] = mean; st[tt * 2 + 1] = 1.0f / sqrtf(var + LN_EPS); } } }
                    __syncthreads();
#pragma unroll
                    for (int i = 0; i < 4; ++i) { const int task = tid + 512 * i, s = task >> 4, dc = task & 15, chn = g * 128 + dc * 8;
                        const u32x4 p = *(const u32x4*)(PROJ + (size_t)(row0 + s) * INC + 3072 + chn); const float mean = st[s * 2], rstd = st[s * 2 + 1];
                        const f32x4 g0 = *(const f32x4*)(lg + chn), g1 = *(const f32x4*)(lg + chn + 4), b0v = *(const f32x4*)(lb + chn), b1v = *(const f32x4*)(lb + chn + 4);
                        u32x4 o; o.x = pk2((bflo(p[0]) - mean) * rstd * g0[0] + b0v[0], (bfhi(p[0]) - mean) * rstd * g0[1] + b0v[1]); o.y = pk2((bflo(p[1]) - mean) * rstd * g0[2] + b0v[2], (bfhi(p[1]) - mean) * rstd * g0[3] + b0v[3]);
                        o.z = pk2((bflo(p[2]) - mean) * rstd * g1[0] + b1v[0], (bfhi(p[2]) - mean) * rstd * g1[1] + b1v[1]); o.w = pk2((bflo(p[3]) - mean) * rstd * g1[2] + b1v[2], (bfhi(p[3]) - mean) * rstd * g1[3] + b1v[3]);
                        *(LAS u32x4*)(VN + s * 136 + dc * 8) = o; }
                    __syncthreads();
                    bf16x8 vf[4];
#pragma unroll
                    for (int kc = 0; kc < 4; ++kc) { short tmp[8];
#pragma unroll
                        for (int j = 0; j < 8; ++j) tmp[j] = (short)VN[(32 * kc + 8 * fq + j) * 136 + 16 * wave + fr];
                        vf[kc] = (bf16x8){tmp[0], tmp[1], tmp[2], tmp[3], tmp[4], tmp[5], tmp[6], tmp[7]}; }
#pragma unroll
                    for (int tt = 0; tt < 8; ++tt) { f32x4 acc = (f32x4){0.f, 0.f, 0.f, 0.f};
#pragma unroll
                        for (int kc = 0; kc <= (16 * tt + 15) / 32; ++kc) { const bf16x8 wf = *(const LAS bf16x8*)(WT + (16 * tt + fr) * 136 + 32 * kc + 8 * fq); acc = __builtin_amdgcn_mfma_f32_16x16x32_bf16(vf[kc], wf, acc, 0, 0, 0); }
                        const int t = 16 * tt + fr, col = g * 128 + 16 * wave + 4 * fq; const size_t row = (size_t)(row0 + t);
                        const float bsv = args.in[I_GBS][g * 128 + t]; const u32x2 gu = *(const u32x2*)(PROJ + row * INC + 2048 + col);
                        u32x2 o; o.x = pk2(bflo(gu.x) * (acc[0] + bsv), bfhi(gu.x) * (acc[1] + bsv)); o.y = pk2(bflo(gu.y) * (acc[2] + bsv), bfhi(gu.y) * (acc[3] + bsv));
                        *(u32x2*)(YAB + row * DM + DR + col) = o; }
                }
            }
            for (int bg = gw; bg < 128; bg += NGW) {
                float vnv[4][16];
#pragma unroll
                for (int t = 0; t < 4; ++t) { const bf16_t* gvp = PROJ + (size_t)(NP + bg * 4 + t) * INC + 3072;
                    const u32x4 p0 = *(const u32x4*)(gvp + lane * 8), p1 = *(const u32x4*)(gvp + 512 + lane * 8);
#pragma unroll
                    for (int q = 0; q < 4; ++q) { vnv[t][2 * q] = bflo(p0[q]); vnv[t][2 * q + 1] = bfhi(p0[q]); vnv[t][8 + 2 * q] = bflo(p1[q]); vnv[t][8 + 2 * q + 1] = bfhi(p1[q]); }
                    float s = 0.f;
#pragma unroll
                    for (int q = 0; q < 16; ++q) s += vnv[t][q];
                    const float mean = wave_sum(s) * (1.0f / DR); float qq = 0.f;
#pragma unroll
                    for (int q = 0; q < 16; ++q) { const float d = vnv[t][q] - mean; qq += d * d; }
                    const float rstd = 1.0f / sqrtf(wave_sum(qq) * (1.0f / DR) + LN_EPS);
#pragma unroll
                    for (int q = 0; q < 16; ++q) { const int chn = (q >> 3) * 512 + lane * 8 + (q & 7); vnv[t][q] = (vnv[t][q] - mean) * rstd * args.in[I_GLNG][chn] + args.in[I_GLNB][chn]; }
                    float* vo = out + O_VS + (size_t)(bg * 4 + t) * DR;
#pragma unroll
                    for (int j = 0; j < 2; ++j) { *(f32x4*)(vo + j * 512 + lane * 8) = (f32x4){vnv[t][j * 8 + 0], vnv[t][j * 8 + 1], vnv[t][j * 8 + 2], vnv[t][j * 8 + 3]};
                        *(f32x4*)(vo + j * 512 + lane * 8 + 4) = (f32x4){vnv[t][j * 8 + 4], vnv[t][j * 8 + 5], vnv[t][j * 8 + 6], vnv[t][j * 8 + 7]}; }
                }
#pragma unroll
                for (int j = 0; j < 2; ++j) { const int g = (lane >> 4) + 4 * j; const float* wg = args.in[I_GWS] + (size_t)g * 16384; const float* bsg = args.in[I_GBS] + g * 128;
#pragma unroll
                    for (int t = 0; t < 4; ++t) { const size_t row = (size_t)NP + bg * 4 + t; const u32x4 gu = *(const u32x4*)(PROJ + row * INC + 2048 + j * 512 + lane * 8); float o[8];
#pragma unroll
                        for (int q = 0; q < 8; ++q) { float acc = bsg[t];
#pragma unroll
                            for (int s = 0; s < 4; ++s) if (s <= t) acc += wg[t * 128 + s] * vnv[s][j * 8 + q];
                            const float guv = (q & 1) ? bfhi(gu[q >> 1]) : bflo(gu[q >> 1]); o[q] = guv * acc; }
                        u32x4 w; w.x = pk2(o[0], o[1]); w.y = pk2(o[2], o[3]); w.z = pk2(o[4], o[5]); w.w = pk2(o[6], o[7]);
                        *(u32x4*)(YAB + row * DM + DR + j * 512 + lane * 8) = w; } }
            }
        }
        if constexpr (KIND == 8) {
            const bf16_t* PROJ = HP; const bf16_t* WLRU = (const bf16_t*)(ws + OFF_WLRU);
            for (int it = gw; it < 2048; it += NGW) lru_item<1>(args, PROJ, WLRU, YAB, SEGA, SEGH, out, lds + wave * 10496, it, lane);
        }
        if constexpr (KIND == 9) {
            pg8::Gemm g{DM, DM}; pg8::TileSched S; S.init(YAB, WPAB, DM, DM, MR, DM, DM, G, bx);
            pg8::EpiMerge E{HP, U};
            pg8::gemm_phase<pg8::EpiMerge, pg8::TileSched>(lds, g, S, E);
        }
}

__global__ void __launch_bounds__(NWAVES * 64, 2) fwd(Args args) {
    extern __shared__ __attribute__((aligned(16))) unsigned char lds_raw[];
    LAS unsigned char* lds = (LAS unsigned char*)lds_raw;
    cg::grid_group grid = cg::this_grid();
    if (args.ph_hi > 1000) grid.sync();
    volatile LAS unsigned* bst = (volatile LAS unsigned*)(lds + 131072 + 1024);
    if (threadIdx.x < 16) bst[threadIdx.x] = 0u;
    __syncthreads();
    XcdBarrier bar = xcd_barrier_post((unsigned*)args.ws, bst);
    for (int ph_ = args.ph_lo; ph_ < args.ph_hi + (REPEAT_PH >= 0 ? 1 : 0); ++ph_) {
        const int ph = (REPEAT_PH >= 0 && ph_ > REPEAT_PH) ? ph_ - 1 : ph_;
        switch (ph) {
        case 0: phase_body<0>(args, ph, lds); break;
        case 1: phase_body<1>(args, ph, lds); break;
        case 2: phase_body<2>(args, ph, lds); break;
        case 3: case 12: phase_body<3>(args, ph, lds); break;
        case 4: case 10: case 13: phase_body<4>(args, ph, lds); break;
        case 5: case 11: case 14: phase_body<5>(args, ph, lds); break;
        case 6: phase_body<6>(args, ph, lds); break;
        case 7: phase_body<7>(args, ph, lds); break;
        case 8: phase_body<8>(args, ph, lds); break;
        case 9: phase_body<9>(args, ph, lds); break;
        default: break;
        }
        if (ph_ + 1 < args.ph_hi + (REPEAT_PH >= 0 ? 1 : 0)) xcd_barrier(bar);
    }
}


#ifdef DIAG_KINDS
template <int KIND> __global__ void __launch_bounds__(NWAVES * 64, 2) diag(Args args) {
    extern __shared__ __attribute__((aligned(16))) unsigned char lds_raw[];
    phase_body<KIND>(args, args.ph_lo, (LAS unsigned char*)lds_raw);
}
template __global__ void diag<0>(Args); template __global__ void diag<1>(Args); template __global__ void diag<2>(Args); template __global__ void diag<3>(Args); template __global__ void diag<4>(Args);
template __global__ void diag<5>(Args); template __global__ void diag<6>(Args); template __global__ void diag<7>(Args); template __global__ void diag<8>(Args); template __global__ void diag<9>(Args);
#endif
extern "C" void kernel_launch(void* const* d_in, const int* in_sizes, int n_in, void* d_out, int out_size, void* d_ws, size_t ws_size, hipStream_t stream) {
    static int grid = 0;
    if (grid == 0) {
        if (n_in != 29 || ws_size < WS_END) { fprintf(stderr, "kernel_launch: need 29 inputs and %zu bytes of ws; got %d, %zu\n", (size_t)WS_END, n_in, ws_size); grid = -1; return; }
        int dev = 0, cus = 0, per_cu = 0;
        hipGetDevice(&dev); hipDeviceGetAttribute(&cus, hipDeviceAttributeMultiprocessorCount, dev);
        if (hipFuncSetAttribute((const void*)fwd, hipFuncAttributeMaxDynamicSharedMemorySize, LDS_BYTES) != hipSuccess) { fprintf(stderr, "kernel_launch: hipFuncSetAttribute failed\n"); grid = -1; return; }
        if (hipOccupancyMaxActiveBlocksPerMultiprocessor(&per_cu, (const void*)fwd, NWAVES * 64, LDS_BYTES) != hipSuccess || per_cu < 1) { fprintf(stderr, "kernel_launch: occupancy query says %d\n", per_cu); per_cu = 1; }
        (void)hipGetLastError();
        grid = cus;
    }
    if (grid < 0) return;
    Args a{};
    for (int i = 0; i < 29; ++i) a.in[i] = (const float*)d_in[i];
    a.out = (float*)d_out; a.ws = (unsigned char*)d_ws;
#if ONE_LAUNCH
    a.ph_lo = 0; a.ph_hi = NPHASE;
    if (hipMemsetAsync(d_ws, 0, 16384, stream) != hipSuccess) { fprintf(stderr, "kernel_launch: memset of barrier words failed\n"); return; }
    { void* kargs[] = {&a}; hipError_t e = hipLaunchCooperativeKernel((const void*)fwd, dim3(grid), dim3(NWAVES * 64), kargs, LDS_BYTES, stream);
      if (e != hipSuccess) fprintf(stderr, "cooperative launch failed: %s (grid %d)\n", hipGetErrorString(e), grid); }
#else
    for (int ph = 0; ph < NPHASE; ++ph) { a.ph_lo = ph; a.ph_hi = ph + 1; void* kargs[] = {&a};
        hipError_t e = hipLaunchCooperativeKernel((const void*)fwd, dim3(grid), dim3(NWAVES * 64), kargs, LDS_BYTES, stream);
        if (e != hipSuccess) { fprintf(stderr, "cooperative launch %d failed: %s (grid %d)\n", ph, hipGetErrorString(e), grid); break; } }
#endif
}
```

```cpp
#include <hip/hip_runtime.h>
#include <hip/hip_cooperative_groups.h>
#include <cstdio>
#include <cstdint>
namespace cg = cooperative_groups;

#define REPEAT_PH -1
#ifndef ONE_LAUNCH
#define ONE_LAUNCH 1
#endif

#define LAS __attribute__((address_space(3)))
typedef unsigned short bf16_t;
typedef short bf16x8 __attribute__((ext_vector_type(8)));
typedef float f32x4 __attribute__((ext_vector_type(4)));
typedef float f32x2 __attribute__((ext_vector_type(2)));
typedef unsigned u32x4 __attribute__((ext_vector_type(4)));
typedef unsigned u32x2 __attribute__((ext_vector_type(2)));

constexpr int DM = 2048, NP = 8192, NS = 512, MR = NP + NS, DFF = 5632, DR = 1024, INC = 8192, NMOD = 9 * DM;
constexpr int SEQ = 2048, NSEG = 32, SEGL = 64;
constexpr float ALPHA = 1.189207115002721f;
constexpr float LN_EPS = 1e-5f;
constexpr int NWAVES = 8;

constexpr size_t MiB = 1u << 20;
constexpr size_t OFF_W1GU = 1 * MiB, OFF_W1D = 45 * MiB, OFF_W2GU = 67 * MiB, OFF_W2D = 111 * MiB, OFF_WIN = 133 * MiB, OFF_WPAB = 165 * MiB, OFF_WOUT = 173 * MiB;
constexpr size_t OFF_WLRU = 181 * MiB, OFF_SC = 182 * MiB, OFF_MOD = 183 * MiB, OFF_U = 201 * MiB, OFF_YAB = 235 * MiB, OFF_X = 269 * MiB, OFF_HP = 337 * MiB, OFF_WADA = 473 * MiB;
constexpr size_t OFF_STP = OFF_WADA + 66 * MiB;
constexpr size_t OFF_HL = OFF_WADA, OFF_PP = OFF_WADA + 32 * MiB, OFF_SEG = OFF_WADA + 64 * MiB, WS_END = 545 * MiB;

constexpr size_t O_Y = 0, O_CP = 17825792, O_HP = 17838080, O_CS = 17842176, O_HS = 18235392, O_VS = 18366464;

constexpr int LDS_BYTES = 131072 + 1024 + 64;

__device__ __forceinline__ unsigned f2bf(float f) { unsigned u = __builtin_bit_cast(unsigned, f); return (u + 0x7fffu + ((u >> 16) & 1u)) >> 16; }
__device__ __forceinline__ unsigned pk2(float lo, float hi) { return f2bf(lo) | (f2bf(hi) << 16); }
__device__ __forceinline__ float bflo(unsigned w) { return __builtin_bit_cast(float, w << 16); }
__device__ __forceinline__ float bfhi(unsigned w) { return __builtin_bit_cast(float, w & 0xffff0000u); }
__device__ __forceinline__ float bf2f(bf16_t b) { return __builtin_bit_cast(float, ((unsigned)b) << 16); }
__device__ __forceinline__ float wave_sum(float v) {
#pragma unroll
    for (int o = 1; o < 64; o <<= 1) v += __shfl_xor(v, o);
    return v;
}
__device__ __forceinline__ float sigmoid_fast(float x) { return __builtin_amdgcn_rcpf(1.0f + __expf(-x)); }
__device__ __forceinline__ float gelu_tanh(float x) { const float z = 0.7978845608028654f * (x + 0.044715f * x * x * x); return x * sigmoid_fast(2.0f * z); }
__device__ __forceinline__ int modrow(int r) { return r < NP ? (r >> 11) : 4 + ((r - NP) >> 2); }
#define LDS_WAIT() asm volatile("s_waitcnt lgkmcnt(0)" ::: "memory")

namespace pg8 {
constexpr int BM = 256, BK = 64, HALF = 128, HTB = HALF * BK * 2, STAGE_BYTES = 8 * HTB, NXCD = 8, WGM = 8;
__host__ __device__ __forceinline__ int lds_byte(int r, int c) { const int st = (r >> 4) * 2 + (c >> 5), rr = r & 15, cc = c & 31, ob = rr * 64 + cc * 2; return st * 1024 + (ob ^ (((ob >> 9) & 1) << 5)); }
__host__ __device__ __forceinline__ void stage_rc(int b, int& R, int& C) { const int st = b / 1024, sb = b % 1024, swz = sb ^ (((sb >> 9) & 1) << 5); R = (st >> 1) * 16 + swz / 64; C = (st & 1) * 32 + (swz % 64) / 2; }
__host__ __device__ __forceinline__ int perm32(int rho) { const int n = rho >> 4, i = rho & 15; return 8 * (i >> 2) + 4 * n + (i & 3); }

struct Unit { const char* a; const char* b; int nt, pm, pn, ks; };
struct Gemm { int lda, ldb; };

struct TileSched {
    const char* A; const char* Bt; size_t tA, tB;
    int nM, nN, nt, nwg, G, c, s_pm0, s_nM, s_splits, s_nt;
    __device__ void init(const bf16_t* A_, const bf16_t* Bt_, int lda, int ldb, int M, int N, int K, int G_, int c_) {
        A = (const char*)A_; Bt = (const char*)Bt_; tA = (size_t)BM * lda * 2; tB = (size_t)BM * ldb * 2; nM = M / BM; nN = N / BM; nt = K / BK; nwg = nM * nN; G = G_; c = c_; s_pm0 = 0; s_nM = 0; s_splits = 0; s_nt = 0; }
    __device__ bool next(int i, Unit& u) const {
        long L = (long)i * G + c;
        if (L < nwg) {
            int wgid = (int)L; { const int q = nwg / NXCD, r = nwg % NXCD, xcd = wgid % NXCD, off = wgid / NXCD; wgid = (xcd < r ? xcd * (q + 1) : r * (q + 1) + (xcd - r) * q) + off; }
            const int nig = WGM * nN, gid = wgid / nig, fm = gid * WGM, gsz = (nM - fm) < WGM ? (nM - fm) : WGM;
            u.pm = fm + ((wgid % nig) % gsz); u.pn = (wgid % nig) / gsz; u.nt = nt; u.ks = -1;
            u.a = A + (size_t)u.pm * tA; u.b = Bt + (size_t)u.pn * tB; return true; }
        L -= nwg; const int per = s_nM * nN;
        if (L >= (long)per * s_splits) return false;
        const int ks = (int)L / per, rem = (int)L % per;
        u.pm = s_pm0 + rem % s_nM; u.pn = rem / s_nM; u.nt = s_nt; u.ks = ks;
        u.a = A + (size_t)u.pm * tA + (size_t)ks * s_nt * (BK * 2); u.b = Bt + (size_t)u.pn * tB + (size_t)ks * s_nt * (BK * 2); return true;
    }
};

__device__ __forceinline__ unsigned cvt_pk_bf16(float lo, float hi) { unsigned r; asm volatile("v_cvt_pk_bf16_f32 %0, %1, %2" : "=v"(r) : "v"(lo), "v"(hi)); return r; }

struct EpiF32 {
    static constexpr bool PERM = false, HAS_MID = false;
    float* C; int ldc; const float* bias;
    __device__ __forceinline__ void mid(f32x4 (&acc)[2][2][4][2], const Unit& u, int wr, int wc, int fr, int fq) const {}
    __device__ __forceinline__ void operator()(const f32x4 (&acc)[2][2][4][2], const Unit& u, int wr, int wc, int fr, int fq) const {
        const int row0 = u.pm * BM + wr * 64 + fr, col0 = u.pn * BM + wc * 32 + 4 * fq;
        f32x4 bv[2][2];
#pragma unroll
        for (int bj = 0; bj < 2; ++bj)
#pragma unroll
            for (int n = 0; n < 2; ++n) bv[bj][n] = *(const f32x4*)(bias + col0 + bj * HALF + n * 16);
#pragma unroll
        for (int ai = 0; ai < 2; ++ai)
#pragma unroll
            for (int m = 0; m < 4; ++m) { float* rowp = C + (size_t)(row0 + ai * HALF + m * 16) * ldc + col0;
#pragma unroll
                for (int bj = 0; bj < 2; ++bj)
#pragma unroll
                    for (int n = 0; n < 2; ++n) *(f32x4*)(rowp + bj * HALF + n * 16) = acc[ai][bj][m][n] + bv[bj][n]; }
    }
};
struct EpiBf16 {
    static constexpr bool PERM = true, HAS_MID = false;
    bf16_t* O; int ldc; f32x2* STP;
    __device__ __forceinline__ void mid(f32x4 (&acc)[2][2][4][2], const Unit& u, int wr, int wc, int fr, int fq) const {}
    __device__ __forceinline__ void operator()(const f32x4 (&acc)[2][2][4][2], const Unit& u, int wr, int wc, int fr, int fq) const {
        const int row0 = u.pm * BM + wr * 64 + fr, col0 = u.pn * BM + wc * 32 + 8 * fq;
#pragma unroll
        for (int ai = 0; ai < 2; ++ai)
#pragma unroll
            for (int m = 0; m < 4; ++m) { bf16_t* rowp = O + (size_t)(row0 + ai * HALF + m * 16) * ldc + col0;
#pragma unroll
                for (int bj = 0; bj < 2; ++bj) { const f32x4 v0 = acc[ai][bj][m][0], v1 = acc[ai][bj][m][1];
                    u32x4 w; w.x = cvt_pk_bf16(v0[0], v0[1]); w.y = cvt_pk_bf16(v0[2], v0[3]); w.z = cvt_pk_bf16(v1[0], v1[1]); w.w = cvt_pk_bf16(v1[2], v1[3]);
                    *(u32x4*)(rowp + bj * HALF) = w; } }
        if (u.pn >= 12 && u.pn < 16) {
#pragma unroll
            for (int ai = 0; ai < 2; ++ai)
#pragma unroll
                for (int m = 0; m < 4; ++m) { float s = 0.f, q = 0.f;
#pragma unroll
                    for (int bj = 0; bj < 2; ++bj)
#pragma unroll
                        for (int n = 0; n < 2; ++n) { const f32x4 v = acc[ai][bj][m][n]; s += (v[0] + v[1]) + (v[2] + v[3]); q += (v[0] * v[0] + v[1] * v[1]) + (v[2] * v[2] + v[3] * v[3]); }
                    s += __shfl_xor(s, 16); q += __shfl_xor(q, 16); s += __shfl_xor(s, 32); q += __shfl_xor(q, 32);
                    if (fq == 0) STP[(size_t)(row0 + ai * HALF + m * 16) * 16 + (u.pn - 12) * 4 + wc] = (f32x2){s, q}; } }
    }
};
struct EpiSwiglu {
    static constexpr bool PERM = true, HAS_MID = false;
    bf16_t* H;
    __device__ __forceinline__ void mid(f32x4 (&acc)[2][2][4][2], const Unit& u, int wr, int wc, int fr, int fq) const {}
    __device__ __forceinline__ void operator()(const f32x4 (&acc)[2][2][4][2], const Unit& u, int wr, int wc, int fr, int fq) const {
        const int row0 = u.pm * BM + wr * 64 + fr, col0 = u.pn * HALF + wc * 32 + 8 * fq;
#pragma unroll
        for (int ai = 0; ai < 2; ++ai)
#pragma unroll
            for (int m = 0; m < 4; ++m) { bf16_t* rowp = H + (size_t)(row0 + ai * HALF + m * 16) * DFF + col0;
                float o[8];
#pragma unroll
                for (int n = 0; n < 2; ++n)
#pragma unroll
                    for (int j = 0; j < 4; ++j) { const float g = acc[ai][0][m][n][j], v = acc[ai][1][m][n][j]; o[n * 4 + j] = g * sigmoid_fast(g) * v; }
                u32x4 w; w.x = cvt_pk_bf16(o[0], o[1]); w.y = cvt_pk_bf16(o[2], o[3]); w.z = cvt_pk_bf16(o[4], o[5]); w.w = cvt_pk_bf16(o[6], o[7]);
                *(u32x4*)rowp = w; }
    }
};
struct EpiResid {
    static constexpr bool PERM = false, HAS_MID = false;
    const float* xp; const float* xs; float* X; const float* MOD; int gk; float coef; float* PART;
    __device__ __forceinline__ void mid(f32x4 (&acc)[2][2][4][2], const Unit& u, int wr, int wc, int fr, int fq) const {}
    __device__ __forceinline__ void operator()(const f32x4 (&acc)[2][2][4][2], const Unit& u, int wr, int wc, int fr, int fq) const {
        const int row0 = u.pm * BM + wr * 64 + fr, col0 = u.pn * BM + wc * 32 + 4 * fq;
        if (u.ks >= 0) {
#pragma unroll
            for (int ai = 0; ai < 2; ++ai)
#pragma unroll
                for (int m = 0; m < 4; ++m) { float* orow = PART + ((size_t)u.ks * NS + (row0 + ai * HALF + m * 16 - NP)) * DM + col0;
#pragma unroll
                    for (int bj = 0; bj < 2; ++bj)
#pragma unroll
                        for (int n = 0; n < 2; ++n) *(f32x4*)(orow + bj * HALF + n * 16) = acc[ai][bj][m][n]; }
            return; }
        const bool samp = u.pm >= NP / BM;
        f32x4 gv[2][2];
        if (!samp) { const float* md = MOD + (size_t)(u.pm >> 3) * NMOD + gk * DM + col0;
#pragma unroll
            for (int bj = 0; bj < 2; ++bj)
#pragma unroll
                for (int n = 0; n < 2; ++n) gv[bj][n] = *(const f32x4*)(md + bj * HALF + n * 16) * coef; }
#pragma unroll
        for (int ai = 0; ai < 2; ++ai)
#pragma unroll
            for (int m = 0; m < 4; ++m) { const int row = row0 + ai * HALF + m * 16;
                const float* xrow = (samp ? xs + (size_t)(row - NP) * DM : xp + (size_t)row * DM) + col0;
                if (samp) { const float* md = MOD + (size_t)(4 + ((row - NP) >> 2)) * NMOD + gk * DM + col0;
#pragma unroll
                    for (int bj = 0; bj < 2; ++bj)
#pragma unroll
                        for (int n = 0; n < 2; ++n) gv[bj][n] = *(const f32x4*)(md + bj * HALF + n * 16) * coef; }
                float* orow = X + (size_t)row * DM + col0;
#pragma unroll
                for (int bj = 0; bj < 2; ++bj)
#pragma unroll
                    for (int n = 0; n < 2; ++n) { const f32x4 xv = *(const f32x4*)(xrow + bj * HALF + n * 16); *(f32x4*)(orow + bj * HALF + n * 16) = xv * ALPHA + gv[bj][n] * acc[ai][bj][m][n]; }
                asm volatile("" ::: "memory"); }
    }
};
struct EpiMerge {
    static constexpr bool PERM = true, HAS_MID = true;
    const bf16_t* PROJ; bf16_t* O;
    __device__ __forceinline__ void mid(f32x4 (&acc)[2][2][4][2], const Unit& u, int wr, int wc, int fr, int fq) const {
        unsigned off = (unsigned)((u.pm * BM + wr * 64 + fr) * INC + u.pn * BM + wc * 32 + 8 * fq) * 2u;
        asm volatile("" : "+v"(off));
        const char* base = (const char*)PROJ;
#pragma unroll
        for (int ai = 0; ai < 2; ++ai) {
#pragma unroll
            for (int m = 0; m < 4; ++m) { const unsigned ro = off + (unsigned)((ai * HALF + m * 16) * INC * 2);
#pragma unroll
                for (int bj = 0; bj < 2; ++bj) { const u32x4 a = *(const u32x4*)(base + ro + (4096 + bj * HALF) * 2), b = *(const u32x4*)(base + ro + (6144 + bj * HALF) * 2);
#pragma unroll
                    for (int q = 0; q < 4; ++q) { const float a0 = fminf(fmaxf(bflo(a[q]), -30.f), 30.f), a1 = fminf(fmaxf(bfhi(a[q]), -30.f), 30.f), b0 = fminf(fmaxf(bflo(b[q]), -30.f), 30.f), b1 = fminf(fmaxf(bfhi(b[q]), -30.f), 30.f);
                        const float r0 = (1.0f + __expf(-b0)) * __builtin_amdgcn_rcpf(1.0f + __expf(-a0)), r1 = (1.0f + __expf(-b1)) * __builtin_amdgcn_rcpf(1.0f + __expf(-a1));
                        acc[ai][bj][m][q >> 1][(q & 1) * 2] *= r0; acc[ai][bj][m][q >> 1][(q & 1) * 2 + 1] *= r1; } } }
            asm volatile("" ::: "memory"); }
    }
    __device__ __forceinline__ void operator()(const f32x4 (&acc)[2][2][4][2], const Unit& u, int wr, int wc, int fr, int fq) const {
        const int row0 = u.pm * BM + wr * 64 + fr, col0 = u.pn * BM + wc * 32 + 8 * fq;
#pragma unroll
        for (int ai = 0; ai < 2; ++ai)
#pragma unroll
            for (int m = 0; m < 4; ++m) { const size_t row = (size_t)(row0 + ai * HALF + m * 16); const bf16_t* pr = PROJ + row * INC + 6144 + col0; bf16_t* orow = O + row * DM + col0;
#pragma unroll
                for (int bj = 0; bj < 2; ++bj) { const u32x4 b = *(const u32x4*)(pr + bj * HALF); u32x4 w;
#pragma unroll
                    for (int q = 0; q < 4; ++q) { const float b0 = fminf(fmaxf(bflo(b[q]), -30.f), 30.f), b1 = fminf(fmaxf(bfhi(b[q]), -30.f), 30.f);
                        w[q] = cvt_pk_bf16(acc[ai][bj][m][q >> 1][(q & 1) * 2] * sigmoid_fast(b0), acc[ai][bj][m][q >> 1][(q & 1) * 2 + 1] * sigmoid_fast(b1)); }
                    *(u32x4*)(orow + bj * HALF) = w; }
                asm volatile("" ::: "memory"); }
    }
};

template <class Epi, class Sched>
__device__ __forceinline__ void gemm_phase(LAS unsigned char* lds, const Gemm g, const Sched& S, const Epi& E) {
    int tid_ = threadIdx.x; asm volatile("" : "+v"(tid_));
    const int tid = tid_, wid = __builtin_amdgcn_readfirstlane(tid >> 6), lane = tid & 63, wr = wid >> 2, wc = wid & 3, fr = lane & 15, fq = lane >> 4;
    unsigned voffA[2], voffB[2];
#pragma unroll
    for (int i = 0; i < 2; ++i) { int R, C; stage_rc(tid * 16 + i * 8192, R, C); const int Rb = Epi::PERM ? ((R & ~31) + perm32(R & 31)) : R;
        voffA[i] = (unsigned)(R * g.lda + C) * 2u; voffB[i] = (unsigned)(Rb * g.ldb + C) * 2u; }
    const size_t kstep = (size_t)(BK * 2);
    const size_t hA = (size_t)HALF * g.lda * 2, hB = (size_t)HALF * g.ldb * 2;
    const unsigned ldsw = (unsigned)wid * 1024u;
    const int aoff = lds_byte(wr * 64 + fr, fq * 8), boff = lds_byte(wc * 32 + fr, fq * 8);
#define PG8_SA(b, h) (((b) * 2 + (h)) * HTB)
#define PG8_SB(b, h) ((4 + (b) * 2 + (h)) * HTB)
#define PG8_STAGE(bufoff, gbase, voff) do { _Pragma("unroll") for (int _i = 0; _i < 2; ++_i) \
        __builtin_amdgcn_global_load_lds((const unsigned*)((const char*)(gbase) + (voff)[_i]), (LAS unsigned*)(lds + (bufoff) + ldsw + _i * 8192), 16, 0, 0); } while (0)
#define PG8_LDA(dst, b, h) do { _Pragma("unroll") for (int m = 0; m < 4; ++m) _Pragma("unroll") for (int k = 0; k < 2; ++k) dst[m][k] = *(const LAS bf16x8*)(lds + PG8_SA(b, h) + aoff + m * 2048 + k * 1024); } while (0)
#define PG8_LDB(dst, b, h) do { _Pragma("unroll") for (int n = 0; n < 2; ++n) _Pragma("unroll") for (int k = 0; k < 2; ++k) dst[n][k] = *(const LAS bf16x8*)(lds + PG8_SB(b, h) + boff + n * 2048 + k * 1024); } while (0)
#define PG8_MMA(ai, bj, At, Bt) do { __builtin_amdgcn_s_setprio(1); _Pragma("unroll") for (int m = 0; m < 4; ++m) _Pragma("unroll") for (int n = 0; n < 2; ++n) _Pragma("unroll") for (int k = 0; k < 2; ++k) \
        acc[ai][bj][m][n] = __builtin_amdgcn_mfma_f32_16x16x32_bf16(Bt[n][k], At[m][k], acc[ai][bj][m][n], 0, 0, 0); __builtin_amdgcn_s_setprio(0); } while (0)
#define PG8_WAIT_V(n) asm volatile("s_waitcnt vmcnt(" #n ")" ::: "memory")
#define PG8_WAIT_L(n) asm volatile("s_waitcnt lgkmcnt(" #n ")" ::: "memory")
#define PG8_BAR __builtin_amdgcn_s_barrier()
#define PG8_SCHED __builtin_amdgcn_sched_barrier(0)
    Unit cur, nxt; int ui = 0;
    if (!S.next(0, cur)) return;
    f32x4 acc[2][2][4][2];
#pragma unroll
    for (int a = 0; a < 2; ++a)
#pragma unroll
        for (int b = 0; b < 2; ++b)
#pragma unroll
            for (int m = 0; m < 4; ++m)
#pragma unroll
                for (int n = 0; n < 2; ++n) acc[a][b][m][n] = (f32x4){0.f, 0.f, 0.f, 0.f};
    bf16x8 At[4][2], B0[2][2], B1[2][2];
    const char* cA = cur.a; const char* cB = cur.b;
    PG8_STAGE(PG8_SB(0, 0), cB, voffB); PG8_STAGE(PG8_SB(0, 1), cB + hB, voffB); PG8_STAGE(PG8_SA(0, 0), cA, voffA); PG8_STAGE(PG8_SA(0, 1), cA + hA, voffA);
    if (wr == 1) PG8_BAR;
    PG8_WAIT_V(2); PG8_BAR;
    PG8_STAGE(PG8_SB(1, 0), cB + kstep, voffB); PG8_STAGE(PG8_SA(1, 0), cA + kstep, voffA); PG8_STAGE(PG8_SB(1, 1), cB + hB + kstep, voffB);
    PG8_WAIT_V(6); PG8_BAR;
    for (;;) {
        const bool has_next = S.next(ui + 1, nxt);
        const char* nA = has_next ? nxt.a : cA; const char* nB = has_next ? nxt.b : cB;
        const int nt = cur.nt, tmid = nt >> 1;
        for (int t = 0; t < nt; t += 2) {
            const bool last = (t == nt - 2);
            const char* a1 = cA + (size_t)(t + 1) * kstep;
            const char* a2 = last ? nA : cA + (size_t)(t + 2) * kstep; const char* b2 = last ? nB : cB + (size_t)(t + 2) * kstep;
            const char* a3 = a2 + kstep; const char* b3 = b2 + kstep;
            if constexpr (Epi::HAS_MID) { if (t == tmid) E.mid(acc, cur, wr, wc, fr, fq); }
            PG8_LDB(B0, 0, 0); PG8_LDB(B1, 0, 1); PG8_SCHED; PG8_LDA(At, 0, 0); PG8_STAGE(PG8_SA(1, 1), a1 + hA, voffA);
            PG8_WAIT_V(8); PG8_WAIT_L(0); PG8_BAR; PG8_MMA(0, 0, At, B0); PG8_MMA(0, 1, At, B1); PG8_BAR; PG8_SCHED;
            PG8_LDA(At, 0, 1); PG8_STAGE(PG8_SB(0, 0), b2, voffB); PG8_STAGE(PG8_SB(0, 1), b2 + hB, voffB); PG8_STAGE(PG8_SA(0, 0), a2, voffA);
            PG8_WAIT_V(8); PG8_WAIT_L(0); PG8_BAR; PG8_MMA(1, 0, At, B0); PG8_MMA(1, 1, At, B1); PG8_BAR; PG8_SCHED;
            PG8_LDB(B0, 1, 0); PG8_LDB(B1, 1, 1); PG8_SCHED; PG8_LDA(At, 1, 0); PG8_STAGE(PG8_SA(0, 1), a2 + hA, voffA);
            PG8_WAIT_V(8); PG8_WAIT_L(0); PG8_BAR; PG8_MMA(0, 0, At, B0); PG8_MMA(0, 1, At, B1); PG8_BAR; PG8_SCHED;
            PG8_LDA(At, 1, 1); PG8_STAGE(PG8_SB(1, 0), b3, voffB); PG8_STAGE(PG8_SB(1, 1), b3 + hB, voffB); PG8_STAGE(PG8_SA(1, 0), a3, voffA);
            PG8_WAIT_V(8); PG8_WAIT_L(0); PG8_BAR; PG8_MMA(1, 0, At, B0); PG8_MMA(1, 1, At, B1); PG8_BAR; PG8_SCHED;
        }
        if (wr == 0) PG8_BAR;
        E(acc, cur, wr, wc, fr, fq);
        if (!has_next) break;
#pragma unroll
        for (int a = 0; a < 2; ++a)
#pragma unroll
            for (int b = 0; b < 2; ++b)
#pragma unroll
                for (int m = 0; m < 4; ++m)
#pragma unroll
                    for (int n = 0; n < 2; ++n) acc[a][b][m][n] = (f32x4){0.f, 0.f, 0.f, 0.f};
        cur = nxt; cA = nA; cB = nB; ++ui;
        if (wr == 1) PG8_BAR;
    }
    PG8_WAIT_V(0);
    PG8_BAR;
#undef PG8_SA
#undef PG8_SB
#undef PG8_STAGE
#undef PG8_LDA
#undef PG8_LDB
#undef PG8_MMA
#undef PG8_WAIT_V
#undef PG8_WAIT_L
#undef PG8_BAR
#undef PG8_SCHED
}
}


#define XB_TMO      128
#define XB_XCNT(j)  (256  + 64 * (j))
#define XB_XSUB(j)  (1280 + 64 * (j))
#define XB_XGEN(j)  (2304 + 64 * (j))
#define XB_TOP      3328
#define XB_TOPGEN   3392
#define XCD_BAR_WORDS 3456
#define XB_SPIN_CAP (1u << 18)
__device__ __forceinline__ unsigned xb_ld(unsigned* p)              { return __hip_atomic_load(p, __ATOMIC_RELAXED, __HIP_MEMORY_SCOPE_AGENT); }
__device__ __forceinline__ unsigned xb_add(unsigned* p, unsigned v) { return __hip_atomic_fetch_add(p, v, __ATOMIC_RELAXED, __HIP_MEMORY_SCOPE_AGENT); }
__device__ __forceinline__ unsigned xb_xcc_id() { return (unsigned)__builtin_amdgcn_s_getreg((3 << 11) | 20) & 0xFu; }
#define XB_SPIN(cond, bar) do { unsigned _sp = 0; while (cond) { __builtin_amdgcn_s_sleep(1); \
    if ((++_sp & 255u) == 0u) { if (xb_ld(&(bar)[XB_TMO])) break; if (_sp > XB_SPIN_CAP) { atomicAdd(&(bar)[XB_TMO], 1u); break; } } } } while (0)
struct XcdBarrier { unsigned* bar; unsigned x; volatile LAS unsigned* st; };
__device__ __forceinline__ XcdBarrier xcd_barrier_post(unsigned* bar, volatile LAS unsigned* st) {
    XcdBarrier b; b.bar = bar; b.x = xb_xcc_id(); b.st = st;
    if (threadIdx.x == 0) (void)xb_add(&bar[XB_XCNT(b.x)], 1u);
    return b;
}
__device__ __forceinline__ void xcd_barrier_complete(unsigned* bar, unsigned x, unsigned& nloc, unsigned& nx) {
    const unsigned G = gridDim.x * gridDim.y * gridDim.z;
    unsigned sum, cnt, mine, sp = 0u;
    for (;;) {
        sum = 0u; cnt = 0u; mine = 0u;
#pragma unroll
        for (unsigned j = 0; j < 16; ++j) { const unsigned c = xb_ld(&bar[XB_XCNT(j)]); sum += c; cnt += (c > 0u) ? 1u : 0u; mine = (j == x) ? c : mine; }
        if (sum == G) break;
        __builtin_amdgcn_s_sleep(1);
        if ((++sp & 255u) == 0u) { if (xb_ld(&bar[XB_TMO])) break; if (sp > XB_SPIN_CAP) { atomicAdd(&bar[XB_TMO], 1u); break; } }
    }
    nloc = mine > 0u ? mine : 1u; nx = cnt > 0u ? cnt : 1u;
}
__device__ __forceinline__ void xcd_barrier(const XcdBarrier& b) {
    asm volatile("s_waitcnt vmcnt(0)" ::: "memory");
    __syncthreads();
    if (threadIdx.x == 0) {
        unsigned* bar = b.bar;
        __builtin_amdgcn_s_waitcnt(0);
        unsigned nloc = b.st[0], nx = b.st[1];
        if (nloc == 0u) { xcd_barrier_complete(bar, b.x, nloc, nx); b.st[0] = nloc; b.st[1] = nx; }
        const unsigned old = xb_add(&bar[XB_XSUB(b.x)], 1u);
        const unsigned gen = old / nloc;
        if (old + 1u == (gen + 1u) * nloc) {
            __builtin_amdgcn_fence(__ATOMIC_RELEASE, "agent");
            asm volatile("s_waitcnt vmcnt(0)" ::: "memory");
            const unsigned og = xb_add(&bar[XB_TOP], 1u);
            const unsigned tg = og / nx;
            if (og + 1u == (tg + 1u) * nx) xb_add(&bar[XB_TOPGEN], 1u);
            else XB_SPIN(xb_ld(&bar[XB_TOPGEN]) == tg, bar);
            __builtin_amdgcn_fence(__ATOMIC_ACQUIRE, "agent");
            xb_add(&bar[XB_XGEN(b.x)], 1u);
            asm volatile("s_waitcnt vmcnt(0)" ::: "memory");
        } else {
            XB_SPIN(xb_ld(&bar[XB_XGEN(b.x)]) == gen, bar);
            __builtin_amdgcn_fence(__ATOMIC_ACQUIRE, "agent");
            asm volatile("s_waitcnt vmcnt(0)" ::: "memory");
        }
    }
    __syncthreads();
}

struct Args { const float* in[29]; float* out; unsigned char* ws; int ph_lo, ph_hi; };
enum { I_XP = 0, I_XS, I_SCONV, I_SH, I_CP, I_CS, I_WADA, I_BADA, I_F1GU, I_F1D, I_F2GU, I_F2D, I_WIN, I_CONVW, I_CONVB, I_LWA, I_LBA, I_LWX, I_LBX, I_LAM, I_GLNG, I_GLNB, I_GWS, I_GBS, I_WPA, I_WPB, I_WOUT, I_LNG, I_LNB };
constexpr int NPHASE = 15;

__device__ __forceinline__ void transpose_item(const float* W, int N, bf16_t* WT, int ldd, int koff, int mode, LAS float* scr, int item, int lane) {
    const int nblk = N / 32, kb = item / nblk, nb = item % nblk, k0 = 64 * kb, n0 = 32 * nb;
    float tv[32];
#pragma unroll
    for (int i = 0; i < 32; ++i) tv[i] = W[(size_t)(k0 + 2 * i + (lane >> 5)) * N + n0 + (lane & 31)];
#pragma unroll
    for (int i = 0; i < 32; ++i) scr[(2 * i + (lane >> 5)) * 33 + (lane & 31)] = tv[i];
    LDS_WAIT(); asm volatile("" ::: "memory");
    int d0 = n0;
    if (mode == 1) { const int half = n0 >= DFF ? 1 : 0, jj = n0 - half * DFF; d0 = 256 * (jj >> 7) + 128 * half + (jj & 127); }
    const int c = lane & 7;
#pragma unroll
    for (int j = 0; j < 4; ++j) { const int n = (lane >> 3) + 8 * j; const LAS float* s = scr + (8 * c) * 33 + n;
        u32x4 o; o.x = pk2(s[0 * 33], s[1 * 33]); o.y = pk2(s[2 * 33], s[3 * 33]); o.z = pk2(s[4 * 33], s[5 * 33]); o.w = pk2(s[6 * 33], s[7 * 33]);
        *(u32x4*)(WT + (size_t)(d0 + n) * ldd + koff + k0 + 8 * c) = o; }
    LDS_WAIT(); asm volatile("" ::: "memory");
}


template <int MODE> __device__ __forceinline__ void lru_item(const Args& args, const bf16_t* PROJ, const bf16_t* WLRU, bf16_t* YAB, float* SEGA, float* SEGH, float* out, LAS unsigned char* wl, int it, int lane) {
    const int n = it & 15, e = lane, ch = n * 64 + e, fr = lane & 15, fq = lane >> 4;
    int b = 0, seg = 0, row0, b0 = 0;
    if (MODE == 2) { b0 = (it >> 4) * 4; row0 = NP + b0 * 4; } else { const int idx = it >> 4; b = idx >> 5; seg = idx & 31; row0 = b * SEQ + seg * SEGL; }
    LAS bf16_t* XA = (LAS bf16_t*)wl; LAS float* PR = (LAS float*)(wl + 2304); LAS float* PI = (LAS float*)(wl + 6400);
    bf16x8 wfa[4][2], wfx[4][2];
#pragma unroll
    for (int et = 0; et < 4; ++et)
#pragma unroll
        for (int kc = 0; kc < 2; ++kc) { wfa[et][kc] = *(const bf16x8*)(WLRU + ((size_t)(n * 64 + 16 * et + fr)) * 64 + 32 * kc + 8 * fq); wfx[et][kc] = *(const bf16x8*)(WLRU + ((size_t)((16 + n) * 64 + 16 * et + fr)) * 64 + 32 * kc + 8 * fq); }
    const float cw0 = args.in[I_CONVW][ch], cw1 = args.in[I_CONVW][DR + ch], cw2 = args.in[I_CONVW][2 * DR + ch], cw3 = args.in[I_CONVW][3 * DR + ch], cbv = args.in[I_CONVB][ch];
    const float ba = args.in[I_LBA][ch], bxv = args.in[I_LBX][ch];
    const float sp8 = -8.0f * log1pf(expf(-args.in[I_LAM][ch]));
    float x1 = 0.f, x2 = 0.f, x3 = 0.f, h = 0.f, P = 1.f;
    if (MODE != 2 && seg > 0) { x1 = bf2f(PROJ[(size_t)(row0 - 1) * INC + ch]); x2 = bf2f(PROJ[(size_t)(row0 - 2) * INC + ch]); x3 = bf2f(PROJ[(size_t)(row0 - 3) * INC + ch]); }
    if (MODE == 1) {
        for (int s0 = 0; s0 < seg; s0 += 8) { float av[8], hv[8];
#pragma unroll
            for (int j = 0; j < 8; ++j) { const int s = s0 + j < seg ? s0 + j : seg - 1; av[j] = SEGA[(size_t)(b * NSEG + s) * DR + ch]; hv[j] = SEGH[(size_t)(b * NSEG + s) * DR + ch]; }
#pragma unroll
            for (int j = 0; j < 8; ++j) if (s0 + j < seg) h = av[j] * h + hv[j]; }
    }
    constexpr int NTILE = MODE == 2 ? 1 : 4;
    bf16_t xn[16], gn[16];
#pragma unroll
    for (int t = 0; t < 16; ++t) { const size_t row = (size_t)(row0 + t); xn[t] = PROJ[row * INC + ch]; if (MODE != 0) gn[t] = PROJ[row * INC + DR + ch]; }
    for (int tile = 0; tile < NTILE; ++tile) {
        float xv[16], grv[16], xc[16];
#pragma unroll
        for (int t = 0; t < 16; ++t) { xv[t] = bf2f(xn[t]); if (MODE != 0) grv[t] = bf2f(gn[t]); }
        if (tile + 1 < NTILE) {
#pragma unroll
            for (int t = 0; t < 16; ++t) { const size_t row = (size_t)(row0 + (tile + 1) * 16 + t); xn[t] = PROJ[row * INC + ch]; if (MODE != 0) gn[t] = PROJ[row * INC + DR + ch]; } }
#pragma unroll
        for (int t = 0; t < 16; ++t) {
            if (MODE == 2 && (t & 3) == 0) { const size_t bg = (size_t)(b0 + tile * 4 + (t >> 2)); x3 = args.in[I_SCONV][(bg * 3 + 0) * DR + ch]; x2 = args.in[I_SCONV][(bg * 3 + 1) * DR + ch]; x1 = args.in[I_SCONV][(bg * 3 + 2) * DR + ch]; }
            xc[t] = cbv + cw0 * x3 + cw1 * x2 + cw2 * x1 + cw3 * xv[t];
            x3 = x2; x2 = x1; x1 = xv[t];
            XA[t * 72 + e] = (bf16_t)f2bf(xc[t]); }
        LDS_WAIT();
        bf16x8 yf[2];
#pragma unroll
        for (int kc = 0; kc < 2; ++kc) yf[kc] = *(const LAS bf16x8*)(XA + fr * 72 + 32 * kc + 8 * fq);
#pragma unroll
        for (int et = 0; et < 4; ++et) { f32x4 dr = (f32x4){0.f, 0.f, 0.f, 0.f}, di = (f32x4){0.f, 0.f, 0.f, 0.f};
            dr = __builtin_amdgcn_mfma_f32_16x16x32_bf16(yf[0], wfa[et][0], dr, 0, 0, 0); dr = __builtin_amdgcn_mfma_f32_16x16x32_bf16(yf[1], wfa[et][1], dr, 0, 0, 0);
            di = __builtin_amdgcn_mfma_f32_16x16x32_bf16(yf[0], wfx[et][0], di, 0, 0, 0); di = __builtin_amdgcn_mfma_f32_16x16x32_bf16(yf[1], wfx[et][1], di, 0, 0, 0);
#pragma unroll
            for (int r = 0; r < 4; ++r) { PR[(4 * fq + r) * 64 + 16 * et + fr] = dr[r]; PI[(4 * fq + r) * 64 + 16 * et + fr] = di[r]; } }
        LDS_WAIT();
#pragma unroll
        for (int t = 0; t < 16; ++t) {
            const float pr = PR[t * 64 + e] + ba, pi = PI[t * 64 + e] + bxv;
            const float rg = sigmoid_fast(pr), ig = sigmoid_fast(pi);
            const float la = sp8 * rg, a = __expf(la), x = 2.0f * la;
            const float em = -x * (1.0f + x * (0.5f + x * (0.16666667f + x * (0.041666668f + x * (0.0083333338f + x * 0.0013888889f)))));
            float mult = sqrtf(em);
            if (MODE != 2 && seg == 0 && tile == 0 && t == 0) mult = 1.0f;
            if (MODE == 2 && (t & 3) == 0) h = args.in[I_SH][(size_t)(b0 + tile * 4 + (t >> 2)) * DR + ch];
            h = a * h + mult * ig * xc[t];
            if (MODE == 0) P *= a;
            if (MODE != 0) { const size_t row = (size_t)(row0 + tile * 16 + t); YAB[row * DM + ch] = (bf16_t)f2bf(h * gelu_tanh(grv[t])); }
            if (MODE == 2) { const size_t bg = (size_t)(b0 + tile * 4 + (t >> 2)); if ((t & 3) == 3) out[O_HS + bg * DR + ch] = h; if ((t & 3) != 0) out[O_CS + (bg * 3 + (t & 3) - 1) * DR + ch] = xv[t]; }
            if (MODE == 1 && seg == NSEG - 1 && tile == 3) { if (t == 15) out[O_HP + (size_t)b * DR + ch] = h; if (t >= 13) out[O_CP + ((size_t)b * 3 + (t - 13)) * DR + ch] = xv[t]; }
        }
        LDS_WAIT();
    }
    if (MODE == 0) { SEGA[(size_t)(b * NSEG + seg) * DR + ch] = P; SEGH[(size_t)(b * NSEG + seg) * DR + ch] = h; }
}

template <int KIND> __device__ __forceinline__ void phase_body(const Args& args, const int ph, LAS unsigned char* lds) {

    int tid_ = threadIdx.x; asm volatile("" : "+v"(tid_));
    const int tid = tid_, lane = tid & 63, wave = __builtin_amdgcn_readfirstlane(tid >> 6);
    int bx_ = blockIdx.x; asm volatile("" : "+s"(bx_));
    const int G = gridDim.x, bx = bx_;
    const int gw = bx * NWAVES + wave, NGW = G * NWAVES;
    unsigned char* ws = args.ws; asm volatile("" : "+s"(ws));
    bf16_t* W1GU = (bf16_t*)(ws + OFF_W1GU); bf16_t* W1D = (bf16_t*)(ws + OFF_W1D); bf16_t* W2GU = (bf16_t*)(ws + OFF_W2GU); bf16_t* W2D = (bf16_t*)(ws + OFF_W2D);
    bf16_t* WIN = (bf16_t*)(ws + OFF_WIN); bf16_t* WPAB = (bf16_t*)(ws + OFF_WPAB); bf16_t* WOUT = (bf16_t*)(ws + OFF_WOUT); bf16_t* WADA = (bf16_t*)(ws + OFF_WADA);
    bf16_t* SC = (bf16_t*)(ws + OFF_SC); float* MOD = (float*)(ws + OFF_MOD); bf16_t* U = (bf16_t*)(ws + OFF_U); bf16_t* YAB = (bf16_t*)(ws + OFF_YAB);
    float* X = (float*)(ws + OFF_X); bf16_t* HP = (bf16_t*)(ws + OFF_HP); float* HL = (float*)(ws + OFF_HL); float* PP = (float*)(ws + OFF_PP);
    float* SEGA = (float*)(ws + OFF_SEG); float* SEGH = SEGA + 4 * NSEG * DR;
    float* out = args.out;

        if constexpr (KIND == 0) {
            LAS float* scr = (LAS float*)(lds + wave * 16384);
            constexpr int I_ADA = 32 * (NMOD / 32), I_GU = 32 * (2 * DFF / 32), I_D = (DFF / 64) * (DM / 32), I_IN = 32 * (INC / 32), I_PA = (DR / 64) * (DM / 32), I_OUT = 32 * (DM / 32);
            constexpr int NIT = I_ADA + 2 * I_GU + 2 * I_D + I_IN + 2 * I_PA + I_OUT;
            for (int it = gw; it < NIT; it += NGW) {
                int r = it;
                if (r < I_ADA) { transpose_item(args.in[I_WADA], NMOD, WADA, DM, 0, 0, scr, r, lane); continue; } r -= I_ADA;
                if (r < I_GU) { transpose_item(args.in[I_F1GU], 2 * DFF, W1GU, DM, 0, 1, scr, r, lane); continue; } r -= I_GU;
                if (r < I_D) { transpose_item(args.in[I_F1D], DM, W1D, DFF, 0, 0, scr, r, lane); continue; } r -= I_D;
                if (r < I_IN) { transpose_item(args.in[I_WIN], INC, WIN, DM, 0, 0, scr, r, lane); continue; } r -= I_IN;
                if (r < I_PA) { transpose_item(args.in[I_WPA], DM, WPAB, DM, 0, 0, scr, r, lane); continue; } r -= I_PA;
                if (r < I_PA) { transpose_item(args.in[I_WPB], DM, WPAB, DM, DR, 0, scr, r, lane); continue; } r -= I_PA;
                if (r < I_OUT) { transpose_item(args.in[I_WOUT], DM, WOUT, DM, 0, 0, scr, r, lane); continue; } r -= I_OUT;
                if (r < I_GU) { transpose_item(args.in[I_F2GU], 2 * DFF, W2GU, DM, 0, 1, scr, r, lane); continue; } r -= I_GU;
                transpose_item(args.in[I_F2D], DM, W2D, DFF, 0, 0, scr, r, lane);
            }
            for (int i = bx * 512 + tid; i < 256 * DM / 2; i += G * 512) { const int row = i / (DM / 2), c2 = (i % (DM / 2)) * 2;
                float v0 = 0.f, v1 = 0.f;
                if (row < 132) { const float* cp = row < 4 ? args.in[I_CP] + (size_t)row * DM : args.in[I_CS] + (size_t)(row - 4) * DM; const float a = cp[c2], b = cp[c2 + 1]; v0 = a / (1.0f + expf(-a)); v1 = b / (1.0f + expf(-b)); }
                ((unsigned*)SC)[i] = pk2(v0, v1); }
            for (int i = bx * 512 + tid; i < 2 * 16 * 64 * 64; i += G * 512) { const int gate = i >> 16, n = (i >> 12) & 15, e = (i >> 6) & 63, d = i & 63;
                ((bf16_t*)(ws + OFF_WLRU))[i] = (bf16_t)f2bf(args.in[gate ? I_LWX : I_LWA][(size_t)n * 4096 + d * 64 + e]); }
        }
        if constexpr (KIND == 1) {
            pg8::Gemm g{DM, DM}; pg8::TileSched S; S.init(SC, WADA, DM, DM, 256, NMOD, DM, G, bx);
            pg8::EpiF32 E{MOD, NMOD, args.in[I_BADA]};
            pg8::gemm_phase<pg8::EpiF32, pg8::TileSched>(lds, g, S, E);
        }
        if constexpr (KIND == 2) {
            for (int r = gw; r < MR; r += NGW) {
                const float* xr = r < NP ? args.in[I_XP] + (size_t)r * DM : args.in[I_XS] + (size_t)(r - NP) * DM;
                const float* md = MOD + (size_t)modrow(r) * NMOD;
#pragma unroll
                for (int j = 0; j < 8; ++j) { const int c = lane * 4 + 256 * j; const f32x4 x = *(const f32x4*)(xr + c), sh = *(const f32x4*)(md + c), sc = *(const f32x4*)(md + DM + c);
                    const f32x4 u = x * (1.0f + sc) + sh; u32x2 w; w.x = pk2(u[0], u[1]); w.y = pk2(u[2], u[3]); *(u32x2*)(U + (size_t)r * DM + c) = w; }
            }
        }
        if constexpr (KIND == 3) {
            pg8::Gemm g{DM, DM}; pg8::TileSched S; S.init(U, ph == 3 ? W1GU : W2GU, DM, DM, MR, 2 * DFF, DM, G, bx);
            pg8::EpiSwiglu E{HP};
            pg8::gemm_phase<pg8::EpiSwiglu, pg8::TileSched>(lds, g, S, E);
        }
        if constexpr (KIND == 4) {
            const int Kd = ph == 10 ? DM : DFF;
            pg8::Gemm g{Kd, Kd}; pg8::TileSched S; S.init(ph == 10 ? U : HP, ph == 4 ? W1D : (ph == 10 ? WOUT : W2D), Kd, Kd, NP, DM, Kd, G, bx);
            S.s_pm0 = NP / 256; S.s_nM = NS / 256; S.s_splits = ph == 10 ? 8 : 11; S.s_nt = ph == 10 ? 4 : 8;
            pg8::EpiResid E{ph == 4 ? args.in[I_XP] : X, ph == 4 ? args.in[I_XS] : X + (size_t)NP * DM, X, MOD, ph == 4 ? 2 : (ph == 10 ? 5 : 8), ph == 10 ? 1.0f : 0.5f, (float*)(ws + OFF_WADA)};
            pg8::gemm_phase<pg8::EpiResid, pg8::TileSched>(lds, g, S, E);
        }
        if constexpr (KIND == 5) {
            const int li = ph == 5 ? 0 : (ph == 11 ? 1 : 2);
            const float* lg = args.in[I_LNG] + li * DM; const float* lb = args.in[I_LNB] + li * DM;
            float* dst = ph == 14 ? out + O_Y : X;
            f32x4 lgv[8], lbv[8], nx[8];
#pragma unroll
            for (int j = 0; j < 8; ++j) { lgv[j] = *(const f32x4*)(lg + lane * 4 + 256 * j); lbv[j] = *(const f32x4*)(lb + lane * 4 + 256 * j); }
            int r = gw;
            if (r < NP) {
#pragma unroll
                for (int j = 0; j < 8; ++j) nx[j] = *(const f32x4*)(X + (size_t)r * DM + lane * 4 + 256 * j); }
            for (; r < MR; r += NGW) {
                f32x4 v[8]; float s = 0.f;
                if (r < NP) {
#pragma unroll
                    for (int j = 0; j < 8; ++j) v[j] = nx[j];
                } else {
                    const float* xsrc = li == 0 ? args.in[I_XS] + (size_t)(r - NP) * DM : X + (size_t)r * DM;
                    const float* gt = MOD + (size_t)modrow(r) * NMOD + (3 * li + 2) * DM; const float coef = li == 1 ? 1.0f : 0.5f;
                    const float* pt = (const float*)(ws + OFF_WADA) + (size_t)(r - NP) * DM;
#define SUMSLABS(NSL) _Pragma("unroll") for (int j = 0; j < 8; ++j) { const int c = lane * 4 + 256 * j; f32x4 a = *(const f32x4*)(pt + c); \
                        _Pragma("unroll") for (int k = 1; k < NSL; ++k) a += *(const f32x4*)(pt + (size_t)k * NS * DM + c); \
                        v[j] = *(const f32x4*)(xsrc + c) * ALPHA + *(const f32x4*)(gt + c) * coef * a; }
                    if (li == 1) { SUMSLABS(8) } else { SUMSLABS(11) }
#undef SUMSLABS
                }
                const int rn = r + NGW;
                if (rn < NP) {
#pragma unroll
                    for (int j = 0; j < 8; ++j) nx[j] = *(const f32x4*)(X + (size_t)rn * DM + lane * 4 + 256 * j); }
#pragma unroll
                for (int j = 0; j < 8; ++j) s += (v[j][0] + v[j][1]) + (v[j][2] + v[j][3]);
                const float mean = wave_sum(s) * (1.0f / DM); float q = 0.f;
#pragma unroll
                for (int j = 0; j < 8; ++j) { v[j] = v[j] - mean; q += (v[j][0] * v[j][0] + v[j][1] * v[j][1]) + (v[j][2] * v[j][2] + v[j][3] * v[j][3]); }
                const float rstd = 1.0f / sqrtf(wave_sum(q) * (1.0f / DM) + LN_EPS);
                const float* md = MOD + (size_t)modrow(r) * NMOD + (3 * (li + 1)) * DM;
#pragma unroll
                for (int j = 0; j < 8; ++j) { const int c = lane * 4 + 256 * j; const f32x4 y = v[j] * rstd * lgv[j] + lbv[j];
                    *(f32x4*)(dst + (size_t)r * DM + c) = y;
                    if (ph != 14) { const f32x4 sh = *(const f32x4*)(md + c), sc = *(const f32x4*)(md + DM + c); const f32x4 u = y * (1.0f + sc) + sh; u32x2 w; w.x = pk2(u[0], u[1]); w.y = pk2(u[2], u[3]); *(u32x2*)(U + (size_t)r * DM + c) = w; } }
            }
        }
        if constexpr (KIND == 6) {
            pg8::Gemm g{DM, DM}; pg8::TileSched S; S.init(U, WIN, DM, DM, MR, INC, DM, G, bx);
            pg8::EpiBf16 E{HP, INC, (f32x2*)(ws + OFF_STP)};
            pg8::gemm_phase<pg8::EpiBf16, pg8::TileSched>(lds, g, S, E);
        }
        if constexpr (KIND == 7) {
            const bf16_t* PROJ = HP; const bf16_t* WLRU = (const bf16_t*)(ws + OFF_WLRU);
            for (int it = gw; it < 2048; it += NGW) lru_item<0>(args, PROJ, WLRU, YAB, SEGA, SEGH, out, lds + wave * 10496, it, lane);
            for (int it = (gw * 4) % NGW + (gw * 4) / NGW; it < 512; it += NGW) lru_item<2>(args, PROJ, WLRU, YAB, SEGA, SEGH, out, lds + wave * 10496, it, lane);
            __syncthreads();
            {
                LAS bf16_t* VN = (LAS bf16_t*)lds;
                LAS bf16_t* WT = (LAS bf16_t*)(lds + 34816);
                LAS float* st = (LAS float*)(lds + 69632);
                const float* lg = args.in[I_GLNG]; const float* lb = args.in[I_GLNB];
                const int fr = lane & 15, fq = lane >> 4;
                int g_loaded = -1;
                for (int it = bx; it < 512; it += G) {
                    const int g = it & 7, pc = it >> 3, b = pc >> 4, c = pc & 15, row0 = b * SEQ + c * 128;
                    __syncthreads();
                    if (g != g_loaded) { g_loaded = g;
                        for (int i = tid; i < 128 * 32; i += 512) { const int t = i >> 5, s4 = (i & 31) * 4; const f32x4 w = *(const f32x4*)(args.in[I_GWS] + (size_t)g * 16384 + t * 128 + s4);
                            u32x2 o; o.x = pk2(s4 + 0 <= t ? w[0] : 0.f, s4 + 1 <= t ? w[1] : 0.f); o.y = pk2(s4 + 2 <= t ? w[2] : 0.f, s4 + 3 <= t ? w[3] : 0.f); *(LAS u32x2*)(WT + t * 136 + s4) = o; } }
                    if (tid < 128) { const f32x4* sp = (const f32x4*)((const f32x2*)(ws + OFF_STP) + (size_t)(row0 + tid) * 16); float s = 0.f, q = 0.f;
#pragma unroll
                        for (int j = 0; j < 8; ++j) { const f32x4 v = sp[j]; s += v[0] + v[2]; q += v[1] + v[3]; }
                        const float mean = s * (1.0f / DR), var = fmaxf(q * (1.0f / DR) - mean * mean, 0.f);
                        st[tid * 2] = mean; st[tid * 2 + 1] = 1.0f / sqrtf(var + LN_EPS); }
                    __syncthreads();
#pragma unroll
                    for (int i = 0; i < 4; ++i) { const int task = tid + 512 * i, s = task >> 4, dc = task & 15, chn = g * 128 + dc * 8;
                        const u32x4 p = *(const u32x4*)(PROJ + (size_t)(row0 + s) * INC + 3072 + chn); const float mean = st[s * 2], rstd = st[s * 2 + 1];
                        const f32x4 g0 = *(const f32x4*)(lg + chn), g1 = *(const f32x4*)(lg + chn + 4), b0v = *(const f32x4*)(lb + chn), b1v = *(const f32x4*)(lb + chn + 4);
                        u32x4 o; o.x = pk2((bflo(p[0]) - mean) * rstd * g0[0] + b0v[0], (bfhi(p[0]) - mean) * rstd * g0[1] + b0v[1]); o.y = pk2((bflo(p[1]) - mean) * rstd * g0[2] + b0v[2], (bfhi(p[1]) - mean) * rstd * g0[3] + b0v[3]);
                        o.z = pk2((bflo(p[2]) - mean) * rstd * g1[0] + b1v[0], (bfhi(p[2]) - mean) * rstd * g1[1] + b1v[1]); o.w = pk2((bflo(p[3]) - mean) * rstd * g1[2] + b1v[2], (bfhi(p[3]) - mean) * rstd * g1[3] + b1v[3]);
                        *(LAS u32x4*)(VN + s * 136 + dc * 8) = o; }
                    __syncthreads();
                    bf16x8 vf[4];
#pragma unroll
                    for (int kc = 0; kc < 4; ++kc) { short tmp[8];
#pragma unroll
                        for (int j = 0; j < 8; ++j) tmp[j] = (short)VN[(32 * kc + 8 * fq + j) * 136 + 16 * wave + fr];
                        vf[kc] = (bf16x8){tmp[0], tmp[1], tmp[2], tmp[3], tmp[4], tmp[5], tmp[6], tmp[7]}; }
#pragma unroll
                    for (int tt = 0; tt < 8; ++tt) { f32x4 acc = (f32x4){0.f, 0.f, 0.f, 0.f};
#pragma unroll
                        for (int kc = 0; kc <= (16 * tt + 15) / 32; ++kc) { const bf16x8 wf = *(const LAS bf16x8*)(WT + (16 * tt + fr) * 136 + 32 * kc + 8 * fq); acc = __builtin_amdgcn_mfma_f32_16x16x32_bf16(vf[kc], wf, acc, 0, 0, 0); }
                        const int t = 16 * tt + fr, col = g * 128 + 16 * wave + 4 * fq; const size_t row = (size_t)(row0 + t);
                        const float bsv = args.in[I_GBS][g * 128 + t]; const u32x2 gu = *(const u32x2*)(PROJ + row * INC + 2048 + col);
                        u32x2 o; o.x = pk2(bflo(gu.x) * (acc[0] + bsv), bfhi(gu.x) * (acc[1] + bsv)); o.y = pk2(bflo(gu.y) * (acc[2] + bsv), bfhi(gu.y) * (acc[3] + bsv));
                        *(u32x2*)(YAB + row * DM + DR + col) = o; }
                }
            }
            for (int bg = NGW - 1 - gw; bg < 128; bg += NGW) {
                float vnv[4][16];
#pragma unroll
                for (int t = 0; t < 4; ++t) { const bf16_t* gvp = PROJ + (size_t)(NP + bg * 4 + t) * INC + 3072;
                    const u32x4 p0 = *(const u32x4*)(gvp + lane * 8), p1 = *(const u32x4*)(gvp + 512 + lane * 8);
#pragma unroll
                    for (int q = 0; q < 4; ++q) { vnv[t][2 * q] = bflo(p0[q]); vnv[t][2 * q + 1] = bfhi(p0[q]); vnv[t][8 + 2 * q] = bflo(p1[q]); vnv[t][8 + 2 * q + 1] = bfhi(p1[q]); }
                    float s = 0.f, qq = 0.f; { const f32x4* sp = (const f32x4*)((const f32x2*)(ws + OFF_STP) + (size_t)(NP + bg * 4 + t) * 16);
#pragma unroll
                        for (int j = 0; j < 8; ++j) { const f32x4 v = sp[j]; s += v[0] + v[2]; qq += v[1] + v[3]; } }
                    const float mean = s * (1.0f / DR), rstd = 1.0f / sqrtf(fmaxf(qq * (1.0f / DR) - mean * mean, 0.f) + LN_EPS);
#pragma unroll
                    for (int q = 0; q < 16; ++q) { const int chn = (q >> 3) * 512 + lane * 8 + (q & 7); vnv[t][q] = (vnv[t][q] - mean) * rstd * args.in[I_GLNG][chn] + args.in[I_GLNB][chn]; }
                    float* vo = out + O_VS + (size_t)(bg * 4 + t) * DR;
#pragma unroll
                    for (int j = 0; j < 2; ++j) { *(f32x4*)(vo + j * 512 + lane * 8) = (f32x4){vnv[t][j * 8 + 0], vnv[t][j * 8 + 1], vnv[t][j * 8 + 2], vnv[t][j * 8 + 3]};
                        *(f32x4*)(vo + j * 512 + lane * 8 + 4) = (f32x4){vnv[t][j * 8 + 4], vnv[t][j * 8 + 5], vnv[t][j * 8 + 6], vnv[t][j * 8 + 7]}; }
                }
#pragma unroll
                for (int j = 0; j < 2; ++j) { const int g = (lane >> 4) + 4 * j; const float* wg = args.in[I_GWS] + (size_t)g * 16384; const float* bsg = args.in[I_GBS] + g * 128;
#pragma unroll
                    for (int t = 0; t < 4; ++t) { const size_t row = (size_t)NP + bg * 4 + t; const u32x4 gu = *(const u32x4*)(PROJ + row * INC + 2048 + j * 512 + lane * 8); float o[8];
#pragma unroll
                        for (int q = 0; q < 8; ++q) { float acc = bsg[t];
#pragma unroll
                            for (int s = 0; s < 4; ++s) if (s <= t) acc += wg[t * 128 + s] * vnv[s][j * 8 + q];
                            const float guv = (q & 1) ? bfhi(gu[q >> 1]) : bflo(gu[q >> 1]); o[q] = guv * acc; }
                        u32x4 w; w.x = pk2(o[0], o[1]); w.y = pk2(o[2], o[3]); w.z = pk2(o[4], o[5]); w.w = pk2(o[6], o[7]);
                        *(u32x4*)(YAB + row * DM + DR + j * 512 + lane * 8) = w; } }
            }
        }
        if constexpr (KIND == 8) {
            const bf16_t* PROJ = HP; const bf16_t* WLRU = (const bf16_t*)(ws + OFF_WLRU);
            for (int it = gw; it < 2048; it += NGW) lru_item<1>(args, PROJ, WLRU, YAB, SEGA, SEGH, out, lds + wave * 10496, it, lane);
        }
        if constexpr (KIND == 9) {
            pg8::Gemm g{DM, DM}; pg8::TileSched S; S.init(YAB, WPAB, DM, DM, MR, DM, DM, G, bx);
            pg8::EpiMerge E{HP, U};
            pg8::gemm_phase<pg8::EpiMerge, pg8::TileSched>(lds, g, S, E);
        }
}

__global__ void __launch_bounds__(NWAVES * 64, 2) fwd(Args args) {
    extern __shared__ __attribute__((aligned(16))) unsigned char lds_raw[];
    LAS unsigned char* lds = (LAS unsigned char*)lds_raw;
    cg::grid_group grid = cg::this_grid();
    if (args.ph_hi > 1000) grid.sync();
    volatile LAS unsigned* bst = (volatile LAS unsigned*)(lds + 131072 + 1024);
    if (threadIdx.x < 16) bst[threadIdx.x] = 0u;
    __syncthreads();
    XcdBarrier bar = xcd_barrier_post((unsigned*)args.ws, bst);
    for (int ph_ = args.ph_lo; ph_ < args.ph_hi + (REPEAT_PH >= 0 ? 1 : 0); ++ph_) {
        const int ph = (REPEAT_PH >= 0 && ph_ > REPEAT_PH) ? ph_ - 1 : ph_;
        switch (ph) {
        case 0: phase_body<0>(args, ph, lds); break;
        case 1: phase_body<1>(args, ph, lds); break;
        case 2: phase_body<2>(args, ph, lds); break;
        case 3: case 12: phase_body<3>(args, ph, lds); break;
        case 4: case 10: case 13: phase_body<4>(args, ph, lds); break;
        case 5: case 11: case 14: phase_body<5>(args, ph, lds); break;
        case 6: phase_body<6>(args, ph, lds); break;
        case 7: phase_body<7>(args, ph, lds); break;
        case 8: phase_body<8>(args, ph, lds); break;
        case 9: phase_body<9>(args, ph, lds); break;
        default: break;
        }
        if (ph_ + 1 < args.ph_hi + (REPEAT_PH >= 0 ? 1 : 0)) xcd_barrier(bar);
    }
}


#ifdef DIAG_KINDS
template <int KIND> __global__ void __launch_bounds__(NWAVES * 64, 2) diag(Args args) {
    extern __shared__ __attribute__((aligned(16))) unsigned char lds_raw[];
    phase_body<KIND>(args, args.ph_lo, (LAS unsigned char*)lds_raw);
}
template __global__ void diag<0>(Args); template __global__ void diag<1>(Args); template __global__ void diag<2>(Args); template __global__ void diag<3>(Args); template __global__ void diag<4>(Args);
template __global__ void diag<5>(Args); template __global__ void diag<6>(Args); template __global__ void diag<7>(Args); template __global__ void diag<8>(Args); template __global__ void diag<9>(Args);
#endif
extern "C" void kernel_launch(void* const* d_in, const int* in_sizes, int n_in, void* d_out, int out_size, void* d_ws, size_t ws_size, hipStream_t stream) {
    static int grid = 0;
    if (grid == 0) {
        if (n_in != 29 || ws_size < WS_END) { fprintf(stderr, "kernel_launch: need 29 inputs and %zu bytes of ws; got %d, %zu\n", (size_t)WS_END, n_in, ws_size); grid = -1; return; }
        int dev = 0, cus = 0, per_cu = 0;
        hipGetDevice(&dev); hipDeviceGetAttribute(&cus, hipDeviceAttributeMultiprocessorCount, dev);
        if (hipFuncSetAttribute((const void*)fwd, hipFuncAttributeMaxDynamicSharedMemorySize, LDS_BYTES) != hipSuccess) { fprintf(stderr, "kernel_launch: hipFuncSetAttribute failed\n"); grid = -1; return; }
        if (hipOccupancyMaxActiveBlocksPerMultiprocessor(&per_cu, (const void*)fwd, NWAVES * 64, LDS_BYTES) != hipSuccess || per_cu < 1) { fprintf(stderr, "kernel_launch: occupancy query says %d\n", per_cu); per_cu = 1; }
        (void)hipGetLastError();
        grid = cus;
    }
    if (grid < 0) return;
    Args a{};
    for (int i = 0; i < 29; ++i) a.in[i] = (const float*)d_in[i];
    a.out = (float*)d_out; a.ws = (unsigned char*)d_ws;
#if ONE_LAUNCH
    a.ph_lo = 0; a.ph_hi = NPHASE;
    if (hipMemsetAsync(d_ws, 0, 16384, stream) != hipSuccess) { fprintf(stderr, "kernel_launch: memset of barrier words failed\n"); return; }
    { void* kargs[] = {&a}; hipError_t e = hipLaunchCooperativeKernel((const void*)fwd, dim3(grid), dim3(NWAVES * 64), kargs, LDS_BYTES, stream);
      if (e != hipSuccess) fprintf(stderr, "cooperative launch failed: %s (grid %d)\n", hipGetErrorString(e), grid); }
#else
    for (int ph = 0; ph < NPHASE; ++ph) { a.ph_lo = ph; a.ph_hi = ph + 1; void* kargs[] = {&a};
        hipError_t e = hipLaunchCooperativeKernel((const void*)fwd, dim3(grid), dim3(NWAVES * 64), kargs, LDS_BYTES, stream);
        if (e != hipSuccess) { fprintf(stderr, "cooperative launch %d failed: %s (grid %d)\n", ph, hipGetErrorString(e), grid); break; } }
#endif
}
```

```cpp
#include <hip/hip_runtime.h>
#include <hip/hip_cooperative_groups.h>
#include <cstdio>
#include <cstdint>
namespace cg = cooperative_groups;

#define REPEAT_PH -1
#ifndef ONE_LAUNCH
#define ONE_LAUNCH 1
#endif

#define LAS __attribute__((address_space(3)))
typedef unsigned short bf16_t;
typedef short bf16x8 __attribute__((ext_vector_type(8)));
typedef float f32x4 __attribute__((ext_vector_type(4)));
typedef float f32x2 __attribute__((ext_vector_type(2)));
typedef unsigned u32x4 __attribute__((ext_vector_type(4)));
typedef unsigned u32x2 __attribute__((ext_vector_type(2)));

constexpr int DM = 2048, NP = 8192, NS = 512, MR = NP + NS, DFF = 5632, DR = 1024, INC = 8192, NMOD = 9 * DM;
constexpr int SEQ = 2048, NSEG = 32, SEGL = 64;
constexpr float ALPHA = 1.189207115002721f;
constexpr float LN_EPS = 1e-5f;
constexpr int NWAVES = 8;

constexpr size_t MiB = 1u << 20;
constexpr size_t OFF_W1GU = 1 * MiB, OFF_W1D = 45 * MiB, OFF_W2GU = 67 * MiB, OFF_W2D = 111 * MiB, OFF_WIN = 133 * MiB, OFF_WPAB = 165 * MiB, OFF_WOUT = 173 * MiB;
constexpr size_t OFF_WLRU = 181 * MiB, OFF_SC = 182 * MiB, OFF_MOD = 183 * MiB, OFF_U = 201 * MiB, OFF_YAB = 235 * MiB, OFF_X = 269 * MiB, OFF_HP = 337 * MiB, OFF_WADA = 473 * MiB;
constexpr size_t OFF_STP = OFF_WADA + 66 * MiB;
constexpr size_t OFF_HL = OFF_WADA, OFF_PP = OFF_WADA + 32 * MiB, OFF_SEG = OFF_WADA + 64 * MiB, WS_END = 545 * MiB;

constexpr size_t O_Y = 0, O_CP = 17825792, O_HP = 17838080, O_CS = 17842176, O_HS = 18235392, O_VS = 18366464;

constexpr int LDS_BYTES = 131072 + 1024 + 64;

__device__ __forceinline__ unsigned f2bf(float f) { unsigned u = __builtin_bit_cast(unsigned, f); return (u + 0x7fffu + ((u >> 16) & 1u)) >> 16; }
__device__ __forceinline__ unsigned pk2(float lo, float hi) { return f2bf(lo) | (f2bf(hi) << 16); }
__device__ __forceinline__ float bflo(unsigned w) { return __builtin_bit_cast(float, w << 16); }
__device__ __forceinline__ float bfhi(unsigned w) { return __builtin_bit_cast(float, w & 0xffff0000u); }
__device__ __forceinline__ float bf2f(bf16_t b) { return __builtin_bit_cast(float, ((unsigned)b) << 16); }
__device__ __forceinline__ float wave_sum(float v) {
#pragma unroll
    for (int o = 1; o < 64; o <<= 1) v += __shfl_xor(v, o);
    return v;
}
__device__ __forceinline__ float sigmoid_fast(float x) { return __builtin_amdgcn_rcpf(1.0f + __expf(-x)); }
__device__ __forceinline__ float gelu_tanh(float x) { const float z = 0.7978845608028654f * (x + 0.044715f * x * x * x); return x * sigmoid_fast(2.0f * z); }
__device__ __forceinline__ int modrow(int r) { return r < NP ? (r >> 11) : 4 + ((r - NP) >> 2); }
#define LDS_WAIT() asm volatile("s_waitcnt lgkmcnt(0)" ::: "memory")

namespace pg8 {
constexpr int BM = 256, BK = 64, HALF = 128, HTB = HALF * BK * 2, STAGE_BYTES = 8 * HTB, NXCD = 8, WGM = 8;
__host__ __device__ __forceinline__ int lds_byte(int r, int c) { const int st = (r >> 4) * 2 + (c >> 5), rr = r & 15, cc = c & 31, ob = rr * 64 + cc * 2; return st * 1024 + (ob ^ (((ob >> 9) & 1) << 5)); }
__host__ __device__ __forceinline__ void stage_rc(int b, int& R, int& C) { const int st = b / 1024, sb = b % 1024, swz = sb ^ (((sb >> 9) & 1) << 5); R = (st >> 1) * 16 + swz / 64; C = (st & 1) * 32 + (swz % 64) / 2; }
__host__ __device__ __forceinline__ int perm32(int rho) { const int n = rho >> 4, i = rho & 15; return 8 * (i >> 2) + 4 * n + (i & 3); }

struct Unit { const char* a; const char* b; int nt, pm, pn, ks; };
struct Gemm { int lda, ldb; };

struct TileSched {
    const char* A; const char* Bt; size_t tA, tB;
    int nM, nN, nt, nwg, G, c, s_pm0, s_nM, s_splits, s_nt;
    __device__ void init(const bf16_t* A_, const bf16_t* Bt_, int lda, int ldb, int M, int N, int K, int G_, int c_) {
        A = (const char*)A_; Bt = (const char*)Bt_; tA = (size_t)BM * lda * 2; tB = (size_t)BM * ldb * 2; nM = M / BM; nN = N / BM; nt = K / BK; nwg = nM * nN; G = G_; c = c_; s_pm0 = 0; s_nM = 0; s_splits = 0; s_nt = 0; }
    __device__ bool next(int i, Unit& u) const {
        long L = (long)i * G + c;
        if (L < nwg) {
            int wgid = (int)L; { const int q = nwg / NXCD, r = nwg % NXCD, xcd = wgid % NXCD, off = wgid / NXCD; wgid = (xcd < r ? xcd * (q + 1) : r * (q + 1) + (xcd - r) * q) + off; }
            const int nig = WGM * nN, gid = wgid / nig, fm = gid * WGM, gsz = (nM - fm) < WGM ? (nM - fm) : WGM;
            u.pm = fm + ((wgid % nig) % gsz); u.pn = (wgid % nig) / gsz; u.nt = nt; u.ks = -1;
            u.a = A + (size_t)u.pm * tA; u.b = Bt + (size_t)u.pn * tB; return true; }
        L -= nwg; const int per = s_nM * nN;
        if (L >= (long)per * s_splits) return false;
        const int ks = (int)L / per, rem = (int)L % per;
        u.pm = s_pm0 + rem % s_nM; u.pn = rem / s_nM; u.nt = s_nt; u.ks = ks;
        u.a = A + (size_t)u.pm * tA + (size_t)ks * s_nt * (BK * 2); u.b = Bt + (size_t)u.pn * tB + (size_t)ks * s_nt * (BK * 2); return true;
    }
};

__device__ __forceinline__ unsigned cvt_pk_bf16(float lo, float hi) { unsigned r; asm volatile("v_cvt_pk_bf16_f32 %0, %1, %2" : "=v"(r) : "v"(lo), "v"(hi)); return r; }

struct EpiF32 {
    static constexpr bool PERM = false, HAS_MID = false;
    float* C; int ldc; const float* bias;
    __device__ __forceinline__ void mid(f32x4 (&acc)[2][2][4][2], const Unit& u, int wr, int wc, int fr, int fq) const {}
    __device__ __forceinline__ void operator()(const f32x4 (&acc)[2][2][4][2], const Unit& u, int wr, int wc, int fr, int fq) const {
        const int row0 = u.pm * BM + wr * 64 + fr, col0 = u.pn * BM + wc * 32 + 4 * fq;
        f32x4 bv[2][2];
#pragma unroll
        for (int bj = 0; bj < 2; ++bj)
#pragma unroll
            for (int n = 0; n < 2; ++n) bv[bj][n] = *(const f32x4*)(bias + col0 + bj * HALF + n * 16);
#pragma unroll
        for (int ai = 0; ai < 2; ++ai)
#pragma unroll
            for (int m = 0; m < 4; ++m) { float* rowp = C + (size_t)(row0 + ai * HALF + m * 16) * ldc + col0;
#pragma unroll
                for (int bj = 0; bj < 2; ++bj)
#pragma unroll
                    for (int n = 0; n < 2; ++n) *(f32x4*)(rowp + bj * HALF + n * 16) = acc[ai][bj][m][n] + bv[bj][n]; }
    }
};
struct EpiBf16 {
    static constexpr bool PERM = true, HAS_MID = false;
    bf16_t* O; int ldc; f32x2* STP;
    __device__ __forceinline__ void mid(f32x4 (&acc)[2][2][4][2], const Unit& u, int wr, int wc, int fr, int fq) const {}
    __device__ __forceinline__ void operator()(const f32x4 (&acc)[2][2][4][2], const Unit& u, int wr, int wc, int fr, int fq) const {
        const int row0 = u.pm * BM + wr * 64 + fr, col0 = u.pn * BM + wc * 32 + 8 * fq;
#pragma unroll
        for (int ai = 0; ai < 2; ++ai)
#pragma unroll
            for (int m = 0; m < 4; ++m) { bf16_t* rowp = O + (size_t)(row0 + ai * HALF + m * 16) * ldc + col0;
#pragma unroll
                for (int bj = 0; bj < 2; ++bj) { const f32x4 v0 = acc[ai][bj][m][0], v1 = acc[ai][bj][m][1];
                    u32x4 w; w.x = cvt_pk_bf16(v0[0], v0[1]); w.y = cvt_pk_bf16(v0[2], v0[3]); w.z = cvt_pk_bf16(v1[0], v1[1]); w.w = cvt_pk_bf16(v1[2], v1[3]);
                    *(u32x4*)(rowp + bj * HALF) = w; } }
        if (u.pn >= 12 && u.pn < 16) {
#pragma unroll
            for (int ai = 0; ai < 2; ++ai)
#pragma unroll
                for (int m = 0; m < 4; ++m) { float s = 0.f, q = 0.f;
#pragma unroll
                    for (int bj = 0; bj < 2; ++bj)
#pragma unroll
                        for (int n = 0; n < 2; ++n) { const f32x4 v = acc[ai][bj][m][n]; s += (v[0] + v[1]) + (v[2] + v[3]); q += (v[0] * v[0] + v[1] * v[1]) + (v[2] * v[2] + v[3] * v[3]); }
                    s += __shfl_xor(s, 16); q += __shfl_xor(q, 16); s += __shfl_xor(s, 32); q += __shfl_xor(q, 32);
                    if (fq == 0) STP[(size_t)(row0 + ai * HALF + m * 16) * 16 + (u.pn - 12) * 4 + wc] = (f32x2){s, q}; } }
    }
};
struct EpiSwiglu {
    static constexpr bool PERM = true, HAS_MID = false;
    bf16_t* H;
    __device__ __forceinline__ void mid(f32x4 (&acc)[2][2][4][2], const Unit& u, int wr, int wc, int fr, int fq) const {}
    __device__ __forceinline__ void operator()(const f32x4 (&acc)[2][2][4][2], const Unit& u, int wr, int wc, int fr, int fq) const {
        const int row0 = u.pm * BM + wr * 64 + fr, col0 = u.pn * HALF + wc * 32 + 8 * fq;
#pragma unroll
        for (int ai = 0; ai < 2; ++ai)
#pragma unroll
            for (int m = 0; m < 4; ++m) { bf16_t* rowp = H + (size_t)(row0 + ai * HALF + m * 16) * DFF + col0;
                float o[8];
#pragma unroll
                for (int n = 0; n < 2; ++n)
#pragma unroll
                    for (int j = 0; j < 4; ++j) { const float g = acc[ai][0][m][n][j], v = acc[ai][1][m][n][j]; o[n * 4 + j] = g * sigmoid_fast(g) * v; }
                u32x4 w; w.x = cvt_pk_bf16(o[0], o[1]); w.y = cvt_pk_bf16(o[2], o[3]); w.z = cvt_pk_bf16(o[4], o[5]); w.w = cvt_pk_bf16(o[6], o[7]);
                *(u32x4*)rowp = w; }
    }
};
struct EpiResid {
    static constexpr bool PERM = false, HAS_MID = false;
    const float* xp; const bf16_t* xb; bf16_t* ZB; const float* MOD; int gk; float coef; float* PART;
    __device__ __forceinline__ void mid(f32x4 (&acc)[2][2][4][2], const Unit& u, int wr, int wc, int fr, int fq) const {}
    __device__ __forceinline__ void operator()(const f32x4 (&acc)[2][2][4][2], const Unit& u, int wr, int wc, int fr, int fq) const {
        const int row0 = u.pm * BM + wr * 64 + fr, col0 = u.pn * BM + wc * 32 + 4 * fq;
        if (u.ks >= 0) {
#pragma unroll
            for (int ai = 0; ai < 2; ++ai)
#pragma unroll
                for (int m = 0; m < 4; ++m) { float* orow = PART + ((size_t)u.ks * NS + (row0 + ai * HALF + m * 16 - NP)) * DM + col0;
#pragma unroll
                    for (int bj = 0; bj < 2; ++bj)
#pragma unroll
                        for (int n = 0; n < 2; ++n) *(f32x4*)(orow + bj * HALF + n * 16) = acc[ai][bj][m][n]; }
            return; }
        unsigned offE = (unsigned)(row0 * DM + col0);
        asm volatile("" : "+v"(offE));
        f32x4 gv[2][2];
        { const float* md = MOD + (size_t)(u.pm >> 3) * NMOD + gk * DM + col0;
#pragma unroll
            for (int bj = 0; bj < 2; ++bj)
#pragma unroll
                for (int n = 0; n < 2; ++n) gv[bj][n] = *(const f32x4*)(md + bj * HALF + n * 16) * coef; }
#pragma unroll
        for (int ai = 0; ai < 2; ++ai)
#pragma unroll
            for (int m = 0; m < 4; ++m) { const unsigned off = offE + (unsigned)((ai * HALF + m * 16) * DM);
                f32x4 xv[2][2];
                if (xb) {
#pragma unroll
                    for (int bj = 0; bj < 2; ++bj)
#pragma unroll
                        for (int n = 0; n < 2; ++n) { const u32x2 p = *(const u32x2*)(xb + off + bj * HALF + n * 16); xv[bj][n] = (f32x4){bflo(p.x), bfhi(p.x), bflo(p.y), bfhi(p.y)}; }
                } else {
#pragma unroll
                    for (int bj = 0; bj < 2; ++bj)
#pragma unroll
                        for (int n = 0; n < 2; ++n) xv[bj][n] = *(const f32x4*)(xp + off + bj * HALF + n * 16);
                }
#pragma unroll
                for (int bj = 0; bj < 2; ++bj)
#pragma unroll
                    for (int n = 0; n < 2; ++n) { const f32x4 z = xv[bj][n] * ALPHA + gv[bj][n] * acc[ai][bj][m][n]; u32x2 w; w.x = cvt_pk_bf16(z[0], z[1]); w.y = cvt_pk_bf16(z[2], z[3]); *(u32x2*)(ZB + off + bj * HALF + n * 16) = w; }
                asm volatile("" ::: "memory"); }
    }
};
struct EpiMerge {
    static constexpr bool PERM = true, HAS_MID = true;
    const bf16_t* PROJ; bf16_t* O;
    __device__ __forceinline__ void mid(f32x4 (&acc)[2][2][4][2], const Unit& u, int wr, int wc, int fr, int fq) const {
        unsigned off = (unsigned)((u.pm * BM + wr * 64 + fr) * INC + u.pn * BM + wc * 32 + 8 * fq) * 2u;
        asm volatile("" : "+v"(off));
        const char* base = (const char*)PROJ;
#pragma unroll
        for (int ai = 0; ai < 2; ++ai) {
#pragma unroll
            for (int m = 0; m < 4; ++m) { const unsigned ro = off + (unsigned)((ai * HALF + m * 16) * INC * 2);
#pragma unroll
                for (int bj = 0; bj < 2; ++bj) { const u32x4 a = *(const u32x4*)(base + ro + (4096 + bj * HALF) * 2), b = *(const u32x4*)(base + ro + (6144 + bj * HALF) * 2);
#pragma unroll
                    for (int q = 0; q < 4; ++q) { const float a0 = fminf(fmaxf(bflo(a[q]), -30.f), 30.f), a1 = fminf(fmaxf(bfhi(a[q]), -30.f), 30.f), b0 = fminf(fmaxf(bflo(b[q]), -30.f), 30.f), b1 = fminf(fmaxf(bfhi(b[q]), -30.f), 30.f);
                        const float r0 = (1.0f + __expf(-b0)) * __builtin_amdgcn_rcpf(1.0f + __expf(-a0)), r1 = (1.0f + __expf(-b1)) * __builtin_amdgcn_rcpf(1.0f + __expf(-a1));
                        acc[ai][bj][m][q >> 1][(q & 1) * 2] *= r0; acc[ai][bj][m][q >> 1][(q & 1) * 2 + 1] *= r1; } } }
            asm volatile("" ::: "memory"); }
    }
    __device__ __forceinline__ void operator()(const f32x4 (&acc)[2][2][4][2], const Unit& u, int wr, int wc, int fr, int fq) const {
        const int row0 = u.pm * BM + wr * 64 + fr, col0 = u.pn * BM + wc * 32 + 8 * fq;
#pragma unroll
        for (int ai = 0; ai < 2; ++ai)
#pragma unroll
            for (int m = 0; m < 4; ++m) { const size_t row = (size_t)(row0 + ai * HALF + m * 16); const bf16_t* pr = PROJ + row * INC + 6144 + col0; bf16_t* orow = O + row * DM + col0;
#pragma unroll
                for (int bj = 0; bj < 2; ++bj) { const u32x4 b = *(const u32x4*)(pr + bj * HALF); u32x4 w;
#pragma unroll
                    for (int q = 0; q < 4; ++q) { const float b0 = fminf(fmaxf(bflo(b[q]), -30.f), 30.f), b1 = fminf(fmaxf(bfhi(b[q]), -30.f), 30.f);
                        w[q] = cvt_pk_bf16(acc[ai][bj][m][q >> 1][(q & 1) * 2] * sigmoid_fast(b0), acc[ai][bj][m][q >> 1][(q & 1) * 2 + 1] * sigmoid_fast(b1)); }
                    *(u32x4*)(orow + bj * HALF) = w; }
                asm volatile("" ::: "memory"); }
    }
};

template <class Epi, class Sched>
__device__ __forceinline__ void gemm_phase(LAS unsigned char* lds, const Gemm g, const Sched& S, const Epi& E) {
    int tid_ = threadIdx.x; asm volatile("" : "+v"(tid_));
    const int tid = tid_, wid = __builtin_amdgcn_readfirstlane(tid >> 6), lane = tid & 63, wr = wid >> 2, wc = wid & 3, fr = lane & 15, fq = lane >> 4;
    unsigned voffA[2], voffB[2];
#pragma unroll
    for (int i = 0; i < 2; ++i) { int R, C; stage_rc(tid * 16 + i * 8192, R, C); const int Rb = Epi::PERM ? ((R & ~31) + perm32(R & 31)) : R;
        voffA[i] = (unsigned)(R * g.lda + C) * 2u; voffB[i] = (unsigned)(Rb * g.ldb + C) * 2u; }
    const size_t kstep = (size_t)(BK * 2);
    const size_t hA = (size_t)HALF * g.lda * 2, hB = (size_t)HALF * g.ldb * 2;
    const unsigned ldsw = (unsigned)wid * 1024u;
    const int aoff = lds_byte(wr * 64 + fr, fq * 8), boff = lds_byte(wc * 32 + fr, fq * 8);
#define PG8_SA(b, h) (((b) * 2 + (h)) * HTB)
#define PG8_SB(b, h) ((4 + (b) * 2 + (h)) * HTB)
#define PG8_STAGE(bufoff, gbase, voff) do { _Pragma("unroll") for (int _i = 0; _i < 2; ++_i) \
        __builtin_amdgcn_global_load_lds((const unsigned*)((const char*)(gbase) + (voff)[_i]), (LAS unsigned*)(lds + (bufoff) + ldsw + _i * 8192), 16, 0, 0); } while (0)
#define PG8_LDA(dst, b, h) do { _Pragma("unroll") for (int m = 0; m < 4; ++m) _Pragma("unroll") for (int k = 0; k < 2; ++k) dst[m][k] = *(const LAS bf16x8*)(lds + PG8_SA(b, h) + aoff + m * 2048 + k * 1024); } while (0)
#define PG8_LDB(dst, b, h) do { _Pragma("unroll") for (int n = 0; n < 2; ++n) _Pragma("unroll") for (int k = 0; k < 2; ++k) dst[n][k] = *(const LAS bf16x8*)(lds + PG8_SB(b, h) + boff + n * 2048 + k * 1024); } while (0)
#define PG8_MMA(ai, bj, At, Bt) do { __builtin_amdgcn_s_setprio(1); _Pragma("unroll") for (int m = 0; m < 4; ++m) _Pragma("unroll") for (int n = 0; n < 2; ++n) _Pragma("unroll") for (int k = 0; k < 2; ++k) \
        acc[ai][bj][m][n] = __builtin_amdgcn_mfma_f32_16x16x32_bf16(Bt[n][k], At[m][k], acc[ai][bj][m][n], 0, 0, 0); __builtin_amdgcn_s_setprio(0); } while (0)
#define PG8_WAIT_V(n) asm volatile("s_waitcnt vmcnt(" #n ")" ::: "memory")
#define PG8_WAIT_L(n) asm volatile("s_waitcnt lgkmcnt(" #n ")" ::: "memory")
#define PG8_BAR __builtin_amdgcn_s_barrier()
#define PG8_SCHED __builtin_amdgcn_sched_barrier(0)
    Unit cur, nxt; int ui = 0;
    if (!S.next(0, cur)) return;
    f32x4 acc[2][2][4][2];
#pragma unroll
    for (int a = 0; a < 2; ++a)
#pragma unroll
        for (int b = 0; b < 2; ++b)
#pragma unroll
            for (int m = 0; m < 4; ++m)
#pragma unroll
                for (int n = 0; n < 2; ++n) acc[a][b][m][n] = (f32x4){0.f, 0.f, 0.f, 0.f};
    bf16x8 At[4][2], B0[2][2], B1[2][2];
    const char* cA = cur.a; const char* cB = cur.b;
    PG8_STAGE(PG8_SB(0, 0), cB, voffB); PG8_STAGE(PG8_SB(0, 1), cB + hB, voffB); PG8_STAGE(PG8_SA(0, 0), cA, voffA); PG8_STAGE(PG8_SA(0, 1), cA + hA, voffA);
    if (wr == 1) PG8_BAR;
    PG8_WAIT_V(2); PG8_BAR;
    PG8_STAGE(PG8_SB(1, 0), cB + kstep, voffB); PG8_STAGE(PG8_SA(1, 0), cA + kstep, voffA); PG8_STAGE(PG8_SB(1, 1), cB + hB + kstep, voffB);
    PG8_WAIT_V(6); PG8_BAR;
    for (;;) {
        const bool has_next = S.next(ui + 1, nxt);
        const char* nA = has_next ? nxt.a : cA; const char* nB = has_next ? nxt.b : cB;
        const int nt = cur.nt, tmid = nt >> 1;
        for (int t = 0; t < nt; t += 2) {
            const bool last = (t == nt - 2);
            const char* a1 = cA + (size_t)(t + 1) * kstep;
            const char* a2 = last ? nA : cA + (size_t)(t + 2) * kstep; const char* b2 = last ? nB : cB + (size_t)(t + 2) * kstep;
            const char* a3 = a2 + kstep; const char* b3 = b2 + kstep;
            if constexpr (Epi::HAS_MID) { if (t == tmid) E.mid(acc, cur, wr, wc, fr, fq); }
            PG8_LDB(B0, 0, 0); PG8_LDB(B1, 0, 1); PG8_SCHED; PG8_LDA(At, 0, 0); PG8_STAGE(PG8_SA(1, 1), a1 + hA, voffA);
            PG8_WAIT_V(8); PG8_WAIT_L(0); PG8_BAR; PG8_MMA(0, 0, At, B0); PG8_MMA(0, 1, At, B1); PG8_BAR; PG8_SCHED;
            PG8_LDA(At, 0, 1); PG8_STAGE(PG8_SB(0, 0), b2, voffB); PG8_STAGE(PG8_SB(0, 1), b2 + hB, voffB); PG8_STAGE(PG8_SA(0, 0), a2, voffA);
            PG8_WAIT_V(8); PG8_WAIT_L(0); PG8_BAR; PG8_MMA(1, 0, At, B0); PG8_MMA(1, 1, At, B1); PG8_BAR; PG8_SCHED;
            PG8_LDB(B0, 1, 0); PG8_LDB(B1, 1, 1); PG8_SCHED; PG8_LDA(At, 1, 0); PG8_STAGE(PG8_SA(0, 1), a2 + hA, voffA);
            PG8_WAIT_V(8); PG8_WAIT_L(0); PG8_BAR; PG8_MMA(0, 0, At, B0); PG8_MMA(0, 1, At, B1); PG8_BAR; PG8_SCHED;
            PG8_LDA(At, 1, 1); PG8_STAGE(PG8_SB(1, 0), b3, voffB); PG8_STAGE(PG8_SB(1, 1), b3 + hB, voffB); PG8_STAGE(PG8_SA(1, 0), a3, voffA);
            PG8_WAIT_V(8); PG8_WAIT_L(0); PG8_BAR; PG8_MMA(1, 0, At, B0); PG8_MMA(1, 1, At, B1); PG8_BAR; PG8_SCHED;
        }
        if (wr == 0) PG8_BAR;
        E(acc, cur, wr, wc, fr, fq);
        if (!has_next) break;
#pragma unroll
        for (int a = 0; a < 2; ++a)
#pragma unroll
            for (int b = 0; b < 2; ++b)
#pragma unroll
                for (int m = 0; m < 4; ++m)
#pragma unroll
                    for (int n = 0; n < 2; ++n) acc[a][b][m][n] = (f32x4){0.f, 0.f, 0.f, 0.f};
        cur = nxt; cA = nA; cB = nB; ++ui;
        if (wr == 1) PG8_BAR;
    }
    PG8_WAIT_V(0);
    PG8_BAR;
#undef PG8_SA
#undef PG8_SB
#undef PG8_STAGE
#undef PG8_LDA
#undef PG8_LDB
#undef PG8_MMA
#undef PG8_WAIT_V
#undef PG8_WAIT_L
#undef PG8_BAR
#undef PG8_SCHED
}
}


#define XB_TMO      128
#define XB_XCNT(j)  (256  + 64 * (j))
#define XB_XSUB(j)  (1280 + 64 * (j))
#define XB_XGEN(j)  (2304 + 64 * (j))
#define XB_TOP      3328
#define XB_TOPGEN   3392
#define XCD_BAR_WORDS 3456
#define XB_SPIN_CAP (1u << 18)
__device__ __forceinline__ unsigned xb_ld(unsigned* p)              { return __hip_atomic_load(p, __ATOMIC_RELAXED, __HIP_MEMORY_SCOPE_AGENT); }
__device__ __forceinline__ unsigned xb_add(unsigned* p, unsigned v) { return __hip_atomic_fetch_add(p, v, __ATOMIC_RELAXED, __HIP_MEMORY_SCOPE_AGENT); }
__device__ __forceinline__ unsigned xb_xcc_id() { return (unsigned)__builtin_amdgcn_s_getreg((3 << 11) | 20) & 0xFu; }
#define XB_SPIN(cond, bar) do { unsigned _sp = 0; while (cond) { __builtin_amdgcn_s_sleep(1); \
    if ((++_sp & 255u) == 0u) { if (xb_ld(&(bar)[XB_TMO])) break; if (_sp > XB_SPIN_CAP) { atomicAdd(&(bar)[XB_TMO], 1u); break; } } } } while (0)
struct XcdBarrier { unsigned* bar; unsigned x; volatile LAS unsigned* st; };
__device__ __forceinline__ XcdBarrier xcd_barrier_post(unsigned* bar, volatile LAS unsigned* st) {
    XcdBarrier b; b.bar = bar; b.x = xb_xcc_id(); b.st = st;
    if (threadIdx.x == 0) (void)xb_add(&bar[XB_XCNT(b.x)], 1u);
    return b;
}
__device__ __forceinline__ void xcd_barrier_complete(unsigned* bar, unsigned x, unsigned& nloc, unsigned& nx) {
    const unsigned G = gridDim.x * gridDim.y * gridDim.z;
    unsigned sum, cnt, mine, sp = 0u;
    for (;;) {
        sum = 0u; cnt = 0u; mine = 0u;
#pragma unroll
        for (unsigned j = 0; j < 16; ++j) { const unsigned c = xb_ld(&bar[XB_XCNT(j)]); sum += c; cnt += (c > 0u) ? 1u : 0u; mine = (j == x) ? c : mine; }
        if (sum == G) break;
        __builtin_amdgcn_s_sleep(1);
        if ((++sp & 255u) == 0u) { if (xb_ld(&bar[XB_TMO])) break; if (sp > XB_SPIN_CAP) { atomicAdd(&bar[XB_TMO], 1u); break; } }
    }
    nloc = mine > 0u ? mine : 1u; nx = cnt > 0u ? cnt : 1u;
}
__device__ __forceinline__ void xcd_barrier(const XcdBarrier& b) {
    asm volatile("s_waitcnt vmcnt(0)" ::: "memory");
    __syncthreads();
    if (threadIdx.x == 0) {
        unsigned* bar = b.bar;
        __builtin_amdgcn_s_waitcnt(0);
        unsigned nloc = b.st[0], nx = b.st[1];
        if (nloc == 0u) { xcd_barrier_complete(bar, b.x, nloc, nx); b.st[0] = nloc; b.st[1] = nx; }
        const unsigned old = xb_add(&bar[XB_XSUB(b.x)], 1u);
        const unsigned gen = old / nloc;
        if (old + 1u == (gen + 1u) * nloc) {
            __builtin_amdgcn_fence(__ATOMIC_RELEASE, "agent");
            asm volatile("s_waitcnt vmcnt(0)" ::: "memory");
            const unsigned og = xb_add(&bar[XB_TOP], 1u);
            const unsigned tg = og / nx;
            if (og + 1u == (tg + 1u) * nx) xb_add(&bar[XB_TOPGEN], 1u);
            else XB_SPIN(xb_ld(&bar[XB_TOPGEN]) == tg, bar);
            __builtin_amdgcn_fence(__ATOMIC_ACQUIRE, "agent");
            xb_add(&bar[XB_XGEN(b.x)], 1u);
            asm volatile("s_waitcnt vmcnt(0)" ::: "memory");
        } else {
            XB_SPIN(xb_ld(&bar[XB_XGEN(b.x)]) == gen, bar);
            __builtin_amdgcn_fence(__ATOMIC_ACQUIRE, "agent");
            asm volatile("s_waitcnt vmcnt(0)" ::: "memory");
        }
    }
    __syncthreads();
}

struct Args { const float* in[29]; float* out; unsigned char* ws; int ph_lo, ph_hi; };
enum { I_XP = 0, I_XS, I_SCONV, I_SH, I_CP, I_CS, I_WADA, I_BADA, I_F1GU, I_F1D, I_F2GU, I_F2D, I_WIN, I_CONVW, I_CONVB, I_LWA, I_LBA, I_LWX, I_LBX, I_LAM, I_GLNG, I_GLNB, I_GWS, I_GBS, I_WPA, I_WPB, I_WOUT, I_LNG, I_LNB };
constexpr int NPHASE = 15;

__device__ __forceinline__ void transpose_item(const float* W, int N, bf16_t* WT, int ldd, int koff, int mode, LAS float* scr, int item, int lane) {
    const int nblk = N / 32, kb = item / nblk, nb = item % nblk, k0 = 64 * kb, n0 = 32 * nb;
    float tv[32];
#pragma unroll
    for (int i = 0; i < 32; ++i) tv[i] = W[(size_t)(k0 + 2 * i + (lane >> 5)) * N + n0 + (lane & 31)];
#pragma unroll
    for (int i = 0; i < 32; ++i) scr[(2 * i + (lane >> 5)) * 33 + (lane & 31)] = tv[i];
    LDS_WAIT(); asm volatile("" ::: "memory");
    int d0 = n0;
    if (mode == 1) { const int half = n0 >= DFF ? 1 : 0, jj = n0 - half * DFF; d0 = 256 * (jj >> 7) + 128 * half + (jj & 127); }
    const int c = lane & 7;
#pragma unroll
    for (int j = 0; j < 4; ++j) { const int n = (lane >> 3) + 8 * j; const LAS float* s = scr + (8 * c) * 33 + n;
        u32x4 o; o.x = pk2(s[0 * 33], s[1 * 33]); o.y = pk2(s[2 * 33], s[3 * 33]); o.z = pk2(s[4 * 33], s[5 * 33]); o.w = pk2(s[6 * 33], s[7 * 33]);
        *(u32x4*)(WT + (size_t)(d0 + n) * ldd + koff + k0 + 8 * c) = o; }
    LDS_WAIT(); asm volatile("" ::: "memory");
}


template <int MODE> __device__ __forceinline__ void lru_item(const Args& args, const bf16_t* PROJ, const bf16_t* WLRU, bf16_t* YAB, float* SEGA, float* SEGH, float* out, LAS unsigned char* wl, int it, int lane) {
    const int n = it & 15, e = lane, ch = n * 64 + e, fr = lane & 15, fq = lane >> 4;
    int b = 0, seg = 0, row0, b0 = 0;
    if (MODE == 2) { b0 = (it >> 4) * 4; row0 = NP + b0 * 4; } else { const int idx = it >> 4; b = idx >> 5; seg = idx & 31; row0 = b * SEQ + seg * SEGL; }
    LAS bf16_t* XA = (LAS bf16_t*)wl; LAS float* PR = (LAS float*)(wl + 2304); LAS float* PI = (LAS float*)(wl + 6400);
    bf16x8 wfa[4][2], wfx[4][2];
#pragma unroll
    for (int et = 0; et < 4; ++et)
#pragma unroll
        for (int kc = 0; kc < 2; ++kc) { wfa[et][kc] = *(const bf16x8*)(WLRU + ((size_t)(n * 64 + 16 * et + fr)) * 64 + 32 * kc + 8 * fq); wfx[et][kc] = *(const bf16x8*)(WLRU + ((size_t)((16 + n) * 64 + 16 * et + fr)) * 64 + 32 * kc + 8 * fq); }
    const float cw0 = args.in[I_CONVW][ch], cw1 = args.in[I_CONVW][DR + ch], cw2 = args.in[I_CONVW][2 * DR + ch], cw3 = args.in[I_CONVW][3 * DR + ch], cbv = args.in[I_CONVB][ch];
    const float ba = args.in[I_LBA][ch], bxv = args.in[I_LBX][ch];
    const float sp8 = -8.0f * log1pf(expf(-args.in[I_LAM][ch]));
    float x1 = 0.f, x2 = 0.f, x3 = 0.f, h = 0.f, P = 1.f;
    if (MODE != 2 && seg > 0) { x1 = bf2f(PROJ[(size_t)(row0 - 1) * INC + ch]); x2 = bf2f(PROJ[(size_t)(row0 - 2) * INC + ch]); x3 = bf2f(PROJ[(size_t)(row0 - 3) * INC + ch]); }
    if (MODE == 1) {
        for (int s0 = 0; s0 < seg; s0 += 8) { float av[8], hv[8];
#pragma unroll
            for (int j = 0; j < 8; ++j) { const int s = s0 + j < seg ? s0 + j : seg - 1; av[j] = SEGA[(size_t)(b * NSEG + s) * DR + ch]; hv[j] = SEGH[(size_t)(b * NSEG + s) * DR + ch]; }
#pragma unroll
            for (int j = 0; j < 8; ++j) if (s0 + j < seg) h = av[j] * h + hv[j]; }
    }
    constexpr int NTILE = MODE == 2 ? 1 : 4;
    bf16_t xn[16], gn[16];
#pragma unroll
    for (int t = 0; t < 16; ++t) { const size_t row = (size_t)(row0 + t); xn[t] = PROJ[row * INC + ch]; if (MODE != 0) gn[t] = PROJ[row * INC + DR + ch]; }
    for (int tile = 0; tile < NTILE; ++tile) {
        float xv[16], grv[16], xc[16];
#pragma unroll
        for (int t = 0; t < 16; ++t) { xv[t] = bf2f(xn[t]); if (MODE != 0) grv[t] = bf2f(gn[t]); }
        if (tile + 1 < NTILE) {
#pragma unroll
            for (int t = 0; t < 16; ++t) { const size_t row = (size_t)(row0 + (tile + 1) * 16 + t); xn[t] = PROJ[row * INC + ch]; if (MODE != 0) gn[t] = PROJ[row * INC + DR + ch]; } }
#pragma unroll
        for (int t = 0; t < 16; ++t) {
            if (MODE == 2 && (t & 3) == 0) { const size_t bg = (size_t)(b0 + tile * 4 + (t >> 2)); x3 = args.in[I_SCONV][(bg * 3 + 0) * DR + ch]; x2 = args.in[I_SCONV][(bg * 3 + 1) * DR + ch]; x1 = args.in[I_SCONV][(bg * 3 + 2) * DR + ch]; }
            xc[t] = cbv + cw0 * x3 + cw1 * x2 + cw2 * x1 + cw3 * xv[t];
            x3 = x2; x2 = x1; x1 = xv[t];
            XA[t * 72 + e] = (bf16_t)f2bf(xc[t]); }
        LDS_WAIT();
        bf16x8 yf[2];
#pragma unroll
        for (int kc = 0; kc < 2; ++kc) yf[kc] = *(const LAS bf16x8*)(XA + fr * 72 + 32 * kc + 8 * fq);
#pragma unroll
        for (int et = 0; et < 4; ++et) { f32x4 dr = (f32x4){0.f, 0.f, 0.f, 0.f}, di = (f32x4){0.f, 0.f, 0.f, 0.f};
            dr = __builtin_amdgcn_mfma_f32_16x16x32_bf16(yf[0], wfa[et][0], dr, 0, 0, 0); dr = __builtin_amdgcn_mfma_f32_16x16x32_bf16(yf[1], wfa[et][1], dr, 0, 0, 0);
            di = __builtin_amdgcn_mfma_f32_16x16x32_bf16(yf[0], wfx[et][0], di, 0, 0, 0); di = __builtin_amdgcn_mfma_f32_16x16x32_bf16(yf[1], wfx[et][1], di, 0, 0, 0);
#pragma unroll
            for (int r = 0; r < 4; ++r) { PR[(4 * fq + r) * 64 + 16 * et + fr] = dr[r]; PI[(4 * fq + r) * 64 + 16 * et + fr] = di[r]; } }
        LDS_WAIT();
#pragma unroll
        for (int t = 0; t < 16; ++t) {
            const float pr = PR[t * 64 + e] + ba, pi = PI[t * 64 + e] + bxv;
            const float rg = sigmoid_fast(pr), ig = sigmoid_fast(pi);
            const float la = sp8 * rg, a = __expf(la), x = 2.0f * la;
            const float em = -x * (1.0f + x * (0.5f + x * (0.16666667f + x * (0.041666668f + x * (0.0083333338f + x * 0.0013888889f)))));
            float mult = sqrtf(em);
            if (MODE != 2 && seg == 0 && tile == 0 && t == 0) mult = 1.0f;
            if (MODE == 2 && (t & 3) == 0) h = args.in[I_SH][(size_t)(b0 + tile * 4 + (t >> 2)) * DR + ch];
            h = a * h + mult * ig * xc[t];
            if (MODE == 0) P *= a;
            if (MODE != 0) { const size_t row = (size_t)(row0 + tile * 16 + t); YAB[row * DM + ch] = (bf16_t)f2bf(h * gelu_tanh(grv[t])); }
            if (MODE == 2) { const size_t bg = (size_t)(b0 + tile * 4 + (t >> 2)); if ((t & 3) == 3) out[O_HS + bg * DR + ch] = h; if ((t & 3) != 0) out[O_CS + (bg * 3 + (t & 3) - 1) * DR + ch] = xv[t]; }
            if (MODE == 1 && seg == NSEG - 1 && tile == 3) { if (t == 15) out[O_HP + (size_t)b * DR + ch] = h; if (t >= 13) out[O_CP + ((size_t)b * 3 + (t - 13)) * DR + ch] = xv[t]; }
        }
        LDS_WAIT();
    }
    if (MODE == 0) { SEGA[(size_t)(b * NSEG + seg) * DR + ch] = P; SEGH[(size_t)(b * NSEG + seg) * DR + ch] = h; }
}

template <int KIND> __device__ __forceinline__ void phase_body(const Args& args, const int ph, LAS unsigned char* lds) {

    int tid_ = threadIdx.x; asm volatile("" : "+v"(tid_));
    const int tid = tid_, lane = tid & 63, wave = __builtin_amdgcn_readfirstlane(tid >> 6);
    int bx_ = blockIdx.x; asm volatile("" : "+s"(bx_));
    const int G = gridDim.x, bx = bx_;
    const int gw = bx * NWAVES + wave, NGW = G * NWAVES;
    unsigned char* ws = args.ws; asm volatile("" : "+s"(ws));
    bf16_t* W1GU = (bf16_t*)(ws + OFF_W1GU); bf16_t* W1D = (bf16_t*)(ws + OFF_W1D); bf16_t* W2GU = (bf16_t*)(ws + OFF_W2GU); bf16_t* W2D = (bf16_t*)(ws + OFF_W2D);
    bf16_t* WIN = (bf16_t*)(ws + OFF_WIN); bf16_t* WPAB = (bf16_t*)(ws + OFF_WPAB); bf16_t* WOUT = (bf16_t*)(ws + OFF_WOUT); bf16_t* WADA = (bf16_t*)(ws + OFF_WADA);
    bf16_t* SC = (bf16_t*)(ws + OFF_SC); float* MOD = (float*)(ws + OFF_MOD); bf16_t* U = (bf16_t*)(ws + OFF_U); bf16_t* YAB = (bf16_t*)(ws + OFF_YAB);
    float* X = (float*)(ws + OFF_X); bf16_t* HP = (bf16_t*)(ws + OFF_HP); float* HL = (float*)(ws + OFF_HL); float* PP = (float*)(ws + OFF_PP);
    float* SEGA = (float*)(ws + OFF_SEG); float* SEGH = SEGA + 4 * NSEG * DR;
    float* out = args.out;

        if constexpr (KIND == 0) {
            LAS float* scr = (LAS float*)(lds + wave * 16384);
            constexpr int I_ADA = 32 * (NMOD / 32), I_GU = 32 * (2 * DFF / 32), I_D = (DFF / 64) * (DM / 32), I_IN = 32 * (INC / 32), I_PA = (DR / 64) * (DM / 32), I_OUT = 32 * (DM / 32);
            constexpr int NIT = I_ADA + 2 * I_GU + 2 * I_D + I_IN + 2 * I_PA + I_OUT;
            for (int it = gw; it < NIT; it += NGW) {
                int r = it;
                if (r < I_ADA) { transpose_item(args.in[I_WADA], NMOD, WADA, DM, 0, 0, scr, r, lane); continue; } r -= I_ADA;
                if (r < I_GU) { transpose_item(args.in[I_F1GU], 2 * DFF, W1GU, DM, 0, 1, scr, r, lane); continue; } r -= I_GU;
                if (r < I_D) { transpose_item(args.in[I_F1D], DM, W1D, DFF, 0, 0, scr, r, lane); continue; } r -= I_D;
                if (r < I_IN) { transpose_item(args.in[I_WIN], INC, WIN, DM, 0, 0, scr, r, lane); continue; } r -= I_IN;
                if (r < I_PA) { transpose_item(args.in[I_WPA], DM, WPAB, DM, 0, 0, scr, r, lane); continue; } r -= I_PA;
                if (r < I_PA) { transpose_item(args.in[I_WPB], DM, WPAB, DM, DR, 0, scr, r, lane); continue; } r -= I_PA;
                if (r < I_OUT) { transpose_item(args.in[I_WOUT], DM, WOUT, DM, 0, 0, scr, r, lane); continue; } r -= I_OUT;
                if (r < I_GU) { transpose_item(args.in[I_F2GU], 2 * DFF, W2GU, DM, 0, 1, scr, r, lane); continue; } r -= I_GU;
                transpose_item(args.in[I_F2D], DM, W2D, DFF, 0, 0, scr, r, lane);
            }
            for (int i = bx * 512 + tid; i < 256 * DM / 2; i += G * 512) { const int row = i / (DM / 2), c2 = (i % (DM / 2)) * 2;
                float v0 = 0.f, v1 = 0.f;
                if (row < 132) { const float* cp = row < 4 ? args.in[I_CP] + (size_t)row * DM : args.in[I_CS] + (size_t)(row - 4) * DM; const float a = cp[c2], b = cp[c2 + 1]; v0 = a / (1.0f + expf(-a)); v1 = b / (1.0f + expf(-b)); }
                ((unsigned*)SC)[i] = pk2(v0, v1); }
            for (int i = bx * 512 + tid; i < 2 * 16 * 64 * 64; i += G * 512) { const int gate = i >> 16, n = (i >> 12) & 15, e = (i >> 6) & 63, d = i & 63;
                ((bf16_t*)(ws + OFF_WLRU))[i] = (bf16_t)f2bf(args.in[gate ? I_LWX : I_LWA][(size_t)n * 4096 + d * 64 + e]); }
        }
        if constexpr (KIND == 1) {
            pg8::Gemm g{DM, DM}; pg8::TileSched S; S.init(SC, WADA, DM, DM, 256, NMOD, DM, G, bx);
            pg8::EpiF32 E{MOD, NMOD, args.in[I_BADA]};
            pg8::gemm_phase<pg8::EpiF32, pg8::TileSched>(lds, g, S, E);
        }
        if constexpr (KIND == 2) {
            for (int r = gw; r < MR; r += NGW) {
                const float* xr = r < NP ? args.in[I_XP] + (size_t)r * DM : args.in[I_XS] + (size_t)(r - NP) * DM;
                const float* md = MOD + (size_t)modrow(r) * NMOD;
#pragma unroll
                for (int j = 0; j < 8; ++j) { const int c = lane * 4 + 256 * j; const f32x4 x = *(const f32x4*)(xr + c), sh = *(const f32x4*)(md + c), sc = *(const f32x4*)(md + DM + c);
                    const f32x4 u = x * (1.0f + sc) + sh; u32x2 w; w.x = pk2(u[0], u[1]); w.y = pk2(u[2], u[3]); *(u32x2*)(U + (size_t)r * DM + c) = w; }
            }
        }
        if constexpr (KIND == 3) {
            pg8::Gemm g{DM, DM}; pg8::TileSched S; S.init(U, ph == 3 ? W1GU : W2GU, DM, DM, MR, 2 * DFF, DM, G, bx);
            pg8::EpiSwiglu E{HP};
            pg8::gemm_phase<pg8::EpiSwiglu, pg8::TileSched>(lds, g, S, E);
        }
        if constexpr (KIND == 4) {
            const int Kd = ph == 10 ? DM : DFF;
            pg8::Gemm g{Kd, Kd}; pg8::TileSched S; S.init(ph == 10 ? U : HP, ph == 4 ? W1D : (ph == 10 ? WOUT : W2D), Kd, Kd, NP, DM, Kd, G, bx);
            S.s_pm0 = NP / 256; S.s_nM = NS / 256; S.s_splits = ph == 10 ? 8 : 11; S.s_nt = ph == 10 ? 4 : 8;
            pg8::EpiResid E{args.in[I_XP], ph == 4 ? (const bf16_t*)nullptr : (const bf16_t*)(ws + OFF_X + 32 * MiB), (bf16_t*)(ws + OFF_X), MOD, ph == 4 ? 2 : (ph == 10 ? 5 : 8), ph == 10 ? 1.0f : 0.5f, (float*)(ws + OFF_WADA)};
            pg8::gemm_phase<pg8::EpiResid, pg8::TileSched>(lds, g, S, E);
        }
        if constexpr (KIND == 5) {
            const int li = ph == 5 ? 0 : (ph == 11 ? 1 : 2);
            const float* lg = args.in[I_LNG] + li * DM; const float* lb = args.in[I_LNB] + li * DM;
            const bf16_t* ZB = (const bf16_t*)(ws + OFF_X); bf16_t* XB = (bf16_t*)(ws + OFF_X + 32 * MiB);
            f32x4 lgv[8], lbv[8]; u32x2 nx[8];
#pragma unroll
            for (int j = 0; j < 8; ++j) { lgv[j] = *(const f32x4*)(lg + lane * 4 + 256 * j); lbv[j] = *(const f32x4*)(lb + lane * 4 + 256 * j); }
#define LN_STATS(v) float s = 0.f; \
                _Pragma("unroll") for (int j = 0; j < 8; ++j) s += (v[j][0] + v[j][1]) + (v[j][2] + v[j][3]); \
                const float mean = wave_sum(s) * (1.0f / DM); float q = 0.f; \
                _Pragma("unroll") for (int j = 0; j < 8; ++j) { v[j] = v[j] - mean; q += (v[j][0] * v[j][0] + v[j][1] * v[j][1]) + (v[j][2] * v[j][2] + v[j][3] * v[j][3]); } \
                const float rstd = 1.0f / sqrtf(wave_sum(q) * (1.0f / DM) + LN_EPS);
            int r = gw;
            if (r < NP) {
#pragma unroll
                for (int j = 0; j < 8; ++j) nx[j] = *(const u32x2*)(ZB + (size_t)r * DM + lane * 4 + 256 * j); }
            for (; r < NP; r += NGW) {
                f32x4 v[8];
#pragma unroll
                for (int j = 0; j < 8; ++j) v[j] = (f32x4){bflo(nx[j].x), bfhi(nx[j].x), bflo(nx[j].y), bfhi(nx[j].y)};
                const int rn = r + NGW;
                if (rn < NP) {
#pragma unroll
                    for (int j = 0; j < 8; ++j) nx[j] = *(const u32x2*)(ZB + (size_t)rn * DM + lane * 4 + 256 * j); }
                LN_STATS(v)
                const float* md = MOD + (size_t)(r >> 11) * NMOD + (3 * (li + 1)) * DM;
#pragma unroll
                for (int j = 0; j < 8; ++j) { const int c = lane * 4 + 256 * j; const f32x4 y = v[j] * rstd * lgv[j] + lbv[j];
                    if (ph == 14) *(f32x4*)(out + O_Y + (size_t)r * DM + c) = y;
                    else { u32x2 w; w.x = pk2(y[0], y[1]); w.y = pk2(y[2], y[3]); *(u32x2*)(XB + (size_t)r * DM + c) = w;
                        const f32x4 sh = *(const f32x4*)(md + c), sc = *(const f32x4*)(md + DM + c); const f32x4 u = y * (1.0f + sc) + sh; u32x2 w2; w2.x = pk2(u[0], u[1]); w2.y = pk2(u[2], u[3]); *(u32x2*)(U + (size_t)r * DM + c) = w2; } }
            }
            for (r = NP + gw; r < MR; r += NGW) {
                f32x4 v[8];
                const float* xsrc = li == 0 ? args.in[I_XS] + (size_t)(r - NP) * DM : X + (size_t)r * DM;
                const float* gt = MOD + (size_t)modrow(r) * NMOD + (3 * li + 2) * DM; const float coef = li == 1 ? 1.0f : 0.5f;
                const float* pt = (const float*)(ws + OFF_WADA) + (size_t)(r - NP) * DM;
#define SUMSLABS(NSL) _Pragma("unroll") for (int j = 0; j < 8; ++j) { const int c = lane * 4 + 256 * j; f32x4 a = *(const f32x4*)(pt + c); \
                    _Pragma("unroll") for (int k = 1; k < NSL; ++k) a += *(const f32x4*)(pt + (size_t)k * NS * DM + c); \
                    v[j] = *(const f32x4*)(xsrc + c) * ALPHA + *(const f32x4*)(gt + c) * coef * a; }
                if (li == 1) { SUMSLABS(8) } else { SUMSLABS(11) }
#undef SUMSLABS
                LN_STATS(v)
                const float* md = MOD + (size_t)modrow(r) * NMOD + (3 * (li + 1)) * DM;
#pragma unroll
                for (int j = 0; j < 8; ++j) { const int c = lane * 4 + 256 * j; const f32x4 y = v[j] * rstd * lgv[j] + lbv[j];
                    if (ph == 14) *(f32x4*)(out + O_Y + (size_t)r * DM + c) = y;
                    else { *(f32x4*)(X + (size_t)r * DM + c) = y;
                        const f32x4 sh = *(const f32x4*)(md + c), sc = *(const f32x4*)(md + DM + c); const f32x4 u = y * (1.0f + sc) + sh; u32x2 w2; w2.x = pk2(u[0], u[1]); w2.y = pk2(u[2], u[3]); *(u32x2*)(U + (size_t)r * DM + c) = w2; } }
            }
#undef LN_STATS
        }
        if constexpr (KIND == 6) {
            pg8::Gemm g{DM, DM}; pg8::TileSched S; S.init(U, WIN, DM, DM, MR, INC, DM, G, bx);
            pg8::EpiBf16 E{HP, INC, (f32x2*)(ws + OFF_STP)};
            pg8::gemm_phase<pg8::EpiBf16, pg8::TileSched>(lds, g, S, E);
        }
        if constexpr (KIND == 7) {
            const bf16_t* PROJ = HP; const bf16_t* WLRU = (const bf16_t*)(ws + OFF_WLRU);
            for (int it = gw; it < 2048; it += NGW) lru_item<0>(args, PROJ, WLRU, YAB, SEGA, SEGH, out, lds + wave * 10496, it, lane);
            for (int it = (gw * 4) % NGW + (gw * 4) / NGW; it < 512; it += NGW) lru_item<2>(args, PROJ, WLRU, YAB, SEGA, SEGH, out, lds + wave * 10496, it, lane);
            __syncthreads();
            {
                LAS bf16_t* VN = (LAS bf16_t*)lds;
                LAS bf16_t* WT = (LAS bf16_t*)(lds + 34816);
                LAS float* st = (LAS float*)(lds + 69632);
                const float* lg = args.in[I_GLNG]; const float* lb = args.in[I_GLNB];
                const int fr = lane & 15, fq = lane >> 4;
                int g_loaded = -1;
                for (int it = bx; it < 512; it += G) {
                    const int g = it & 7, pc = it >> 3, b = pc >> 4, c = pc & 15, row0 = b * SEQ + c * 128;
                    __syncthreads();
                    if (g != g_loaded) { g_loaded = g;
                        for (int i = tid; i < 128 * 32; i += 512) { const int t = i >> 5, s4 = (i & 31) * 4; const f32x4 w = *(const f32x4*)(args.in[I_GWS] + (size_t)g * 16384 + t * 128 + s4);
                            u32x2 o; o.x = pk2(s4 + 0 <= t ? w[0] : 0.f, s4 + 1 <= t ? w[1] : 0.f); o.y = pk2(s4 + 2 <= t ? w[2] : 0.f, s4 + 3 <= t ? w[3] : 0.f); *(LAS u32x2*)(WT + t * 136 + s4) = o; } }
                    if (tid < 128) { const f32x4* sp = (const f32x4*)((const f32x2*)(ws + OFF_STP) + (size_t)(row0 + tid) * 16); float s = 0.f, q = 0.f;
#pragma unroll
                        for (int j = 0; j < 8; ++j) { const f32x4 v = sp[j]; s += v[0] + v[2]; q += v[1] + v[3]; }
                        const float mean = s * (1.0f / DR), var = fmaxf(q * (1.0f / DR) - mean * mean, 0.f);
                        st[tid * 2] = mean; st[tid * 2 + 1] = 1.0f / sqrtf(var + LN_EPS); }
                    __syncthreads();
#pragma unroll
                    for (int i = 0; i < 4; ++i) { const int task = tid + 512 * i, s = task >> 4, dc = task & 15, chn = g * 128 + dc * 8;
                        const u32x4 p = *(const u32x4*)(PROJ + (size_t)(row0 + s) * INC + 3072 + chn); const float mean = st[s * 2], rstd = st[s * 2 + 1];
                        const f32x4 g0 = *(const f32x4*)(lg + chn), g1 = *(const f32x4*)(lg + chn + 4), b0v = *(const f32x4*)(lb + chn), b1v = *(const f32x4*)(lb + chn + 4);
                        u32x4 o; o.x = pk2((bflo(p[0]) - mean) * rstd * g0[0] + b0v[0], (bfhi(p[0]) - mean) * rstd * g0[1] + b0v[1]); o.y = pk2((bflo(p[1]) - mean) * rstd * g0[2] + b0v[2], (bfhi(p[1]) - mean) * rstd * g0[3] + b0v[3]);
                        o.z = pk2((bflo(p[2]) - mean) * rstd * g1[0] + b1v[0], (bfhi(p[2]) - mean) * rstd * g1[1] + b1v[1]); o.w = pk2((bflo(p[3]) - mean) * rstd * g1[2] + b1v[2], (bfhi(p[3]) - mean) * rstd * g1[3] + b1v[3]);
                        *(LAS u32x4*)(VN + s * 136 + dc * 8) = o; }
                    __syncthreads();
                    bf16x8 vf[4];
#pragma unroll
                    for (int kc = 0; kc < 4; ++kc) { short tmp[8];
#pragma unroll
                        for (int j = 0; j < 8; ++j) tmp[j] = (short)VN[(32 * kc + 8 * fq + j) * 136 + 16 * wave + fr];
                        vf[kc] = (bf16x8){tmp[0], tmp[1], tmp[2], tmp[3], tmp[4], tmp[5], tmp[6], tmp[7]}; }
#pragma unroll
                    for (int tt = 0; tt < 8; ++tt) { f32x4 acc = (f32x4){0.f, 0.f, 0.f, 0.f};
#pragma unroll
                        for (int kc = 0; kc <= (16 * tt + 15) / 32; ++kc) { const bf16x8 wf = *(const LAS bf16x8*)(WT + (16 * tt + fr) * 136 + 32 * kc + 8 * fq); acc = __builtin_amdgcn_mfma_f32_16x16x32_bf16(vf[kc], wf, acc, 0, 0, 0); }
                        const int t = 16 * tt + fr, col = g * 128 + 16 * wave + 4 * fq; const size_t row = (size_t)(row0 + t);
                        const float bsv = args.in[I_GBS][g * 128 + t]; const u32x2 gu = *(const u32x2*)(PROJ + row * INC + 2048 + col);
                        u32x2 o; o.x = pk2(bflo(gu.x) * (acc[0] + bsv), bfhi(gu.x) * (acc[1] + bsv)); o.y = pk2(bflo(gu.y) * (acc[2] + bsv), bfhi(gu.y) * (acc[3] + bsv));
                        *(u32x2*)(YAB + row * DM + DR + col) = o; }
                }
            }
            for (int bg = NGW - 1 - gw; bg < 128; bg += NGW) {
                float vnv[4][16];
#pragma unroll
                for (int t = 0; t < 4; ++t) { const bf16_t* gvp = PROJ + (size_t)(NP + bg * 4 + t) * INC + 3072;
                    const u32x4 p0 = *(const u32x4*)(gvp + lane * 8), p1 = *(const u32x4*)(gvp + 512 + lane * 8);
#pragma unroll
                    for (int q = 0; q < 4; ++q) { vnv[t][2 * q] = bflo(p0[q]); vnv[t][2 * q + 1] = bfhi(p0[q]); vnv[t][8 + 2 * q] = bflo(p1[q]); vnv[t][8 + 2 * q + 1] = bfhi(p1[q]); }
                    float s = 0.f, qq = 0.f; { const f32x4* sp = (const f32x4*)((const f32x2*)(ws + OFF_STP) + (size_t)(NP + bg * 4 + t) * 16);
#pragma unroll
                        for (int j = 0; j < 8; ++j) { const f32x4 v = sp[j]; s += v[0] + v[2]; qq += v[1] + v[3]; } }
                    const float mean = s * (1.0f / DR), rstd = 1.0f / sqrtf(fmaxf(qq * (1.0f / DR) - mean * mean, 0.f) + LN_EPS);
#pragma unroll
                    for (int q = 0; q < 16; ++q) { const int chn = (q >> 3) * 512 + lane * 8 + (q & 7); vnv[t][q] = (vnv[t][q] - mean) * rstd * args.in[I_GLNG][chn] + args.in[I_GLNB][chn]; }
                    float* vo = out + O_VS + (size_t)(bg * 4 + t) * DR;
#pragma unroll
                    for (int j = 0; j < 2; ++j) { *(f32x4*)(vo + j * 512 + lane * 8) = (f32x4){vnv[t][j * 8 + 0], vnv[t][j * 8 + 1], vnv[t][j * 8 + 2], vnv[t][j * 8 + 3]};
                        *(f32x4*)(vo + j * 512 + lane * 8 + 4) = (f32x4){vnv[t][j * 8 + 4], vnv[t][j * 8 + 5], vnv[t][j * 8 + 6], vnv[t][j * 8 + 7]}; }
                }
#pragma unroll
                for (int j = 0; j < 2; ++j) { const int g = (lane >> 4) + 4 * j; const float* wg = args.in[I_GWS] + (size_t)g * 16384; const float* bsg = args.in[I_GBS] + g * 128;
#pragma unroll
                    for (int t = 0; t < 4; ++t) { const size_t row = (size_t)NP + bg * 4 + t; const u32x4 gu = *(const u32x4*)(PROJ + row * INC + 2048 + j * 512 + lane * 8); float o[8];
#pragma unroll
                        for (int q = 0; q < 8; ++q) { float acc = bsg[t];
#pragma unroll
                            for (int s = 0; s < 4; ++s) if (s <= t) acc += wg[t * 128 + s] * vnv[s][j * 8 + q];
                            const float guv = (q & 1) ? bfhi(gu[q >> 1]) : bflo(gu[q >> 1]); o[q] = guv * acc; }
                        u32x4 w; w.x = pk2(o[0], o[1]); w.y = pk2(o[2], o[3]); w.z = pk2(o[4], o[5]); w.w = pk2(o[6], o[7]);
                        *(u32x4*)(YAB + row * DM + DR + j * 512 + lane * 8) = w; } }
            }
        }
        if constexpr (KIND == 8) {
            const bf16_t* PROJ = HP; const bf16_t* WLRU = (const bf16_t*)(ws + OFF_WLRU);
            for (int it = gw; it < 2048; it += NGW) lru_item<1>(args, PROJ, WLRU, YAB, SEGA, SEGH, out, lds + wave * 10496, it, lane);
        }
        if constexpr (KIND == 9) {
            pg8::Gemm g{DM, DM}; pg8::TileSched S; S.init(YAB, WPAB, DM, DM, MR, DM, DM, G, bx);
            pg8::EpiMerge E{HP, U};
            pg8::gemm_phase<pg8::EpiMerge, pg8::TileSched>(lds, g, S, E);
        }
}

__global__ void __launch_bounds__(NWAVES * 64, 2) fwd(Args args) {
    extern __shared__ __attribute__((aligned(16))) unsigned char lds_raw[];
    LAS unsigned char* lds = (LAS unsigned char*)lds_raw;
    cg::grid_group grid = cg::this_grid();
    if (args.ph_hi > 1000) grid.sync();
    volatile LAS unsigned* bst = (volatile LAS unsigned*)(lds + 131072 + 1024);
    if (threadIdx.x < 16) bst[threadIdx.x] = 0u;
    __syncthreads();
    XcdBarrier bar = xcd_barrier_post((unsigned*)args.ws, bst);
    for (int ph_ = args.ph_lo; ph_ < args.ph_hi + (REPEAT_PH >= 0 ? 1 : 0); ++ph_) {
        const int ph = (REPEAT_PH >= 0 && ph_ > REPEAT_PH) ? ph_ - 1 : ph_;
        switch (ph) {
        case 0: phase_body<0>(args, ph, lds); break;
        case 1: phase_body<1>(args, ph, lds); break;
        case 2: phase_body<2>(args, ph, lds); break;
        case 3: case 12: phase_body<3>(args, ph, lds); break;
        case 4: case 10: case 13: phase_body<4>(args, ph, lds); break;
        case 5: case 11: case 14: phase_body<5>(args, ph, lds); break;
        case 6: phase_body<6>(args, ph, lds); break;
        case 7: phase_body<7>(args, ph, lds); break;
        case 8: phase_body<8>(args, ph, lds); break;
        case 9: phase_body<9>(args, ph, lds); break;
        default: break;
        }
        if (ph_ + 1 < args.ph_hi + (REPEAT_PH >= 0 ? 1 : 0)) xcd_barrier(bar);
    }
}


#ifdef DIAG_KINDS
template <int KIND> __global__ void __launch_bounds__(NWAVES * 64, 2) diag(Args args) {
    extern __shared__ __attribute__((aligned(16))) unsigned char lds_raw[];
    phase_body<KIND>(args, args.ph_lo, (LAS unsigned char*)lds_raw);
}
template __global__ void diag<0>(Args); template __global__ void diag<1>(Args); template __global__ void diag<2>(Args); template __global__ void diag<3>(Args); template __global__ void diag<4>(Args);
template __global__ void diag<5>(Args); template __global__ void diag<6>(Args); template __global__ void diag<7>(Args); template __global__ void diag<8>(Args); template __global__ void diag<9>(Args);
#endif
extern "C" void kernel_launch(void* const* d_in, const int* in_sizes, int n_in, void* d_out, int out_size, void* d_ws, size_t ws_size, hipStream_t stream) {
    static int grid = 0;
    if (grid == 0) {
        if (n_in != 29 || ws_size < WS_END) { fprintf(stderr, "kernel_launch: need 29 inputs and %zu bytes of ws; got %d, %zu\n", (size_t)WS_END, n_in, ws_size); grid = -1; return; }
        int dev = 0, cus = 0, per_cu = 0;
        hipGetDevice(&dev); hipDeviceGetAttribute(&cus, hipDeviceAttributeMultiprocessorCount, dev);
        if (hipFuncSetAttribute((const void*)fwd, hipFuncAttributeMaxDynamicSharedMemorySize, LDS_BYTES) != hipSuccess) { fprintf(stderr, "kernel_launch: hipFuncSetAttribute failed\n"); grid = -1; return; }
        if (hipOccupancyMaxActiveBlocksPerMultiprocessor(&per_cu, (const void*)fwd, NWAVES * 64, LDS_BYTES) != hipSuccess || per_cu < 1) { fprintf(stderr, "kernel_launch: occupancy query says %d\n", per_cu); per_cu = 1; }
        (void)hipGetLastError();
        grid = cus;
    }
    if (grid < 0) return;
    Args a{};
    for (int i = 0; i < 29; ++i) a.in[i] = (const float*)d_in[i];
    a.out = (float*)d_out; a.ws = (unsigned char*)d_ws;
#if ONE_LAUNCH
    a.ph_lo = 0; a.ph_hi = NPHASE;
    if (hipMemsetAsync(d_ws, 0, 16384, stream) != hipSuccess) { fprintf(stderr, "kernel_launch: memset of barrier words failed\n"); return; }
    { void* kargs[] = {&a}; hipError_t e = hipLaunchCooperativeKernel((const void*)fwd, dim3(grid), dim3(NWAVES * 64), kargs, LDS_BYTES, stream);
      if (e != hipSuccess) fprintf(stderr, "cooperative launch failed: %s (grid %d)\n", hipGetErrorString(e), grid); }
#else
    for (int ph = 0; ph < NPHASE; ++ph) { a.ph_lo = ph; a.ph_hi = ph + 1; void* kargs[] = {&a};
        hipError_t e = hipLaunchCooperativeKernel((const void*)fwd, dim3(grid), dim3(NWAVES * 64), kargs, LDS_BYTES, stream);
        if (e != hipSuccess) { fprintf(stderr, "cooperative launch %d failed: %s (grid %d)\n", ph, hipGetErrorString(e), grid); break; } }
#endif
}
```
